# Optimizing an MI355X kernel written in HIP

```python
import jax, jax.numpy as jnp
from jax import lax
import numpy as np

D_MODEL = 1024
BATCH = 32
SEQ = 2048
DEPTH = 1
DEC_BATCH = 16
DEC_SEQ = 64
PAST_LEN = 4096

CHUNK = 64
Q_BLOCK = 128
D_MIX = D_MODEL
SB_WIDTH = D_MIX // 2
MLA_WIDTH = D_MIX - SB_WIDTH
SB_HEAD_DIM = 64
SB_HEADS = SB_WIDTH // SB_HEAD_DIM
MLA_V_DIM = 64
MLA_HEADS = MLA_WIDTH // MLA_V_DIM
MLA_NOPE_DIM = 64
MLA_ROPE_DIM = 32
Q_LORA_RANK = 3 * D_MODEL // 8
KV_LORA_RANK = D_MODEL // 4
ROPE_THETA = 10000.0
EPS = 1e-6
IN_SIZES = (SB_WIDTH, SB_WIDTH, SB_WIDTH, SB_WIDTH,
            Q_LORA_RANK, KV_LORA_RANK, MLA_ROPE_DIM, MLA_WIDTH)
IN_COLS = SB_WIDTH * 4 + Q_LORA_RANK + KV_LORA_RANK + MLA_ROPE_DIM + MLA_WIDTH

kernel_name = "sb_mla_parallel_stream_encoder_step"


def rms_norm(x, g):
    xf = x.astype(jnp.float32)
    y = xf * lax.rsqrt(jnp.mean(xf * xf, axis=-1, keepdims=True) + EPS)
    return (y * g.astype(jnp.float32)).astype(x.dtype)


def rope(x, pos):
    r = x.shape[-1]
    inv_freq = ROPE_THETA ** (-jnp.arange(0, r, 2, dtype=jnp.float32) / r)
    ang = pos.astype(jnp.float32)[:, None] * inv_freq[None, :]
    cos = jnp.cos(ang)[:, None, :]
    sin = jnp.sin(ang)[:, None, :]
    xf = x.astype(jnp.float32)
    x1, x2 = xf[..., : r // 2], xf[..., r // 2:]
    return jnp.concatenate([x1 * cos - x2 * sin, x2 * cos + x1 * sin], axis=-1).astype(x.dtype)


def split_cols(a, sizes):
    out, start = [], 0
    for s in sizes:
        out.append(a[..., start:start + s])
        start += s
    return out


def stick_breaking_block(q, k, v, q_pos, k_pos):
    z = jnp.einsum('bqhd,bkhd->bhqk', q, k).astype(jnp.float32) * (SB_HEAD_DIM ** -0.5)
    causal = k_pos[None, :] < q_pos[:, None]
    log_beta = jax.nn.log_sigmoid(z)
    log_rem = jnp.where(causal, log_beta - z, 0.0)
    tail = lax.cumsum(log_rem, axis=3, reverse=True) - log_rem
    w = jnp.where(causal, jnp.exp(log_beta + tail), 0.0)
    return jnp.einsum('bhqk,bkhd->bqhd', w.astype(v.dtype), v)


def mla_block(q_nope, q_rope, k_nope, k_rope, v, q_pos, k_pos):
    s = (jnp.einsum('bqhn,bkhn->bhqk', q_nope, k_nope)
         + jnp.einsum('bqhr,bkr->bhqk', q_rope, k_rope)).astype(jnp.float32)
    s = s * ((MLA_NOPE_DIM + MLA_ROPE_DIM) ** -0.5)
    visible = (k_pos[None, :] // CHUNK) <= (q_pos[:, None] // CHUNK)
    s = jnp.where(visible, s, jnp.finfo(jnp.float32).min)
    p = jax.nn.softmax(s, axis=-1)
    return jnp.einsum('bhqk,bkhv->bqhv', p.astype(v.dtype), v)


def sweep_query_blocks(fn, qs, kvs, q_pos, k_pos):
    b, t = qs[0].shape[0], qs[0].shape[1]
    if t <= Q_BLOCK:
        return fn(*qs, *kvs, q_pos, k_pos)
    n = t // Q_BLOCK
    qs_b = tuple(jnp.moveaxis(a.reshape(b, n, Q_BLOCK, *a.shape[2:]), 1, 0) for a in qs)

    def one(args):
        blk, pos = args
        return fn(*blk, *kvs, pos, k_pos)

    out = lax.map(one, (qs_b, q_pos.reshape(n, Q_BLOCK)))
    return jnp.moveaxis(out, 0, 1).reshape(b, t, *out.shape[3:])


def mixer_layer(x, c, pos, past_sb_k, past_sb_v, past_ckv, past_krope,
                ada_w, ada_b, pre_g, w_in, q_norm_g, w_uq, kv_norm_g, w_ukv, w_out, post_g):
    b, t, _ = x.shape
    mod = jax.nn.silu(c) @ ada_w + ada_b
    shift, scale, gate = jnp.split(mod[:, None, :], 3, axis=-1)
    h = rms_norm(x, pre_g) * (1.0 + scale) + shift
    proj = h @ w_in
    sb_q, sb_k, sb_v, sb_g, c_q, c_kv, k_rope, mla_g = split_cols(proj, IN_SIZES)
    sb_q = sb_q.reshape(b, t, SB_HEADS, SB_HEAD_DIM)
    sb_k = sb_k.reshape(b, t, SB_HEADS, SB_HEAD_DIM)
    sb_v = sb_v.reshape(b, t, SB_HEADS, SB_HEAD_DIM)
    q = (rms_norm(c_q, q_norm_g) @ w_uq).reshape(b, t, MLA_HEADS, MLA_NOPE_DIM + MLA_ROPE_DIM)
    q_nope = q[..., :MLA_NOPE_DIM]
    q_rope = rope(q[..., MLA_NOPE_DIM:], pos)
    c_kv = rms_norm(c_kv, kv_norm_g)
    k_rope = rope(k_rope[:, :, None, :], pos)[:, :, 0, :]
    if past_sb_k is None:
        all_sb_k, all_sb_v, all_ckv, all_krope, k_pos = sb_k, sb_v, c_kv, k_rope, pos
    else:
        past_len = past_sb_k.shape[1]
        all_sb_k = jnp.concatenate([past_sb_k, sb_k], axis=1)
        all_sb_v = jnp.concatenate([past_sb_v, sb_v], axis=1)
        all_ckv = jnp.concatenate([past_ckv, c_kv], axis=1)
        all_krope = jnp.concatenate([past_krope, k_rope], axis=1)
        k_pos = jnp.concatenate([jnp.arange(past_len, dtype=jnp.int32), pos])
    tk = all_ckv.shape[1]
    kv = (all_ckv @ w_ukv).reshape(b, tk, MLA_HEADS, MLA_NOPE_DIM + MLA_V_DIM)
    k_nope, mla_v = kv[..., :MLA_NOPE_DIM], kv[..., MLA_NOPE_DIM:]
    sb_o = sweep_query_blocks(stick_breaking_block, (sb_q,), (all_sb_k, all_sb_v), pos, k_pos)
    mla_o = sweep_query_blocks(mla_block, (q_nope, q_rope), (k_nope, all_krope, mla_v), pos, k_pos)
    mixed = jnp.concatenate([sb_o.reshape(b, t, SB_WIDTH) * jax.nn.silu(sb_g),
                             mla_o.reshape(b, t, MLA_WIDTH) * jax.nn.silu(mla_g)], axis=-1)
    y = x + gate * rms_norm(mixed @ w_out, post_g)
    return y, sb_k, sb_v, c_kv, k_rope


def setup_inputs(seed: int = 0) -> dict:
    key = jax.random.key(seed)
    ks = jax.random.split(key, 20)
    f32 = jnp.float32
    nrm = lambda k, shape, s=1.0: (jax.random.normal(k, shape, f32) * s)
    return {
        "x_prompt": nrm(ks[0], (BATCH, SEQ, D_MODEL)),
        "x_sample": nrm(ks[1], (DEC_BATCH, DEC_SEQ, D_MODEL)),
        "cache_sb_k": nrm(ks[2], (DEPTH, DEC_BATCH, PAST_LEN, SB_HEADS, SB_HEAD_DIM)),
        "cache_sb_v": nrm(ks[3], (DEPTH, DEC_BATCH, PAST_LEN, SB_HEADS, SB_HEAD_DIM)),
        "cache_mla_ckv": nrm(ks[4], (DEPTH, DEC_BATCH, PAST_LEN, KV_LORA_RANK)),
        "cache_mla_krope": nrm(ks[5], (DEPTH, DEC_BATCH, PAST_LEN, MLA_ROPE_DIM)),
        "c_prompt": nrm(ks[6], (BATCH, D_MODEL)),
        "c_sample": nrm(ks[7], (DEC_BATCH, D_MODEL)),
        "ada_w": nrm(ks[8], (DEPTH, D_MODEL, 3 * D_MODEL), D_MODEL ** -0.5),
        "ada_b": nrm(ks[9], (DEPTH, 3 * D_MODEL), 0.01),
        "pre_norm_g": 1.0 + nrm(ks[10], (DEPTH, D_MODEL), 0.01),
        "w_in": nrm(ks[11], (DEPTH, D_MODEL, IN_COLS), D_MODEL ** -0.5),
        "q_norm_g": 1.0 + nrm(ks[12], (DEPTH, Q_LORA_RANK), 0.01),
        "w_uq": nrm(ks[13], (DEPTH, Q_LORA_RANK, MLA_HEADS * (MLA_NOPE_DIM + MLA_ROPE_DIM)), Q_LORA_RANK ** -0.5),
        "kv_norm_g": 1.0 + nrm(ks[14], (DEPTH, KV_LORA_RANK), 0.01),
        "w_ukv": nrm(ks[15], (DEPTH, KV_LORA_RANK, MLA_HEADS * (MLA_NOPE_DIM + MLA_V_DIM)), KV_LORA_RANK ** -0.5),
        "w_out": nrm(ks[16], (DEPTH, D_MIX, D_MODEL), D_MIX ** -0.5),
        "post_norm_g": 1.0 + nrm(ks[17], (DEPTH, D_MODEL), 0.01),
    }


def reference(x_prompt, x_sample, cache_sb_k, cache_sb_v, cache_mla_ckv, cache_mla_krope,
              c_prompt, c_sample, ada_w, ada_b, pre_norm_g, w_in, q_norm_g, w_uq,
              kv_norm_g, w_ukv, w_out, post_norm_g):
    pos_p = jnp.arange(x_prompt.shape[1], dtype=jnp.int32)
    pos_s = cache_sb_k.shape[2] + jnp.arange(x_sample.shape[1], dtype=jnp.int32)
    yp, ys = x_prompt, x_sample
    sk_p, sv_p, ckv_p, kr_p = [], [], [], []
    sk_s, sv_s, ckv_s, kr_s = [], [], [], []
    for l in range(DEPTH):
        w = (ada_w[l], ada_b[l], pre_norm_g[l], w_in[l], q_norm_g[l], w_uq[l],
             kv_norm_g[l], w_ukv[l], w_out[l], post_norm_g[l])
        yp, a, b_, c_, d_ = mixer_layer(yp, c_prompt, pos_p, None, None, None, None, *w)
        sk_p.append(a); sv_p.append(b_); ckv_p.append(c_); kr_p.append(d_)
        ys, a, b_, c_, d_ = mixer_layer(ys, c_sample, pos_s, cache_sb_k[l], cache_sb_v[l],
                                        cache_mla_ckv[l], cache_mla_krope[l], *w)
        sk_s.append(a); sv_s.append(b_); ckv_s.append(c_); kr_s.append(d_)
    return (yp, ys,
            jnp.stack(sk_p), jnp.stack(sv_p), jnp.stack(ckv_p), jnp.stack(kr_p),
            jnp.stack(sk_s), jnp.stack(sv_s), jnp.stack(ckv_s), jnp.stack(kr_s))
```

```cpp
#include <hip/hip_runtime.h>
#include <hip/hip_cooperative_groups.h>
#include <cstdio>
namespace cg = cooperative_groups;

#define DI __device__ __forceinline__
typedef unsigned short u16;
typedef short bf16x8 __attribute__((ext_vector_type(8)));
typedef short s16x4 __attribute__((ext_vector_type(4)));
typedef float f32x4 __attribute__((ext_vector_type(4)));
typedef float f32x16 __attribute__((ext_vector_type(16)));
typedef unsigned u32x4 __attribute__((ext_vector_type(4)));
typedef unsigned u32x2 __attribute__((ext_vector_type(2)));

constexpr int T_P = 2048, T_S = 64, PAST = 4096;
constexpr int NTOK_P = 65536, NTOK = 66560;
constexpr int TKS = PAST + T_S;
constexpr int NKV = NTOK_P + 16 * TKS;
constexpr int IN_COLS = 3232, NPAD = 3328;
constexpr float EPS = 1e-6f;
constexpr float LOG2E = 1.4426950408889634f;
constexpr float QS_SB = 0.125f * LOG2E;
constexpr float QS_MLA = 0.10206207261596575f * LOG2E;
constexpr float SB_DONE = -170.f;

constexpr size_t O_YP = 0, O_YS = 67108864, O_SKP = 68157440, O_SVP = 101711872, O_CKVP = 135266304, O_KRP = 152043520,
                 O_SKS = 154140672, O_SVS = 154664960, O_CKVS = 155189248, O_KRS = 155451392;

constexpr size_t OFF_CTR = 0;
constexpr size_t OFF_MOD = 256;
constexpr size_t OFF_ROPE = OFF_MOD + 589824;
constexpr size_t OFF_WIN = OFF_ROPE + 270336;
constexpr size_t OFF_WUQ = OFF_WIN + 6815744;
constexpr size_t OFF_WUKV = OFF_WUQ + 589824;
constexpr size_t OFF_WOUT = OFF_WUKV + 524288;
constexpr size_t OFF_CQSS = OFF_WOUT + 2097152;
constexpr size_t OFF_ROWSS = OFF_CQSS + 532480;
constexpr size_t OFF_H = OFF_ROWSS + 1064960;
constexpr size_t OFF_GATES = OFF_H + 136314880;
constexpr size_t OFF_SBQ = OFF_GATES + 136314880;
constexpr size_t OFF_SBK = OFF_SBQ + 68157440;
constexpr size_t OFF_SBV = OFF_SBK + 68157440;
constexpr size_t OFF_CQ = OFF_SBV + 68157440;
constexpr size_t OFF_CKV = OFF_CQ + 51118080;
constexpr size_t OFF_KROPE = OFF_CKV + 67633152;
constexpr size_t OFF_QMLA = OFF_KROPE + 8454144;
constexpr size_t OFF_KV = OFF_QMLA + 102236160;
constexpr size_t WS_END = OFF_KV + 270532608;

constexpr int LDS_BYTES = 131072 + 4096;

struct P {
  const float *x_prompt, *x_sample, *cache_sb_k, *cache_sb_v, *cache_ckv, *cache_krope, *c_prompt, *c_sample,
      *ada_w, *ada_b, *pre_g, *w_in, *q_norm_g, *w_uq, *kv_norm_g, *w_ukv, *w_out, *post_g;
  float* out;
  char* ws;
};

DI unsigned pk2(float a, float b) {
  typedef __bf16 bf2 __attribute__((ext_vector_type(2)));
  typedef float f2 __attribute__((ext_vector_type(2)));
  f2 v = {a, b};
  bf2 r = __builtin_convertvector(v, bf2);
  return __builtin_bit_cast(unsigned, r);
}
DI u16 bf1(float a) { return (u16)(pk2(a, 0.f) & 0xffffu); }
DI float bflo(unsigned v) { return __uint_as_float(v << 16); }
DI float bfhi(unsigned v) { return __uint_as_float(v & 0xffff0000u); }
DI float silu_f(float x) { return x / (1.f + __expf(-x)); }
DI float ex2(float x) { return __builtin_amdgcn_exp2f(x); }
DI float lg2(float x) { return __builtin_amdgcn_logf(x); }
DI float wave_sum(float v) {
#pragma unroll
  for (int o = 1; o < 64; o <<= 1) v += __shfl_xor(v, o);
  return v;
}
#define MFMA32(a, b, c) __builtin_amdgcn_mfma_f32_32x32x16_bf16((a), (b), (c), 0, 0, 0)
#define MFMA16(a, b, c) __builtin_amdgcn_mfma_f32_16x16x32_bf16((a), (b), (c), 0, 0, 0)

typedef __attribute__((address_space(3))) s16x4* lds_s16x4_ptr;
DI s16x4 tr_read(const char* ptr) {
  return __builtin_amdgcn_ds_read_tr16_b64_v4i16((lds_s16x4_ptr)(unsigned)(size_t)ptr);
}

DI int win_src_col(int p) {
  if (p < 2432) return p;
  if (p < 2464) return 2688 + (p - 2432);
  if (p < 2560) return -1;
  if (p < 2816) return 2432 + (p - 2560);
  return 2720 + (p - 2816);
}

DI void transpose_w(const float* __restrict__ W, int K, int N, int NP, u16* __restrict__ Wt, const float* __restrict__ kscale,
                    bool perm, int gtid, int gstride) {
  const int nk8 = K / 8;
  for (int e = gtid; e < NP * nk8; e += gstride) {
    const int pcol = e % NP, k8 = e / NP;
    const int c = perm ? win_src_col(pcol) : pcol;
    float v[8];
#pragma unroll
    for (int i = 0; i < 8; ++i) {
      float x = (c >= 0) ? W[(size_t)(k8 * 8 + i) * N + c] : 0.f;
      if (kscale) x *= kscale[k8 * 8 + i];
      v[i] = x;
    }
    u32x4 o = {pk2(v[0], v[1]), pk2(v[2], v[3]), pk2(v[4], v[5]), pk2(v[6], v[7])};
    *(u32x4*)(Wt + (size_t)pcol * K + k8 * 8) = o;
  }
}

DI void mod_job(const P& p, int job, float* lds) {
  const int cc = job % 48, bh = job / 48;
  const int tid = threadIdx.x, lane = tid & 63, w = tid >> 6;
  float* mod = (float*)(p.ws + OFF_MOD);
  __syncthreads();
  for (int e = tid; e < 24 * 1024; e += 512) {
    const int bl = e >> 10, k = e & 1023;
    const int b = bh * 24 + bl;
    const float cv = b < 32 ? p.c_prompt[b * 1024 + k] : p.c_sample[(b - 32) * 1024 + k];
    lds[k * 24 + bl] = silu_f(cv);
  }
  __syncthreads();
  float acc[24];
#pragma unroll
  for (int i = 0; i < 24; ++i) acc[i] = 0.f;
  const int col = cc * 64 + lane;
  for (int k = w * 128; k < w * 128 + 128; ++k) {
    const float wv = p.ada_w[(size_t)k * 3072 + col];
    const f32x4* s4 = (const f32x4*)(lds + k * 24);
#pragma unroll
    for (int q = 0; q < 6; ++q) {
      const f32x4 s = s4[q];
      acc[q * 4 + 0] += s.x * wv; acc[q * 4 + 1] += s.y * wv; acc[q * 4 + 2] += s.z * wv; acc[q * 4 + 3] += s.w * wv;
    }
  }
  __syncthreads();
#pragma unroll
  for (int i = 0; i < 24; ++i) lds[(w * 24 + i) * 64 + lane] = acc[i];
  __syncthreads();
  for (int e = tid; e < 24 * 64; e += 512) {
    const int bl = e >> 6, l = e & 63;
    float s = 0.f;
#pragma unroll
    for (int ww = 0; ww < 8; ++ww) s += lds[(ww * 24 + bl) * 64 + l];
    const int b = bh * 24 + bl, c = cc * 64 + l;
    mod[b * 3072 + c] = s + p.ada_b[c];
  }
  __syncthreads();
}

DI void phase0(const P& p, char* smem) {
  const int tid = threadIdx.x;
  const int gtid = blockIdx.x * 512 + tid, gstride = gridDim.x * 512;
  if (gtid == 0) { *(int*)(p.ws + OFF_CTR) = 0; }
  for (int job = blockIdx.x; job < 96; job += gridDim.x) mod_job(p, job, (float*)smem);
  transpose_w(p.w_in, 1024, IN_COLS, NPAD, (u16*)(p.ws + OFF_WIN), nullptr, true, gtid, gstride);
  transpose_w(p.w_uq, 384, 768, 768, (u16*)(p.ws + OFF_WUQ), p.q_norm_g, false, gtid, gstride);
  transpose_w(p.w_ukv, 256, 1024, 1024, (u16*)(p.ws + OFF_WUKV), nullptr, false, gtid, gstride);
  transpose_w(p.w_out, 1024, 1024, 1024, (u16*)(p.ws + OFF_WOUT), nullptr, false, gtid, gstride);
  {
    u16* ckv = (u16*)(p.ws + OFF_CKV);
    for (int e = gtid; e < 16 * PAST * 32; e += gstride) {
      const int c8 = e & 31, s = (e >> 5) & 4095, b = e >> 17;
      const f32x4* src = (const f32x4*)(p.cache_ckv + ((size_t)(b * PAST + s) * 256 + c8 * 8));
      const f32x4 a = src[0], c = src[1];
      u32x4 o = {pk2(a.x, a.y), pk2(a.z, a.w), pk2(c.x, c.y), pk2(c.z, c.w)};
      *(u32x4*)(ckv + ((size_t)(NTOK + b * PAST + s) * 256 + c8 * 8)) = o;
    }
    u16* kr = (u16*)(p.ws + OFF_KROPE);
    for (int e = gtid; e < 16 * PAST * 4; e += gstride) {
      const int c8 = e & 3, s = (e >> 2) & 4095, b = e >> 14;
      const f32x4* src = (const f32x4*)(p.cache_krope + ((size_t)(b * PAST + s) * 32 + c8 * 8));
      const f32x4 a = src[0], c = src[1];
      u32x4 o = {pk2(a.x, a.y), pk2(a.z, a.w), pk2(c.x, c.y), pk2(c.z, c.w)};
      *(u32x4*)(kr + ((size_t)(NTOK + b * PAST + s) * 32 + c8 * 8)) = o;
    }
  }
  {
    float* tab = (float*)(p.ws + OFF_ROPE);
    for (int e = gtid; e < 2112 * 16; e += gstride) {
      const int idx = e >> 4, i = e & 15;
      const int pos = idx < 2048 ? idx : PAST + (idx - 2048);
      const float inv = exp2f(-(float)i * (13.287712379549449f / 16.f));
      const float ang = (float)pos * inv;
      tab[idx * 32 + i] = cosf(ang);
      tab[idx * 32 + 16 + i] = sinf(ang);
    }
  }
}

DI void phase1(const P& p) {
  const int lane = threadIdx.x & 63, gw = blockIdx.x * 8 + (threadIdx.x >> 6), ngw = gridDim.x * 8;
  const float* mod = (const float*)(p.ws + OFF_MOD);
  u16* hb = (u16*)(p.ws + OFF_H);
  for (int row = gw; row < NTOK; row += ngw) {
    const float* xr; int bm;
    if (row < NTOK_P) { xr = p.x_prompt + (size_t)row * 1024; bm = row >> 11; }
    else { xr = p.x_sample + (size_t)(row - NTOK_P) * 1024; bm = 32 + ((row - NTOK_P) >> 6); }
    const f32x4* x4 = (const f32x4*)xr;
    const f32x4* sh4 = (const f32x4*)(mod + bm * 3072);
    const f32x4* sc4 = (const f32x4*)(mod + bm * 3072 + 1024);
    const f32x4* g4 = (const f32x4*)p.pre_g;
    f32x4 v[4]; float ss = 0.f;
#pragma unroll
    for (int j = 0; j < 4; ++j) { v[j] = x4[lane + 64 * j]; ss += v[j].x * v[j].x + v[j].y * v[j].y + v[j].z * v[j].z + v[j].w * v[j].w; }
    ss = wave_sum(ss);
    const float r = rsqrtf(ss * (1.f / 1024.f) + EPS);
#pragma unroll
    for (int j = 0; j < 4; ++j) {
      const int c4 = lane + 64 * j;
      const f32x4 g = g4[c4], sc = sc4[c4], sh = sh4[c4];
      const float o0 = v[j].x * r * g.x * (1.f + sc.x) + sh.x;
      const float o1 = v[j].y * r * g.y * (1.f + sc.y) + sh.y;
      const float o2 = v[j].z * r * g.z * (1.f + sc.z) + sh.z;
      const float o3 = v[j].w * r * g.w * (1.f + sc.w) + sh.w;
      u32x2 o = {pk2(o0, o1), pk2(o2, o3)};
      *(u32x2*)(hb + (size_t)row * 1024 + c4 * 4) = o;
    }
  }
}

#define LAS __attribute__((address_space(3)))
constexpr int BM = 256, BK = 64, HALF = 128, HTB = HALF * BK * 2, NXCD = 8, WGM = 8;
constexpr int XCH_OFF = 131072;
DI int lds_byte(int r, int c) { const int st = (r >> 4) * 2 + (c >> 5), rr = r & 15, cc = c & 31, ob = rr * 64 + cc * 2; return st * 1024 + (ob ^ (((ob >> 9) & 1) << 5)); }
DI void stage_rc(int b, int& R, int& C) { const int st = b / 1024, sb = b % 1024, swz = sb ^ (((sb >> 9) & 1) << 5); R = (st >> 1) * 16 + swz / 64; C = (st & 1) * 32 + (swz % 64) / 2; }
DI int perm32(int rho) { const int n = rho >> 4, i = rho & 15; return 8 * (i >> 2) + 4 * n + (i & 3); }

struct Unit { int pm, pn; };
struct StaticOrder {
  int nM, nN, nwg, G, c;
  DI void init(int M, int N, int G_, int c_) { nM = M / BM; nN = N / BM; nwg = nM * nN; G = G_; c = c_; }
  DI bool next(int i, Unit& u) const {
    const long L = (long)i * G + c; if (L >= nwg) return false;
    int wgid = (int)L; { const int q = nwg / NXCD, r = nwg % NXCD, xcd = wgid % NXCD, off = wgid / NXCD; wgid = (xcd < r ? xcd * (q + 1) : r * (q + 1) + (xcd - r) * q) + off; }
    const int nig = WGM * nN, gid = wgid / nig, fm = gid * WGM, gsz = (nM - fm) < WGM ? (nM - fm) : WGM;
    u.pm = fm + ((wgid % nig) % gsz); u.pn = (wgid % nig) / gsz; return true;
  }
};

typedef f32x4 acc_t[2][2][4][2];
template <class Epi>
DI void gemm_phase(LAS unsigned char* lds, const u16* Ag, const u16* Btg, const int K, const StaticOrder& S, const Epi& E) {
  int tid = threadIdx.x; asm volatile("" : "+v"(tid));
  const int wid = __builtin_amdgcn_readfirstlane(tid >> 6), lane = tid & 63, wr = wid >> 2, wc = wid & 3, fr = lane & 15, fq = lane >> 4;
  const int nt = K / BK;
  unsigned voffA[2], voffB[2];
#pragma unroll
  for (int i = 0; i < 2; ++i) { int R, C; stage_rc(tid * 16 + i * 8192, R, C); const int Rb = Epi::PERM ? ((R & ~31) + perm32(R & 31)) : R;
    voffA[i] = (unsigned)(R * K + C) * 2u; voffB[i] = (unsigned)(Rb * K + C) * 2u; }
  const size_t kstep = (size_t)(BK * 2);
  const size_t hstep = (size_t)HALF * K * 2;
  const size_t tstep = 2 * hstep;
  const unsigned ldsw = (unsigned)wid * 1024u;
  const int aoff = lds_byte(wr * 64 + fr, fq * 8), boff = lds_byte(wc * 32 + fr, fq * 8);
#define PG8_SA(b, h) (((b) * 2 + (h)) * HTB)
#define PG8_SB(b, h) ((4 + (b) * 2 + (h)) * HTB)
#define PG8_STAGE(bufoff, gbase, voff) do { _Pragma("unroll") for (int _i = 0; _i < 2; ++_i) \
    __builtin_amdgcn_global_load_lds((const unsigned*)((const char*)(gbase) + (voff)[_i]), (LAS unsigned*)(lds + (bufoff) + ldsw + _i * 8192), 16, 0, 0); } while (0)
#define PG8_LDA(dst, b, h) do { _Pragma("unroll") for (int m = 0; m < 4; ++m) _Pragma("unroll") for (int k = 0; k < 2; ++k) dst[m][k] = *(const LAS bf16x8*)(lds + PG8_SA(b, h) + aoff + m * 2048 + k * 1024); } while (0)
#define PG8_LDB(dst, b, h) do { _Pragma("unroll") for (int n = 0; n < 2; ++n) _Pragma("unroll") for (int k = 0; k < 2; ++k) dst[n][k] = *(const LAS bf16x8*)(lds + PG8_SB(b, h) + boff + n * 2048 + k * 1024); } while (0)
#define PG8_MMA(ai, bj, At, Bt) do { __builtin_amdgcn_s_setprio(1); _Pragma("unroll") for (int m = 0; m < 4; ++m) _Pragma("unroll") for (int n = 0; n < 2; ++n) _Pragma("unroll") for (int k = 0; k < 2; ++k) \
    acc[ai][bj][m][n] = __builtin_amdgcn_mfma_f32_16x16x32_bf16(Bt[n][k], At[m][k], acc[ai][bj][m][n], 0, 0, 0); __builtin_amdgcn_s_setprio(0); } while (0)
#define PG8_WAIT_V(n) asm volatile("s_waitcnt vmcnt(" #n ")" ::: "memory")
#define PG8_WAIT_L(n) asm volatile("s_waitcnt lgkmcnt(" #n ")" ::: "memory")
#define PG8_BAR __builtin_amdgcn_s_barrier()
#define PG8_SCHED __builtin_amdgcn_sched_barrier(0)
  Unit cur, nxt; int ui = 0;
  if (!S.next(0, cur)) return;
  f32x4 acc[2][2][4][2];
#pragma unroll
  for (int a = 0; a < 2; ++a)
#pragma unroll
    for (int b = 0; b < 2; ++b)
#pragma unroll
      for (int m = 0; m < 4; ++m)
#pragma unroll
        for (int n = 0; n < 2; ++n) acc[a][b][m][n] = (f32x4){0.f, 0.f, 0.f, 0.f};
  bf16x8 At[4][2], B0[2][2], B1[2][2];
  const char* cA = (const char*)Ag + (size_t)cur.pm * tstep; const char* cB = (const char*)Btg + (size_t)cur.pn * tstep;
  PG8_STAGE(PG8_SB(0, 0), cB, voffB); PG8_STAGE(PG8_SA(0, 0), cA, voffA); PG8_STAGE(PG8_SB(0, 1), cB + hstep, voffB); PG8_STAGE(PG8_SA(0, 1), cA + hstep, voffA);
  if (wr == 1) PG8_BAR;
  PG8_WAIT_V(4); PG8_BAR;
  PG8_STAGE(PG8_SB(1, 0), cB + kstep, voffB); PG8_STAGE(PG8_SA(1, 0), cA + kstep, voffA); PG8_STAGE(PG8_SB(1, 1), cB + hstep + kstep, voffB);
  PG8_WAIT_V(6); PG8_BAR;
  for (;;) {
    const bool has_next = S.next(ui + 1, nxt);
    const char* nA = has_next ? (const char*)Ag + (size_t)nxt.pm * tstep : cA; const char* nB = has_next ? (const char*)Btg + (size_t)nxt.pn * tstep : cB;
#pragma unroll 1
    for (int t = 0; t < nt; t += 2) {
      const bool last = (t == nt - 2);
      const char* a1 = cA + (size_t)(t + 1) * kstep;
      const char* a2 = last ? nA : cA + (size_t)(t + 2) * kstep; const char* b2 = last ? nB : cB + (size_t)(t + 2) * kstep;
      const char* a3 = a2 + kstep; const char* b3 = b2 + kstep;
      PG8_LDB(B0, 0, 0); PG8_SCHED; PG8_LDA(At, 0, 0); PG8_STAGE(PG8_SA(1, 1), a1 + hstep, voffA);
      PG8_WAIT_L(8); PG8_BAR; PG8_WAIT_L(0); PG8_MMA(0, 0, At, B0); PG8_BAR; PG8_SCHED;
      PG8_LDB(B1, 0, 1); PG8_STAGE(PG8_SB(0, 0), b2, voffB);
      PG8_BAR; PG8_WAIT_L(0); PG8_MMA(0, 1, At, B1); PG8_BAR;
      PG8_LDA(At, 0, 1); PG8_STAGE(PG8_SA(0, 0), a2, voffA);
      PG8_BAR; PG8_WAIT_L(0); PG8_MMA(1, 0, At, B0); PG8_BAR; PG8_SCHED;
      PG8_STAGE(PG8_SB(0, 1), b2 + hstep, voffB);
      PG8_WAIT_V(6); PG8_BAR; PG8_MMA(1, 1, At, B1); PG8_BAR;
      PG8_LDB(B0, 1, 0); PG8_SCHED; PG8_LDA(At, 1, 0); PG8_STAGE(PG8_SA(0, 1), a2 + hstep, voffA);
      PG8_WAIT_L(8); PG8_BAR; PG8_WAIT_L(0); PG8_MMA(0, 0, At, B0); PG8_BAR; PG8_SCHED;
      PG8_LDB(B1, 1, 1); PG8_STAGE(PG8_SB(1, 0), b3, voffB);
      PG8_BAR; PG8_WAIT_L(0); PG8_MMA(0, 1, At, B1); PG8_BAR;
      PG8_LDA(At, 1, 1); PG8_STAGE(PG8_SA(1, 0), a3, voffA);
      PG8_BAR; PG8_WAIT_L(0); PG8_MMA(1, 0, At, B0); PG8_BAR; PG8_SCHED;
      PG8_STAGE(PG8_SB(1, 1), b3 + hstep, voffB);
      PG8_WAIT_V(6); PG8_BAR; PG8_MMA(1, 1, At, B1); PG8_BAR;
    }
    E(acc, cur, wr, wc, fr, fq);
    if (!has_next) break;
#pragma unroll
    for (int a = 0; a < 2; ++a)
#pragma unroll
      for (int b = 0; b < 2; ++b)
#pragma unroll
        for (int m = 0; m < 4; ++m)
#pragma unroll
          for (int n = 0; n < 2; ++n) acc[a][b][m][n] = (f32x4){0.f, 0.f, 0.f, 0.f};
    cur = nxt; cA = nA; cB = nB; ++ui;
  }
  PG8_WAIT_V(0);
  if (wr == 0) PG8_BAR;
  PG8_BAR;
#undef PG8_SA
#undef PG8_SB
#undef PG8_STAGE
#undef PG8_LDA
#undef PG8_LDB
#undef PG8_MMA
#undef PG8_WAIT_V
#undef PG8_WAIT_L
#undef PG8_BAR
#undef PG8_SCHED
}

DI u32x4 pack8(const f32x4 a, const f32x4 b) { return (u32x4){pk2(a.x, a.y), pk2(a.z, a.w), pk2(b.x, b.y), pk2(b.z, b.w)}; }
DI float sq4(const f32x4 a) { return (a.x * a.x + a.y * a.y) + (a.z * a.z + a.w * a.w); }

DI void rowsum_xch(float (&ss)[2][4], LAS float* xch, int wr, int wc, int fr, int fq) {
#pragma unroll
  for (int ai = 0; ai < 2; ++ai)
#pragma unroll
    for (int m = 0; m < 4; ++m) { float s = ss[ai][m]; s += __shfl_xor(s, 16); s += __shfl_xor(s, 32); ss[ai][m] = s; }
  if (fq == 0) {
#pragma unroll
    for (int ai = 0; ai < 2; ++ai)
#pragma unroll
      for (int m = 0; m < 4; ++m) xch[(128 * ai + 64 * wr + 16 * m + fr) * 4 + wc] = ss[ai][m];
  }
  __syncthreads();
#pragma unroll
  for (int ai = 0; ai < 2; ++ai)
#pragma unroll
    for (int m = 0; m < 4; ++m) { const f32x4 t = *(const LAS f32x4*)(xch + (128 * ai + 64 * wr + 16 * m + fr) * 4); ss[ai][m] = (t.x + t.y) + (t.z + t.w); }
}

struct EpiG1 {
  static constexpr bool PERM = true;
  P p; LAS unsigned char* lds;
  DI void operator()(const acc_t& acc, const Unit& u, int, int, int, int) const {
    int t_ = threadIdx.x; asm volatile("" : "+v"(t_));
    const int wid_ = __builtin_amdgcn_readfirstlane(t_ >> 6), wr = wid_ >> 2, wc = wid_ & 3, fr = t_ & 15, fq = (t_ >> 4) & 3;
    char* ws_ = p.ws; float* out_ = p.out; asm volatile("" : "+s"(ws_), "+s"(out_));
    (void)out_;
    const int nt = u.pn;
    const bool samp = u.pm >= 256;
    const int row0 = u.pm * 256 + wr * 64 + fr;
    const int rl0 = samp ? row0 - NTOK_P : row0;
    const int c8 = wc * 32 + 8 * fq;
    if (nt < 2) {
      u16* base = (u16*)(ws_ + OFF_SBQ) + nt * 256 + c8;
#pragma unroll
      for (int ai = 0; ai < 2; ++ai)
#pragma unroll
        for (int m = 0; m < 4; ++m) { u16* rp = base + (size_t)(row0 + ai * 128 + m * 16) * 512;
#pragma unroll
          for (int bj = 0; bj < 2; ++bj) *(u32x4*)(rp + bj * 128) = pack8(acc[ai][bj][m][0] * QS_SB, acc[ai][bj][m][1] * QS_SB); }
    } else if (nt < 6) {
      const bool isv = nt >= 4;
      const int cb = (nt & 1) * 256 + c8;
      float* ofb = out_ + (samp ? (isv ? O_SVS : O_SKS) : (isv ? O_SVP : O_SKP)) + cb;
      u16* base = (u16*)(ws_ + (isv ? OFF_SBV : OFF_SBK)) + cb;
#pragma unroll
      for (int ai = 0; ai < 2; ++ai)
#pragma unroll
        for (int m = 0; m < 4; ++m) { u16* rp = base + (size_t)(row0 + ai * 128 + m * 16) * 512; float* of = ofb + (size_t)(rl0 + ai * 128 + m * 16) * 512;
#pragma unroll
          for (int bj = 0; bj < 2; ++bj) { *(f32x4*)(of + bj * 128) = acc[ai][bj][m][0]; *(f32x4*)(of + bj * 128 + 4) = acc[ai][bj][m][1];
            *(u32x4*)(rp + bj * 128) = pack8(acc[ai][bj][m][0], acc[ai][bj][m][1]); } }
    } else if (nt < 8 || nt >= 11) {
      const int cb = (nt < 8 ? (nt - 6) * 256 : 512 + (nt - 11) * 256) + c8;
      u16* base = (u16*)(ws_ + OFF_GATES) + cb;
#pragma unroll
      for (int ai = 0; ai < 2; ++ai)
#pragma unroll
        for (int m = 0; m < 4; ++m) { u16* rp = base + (size_t)(row0 + ai * 128 + m * 16) * 1024;
#pragma unroll
          for (int bj = 0; bj < 2; ++bj) { f32x4 a = acc[ai][bj][m][0], b = acc[ai][bj][m][1];
            a.x = silu_f(a.x); a.y = silu_f(a.y); a.z = silu_f(a.z); a.w = silu_f(a.w); b.x = silu_f(b.x); b.y = silu_f(b.y); b.z = silu_f(b.z); b.w = silu_f(b.w);
            *(u32x4*)(rp + bj * 128) = pack8(a, b); } }
    } else if (nt == 8 || nt == 9) {
      const int part = nt - 8;
      float ss[2][4];
#pragma unroll
      for (int ai = 0; ai < 2; ++ai)
#pragma unroll
        for (int m = 0; m < 4; ++m) { float s = sq4(acc[ai][0][m][0]) + sq4(acc[ai][0][m][1]); if (part == 0) s += sq4(acc[ai][1][m][0]) + sq4(acc[ai][1][m][1]); ss[ai][m] = s; }
      rowsum_xch(ss, (LAS float*)(lds + XCH_OFF), wr, wc, fr, fq);
      float* cqss = (float*)(ws_ + OFF_CQSS) + (size_t)part * NTOK;
      if (wc == 0 && fq == 0) {
#pragma unroll
        for (int ai = 0; ai < 2; ++ai)
#pragma unroll
          for (int m = 0; m < 4; ++m) cqss[row0 + ai * 128 + m * 16] = ss[ai][m];
      }
      u16* base = (u16*)(ws_ + OFF_CQ) + part * 256 + c8;
#pragma unroll
      for (int ai = 0; ai < 2; ++ai)
#pragma unroll
        for (int m = 0; m < 4; ++m) { u16* rp = base + (size_t)(row0 + ai * 128 + m * 16) * 384;
          *(u32x4*)(rp) = pack8(acc[ai][0][m][0], acc[ai][0][m][1]);
          if (part == 0) *(u32x4*)(rp + 128) = pack8(acc[ai][1][m][0], acc[ai][1][m][1]); }
      if (part == 1 && wc == 0) {
        const float* tab = (const float*)(ws_ + OFF_ROPE);
        float* okr = out_ + (samp ? O_KRS : O_KRP);
        u16* kr = (u16*)(ws_ + OFF_KROPE);
        const int i0 = (8 * fq) & 15;
#pragma unroll
        for (int ai = 0; ai < 2; ++ai)
#pragma unroll
          for (int m = 0; m < 4; ++m) {
            const int row = row0 + ai * 128 + m * 16, rl = rl0 + ai * 128 + m * 16;
            const int ridx = samp ? 2048 + (rl & 63) : (rl & 2047);
            f32x4 o[2];
#pragma unroll
            for (int n = 0; n < 2; ++n) {
              const f32x4 cs = *(const f32x4*)(tab + ridx * 32 + i0 + 4 * n), sn = *(const f32x4*)(tab + ridx * 32 + 16 + i0 + 4 * n);
              const f32x4 mine = acc[ai][1][m][n];
              f32x4 oth; oth.x = __shfl_xor(mine.x, 32); oth.y = __shfl_xor(mine.y, 32); oth.z = __shfl_xor(mine.z, 32); oth.w = __shfl_xor(mine.w, 32);
              o[n] = (fq < 2) ? (mine * cs - oth * sn) : (mine * cs + oth * sn);
            }
            *(f32x4*)(okr + (size_t)rl * 32 + 8 * fq) = o[0]; *(f32x4*)(okr + (size_t)rl * 32 + 8 * fq + 4) = o[1];
            *(u32x4*)(kr + (size_t)row * 32 + 8 * fq) = pack8(o[0], o[1]);
          }
      }
    } else {
      float ss[2][4];
#pragma unroll
      for (int ai = 0; ai < 2; ++ai)
#pragma unroll
        for (int m = 0; m < 4; ++m) ss[ai][m] = (sq4(acc[ai][0][m][0]) + sq4(acc[ai][0][m][1])) + (sq4(acc[ai][1][m][0]) + sq4(acc[ai][1][m][1]));
      rowsum_xch(ss, (LAS float*)(lds + XCH_OFF), wr, wc, fr, fq);
      float* ofb = out_ + (samp ? O_CKVS : O_CKVP) + c8;
      u16* base = (u16*)(ws_ + OFF_CKV) + c8;
      f32x4 gv[2][2];
#pragma unroll
      for (int bj = 0; bj < 2; ++bj)
#pragma unroll
        for (int n = 0; n < 2; ++n) gv[bj][n] = *(const f32x4*)(p.kv_norm_g + bj * 128 + c8 + 4 * n);
#pragma unroll
      for (int ai = 0; ai < 2; ++ai)
#pragma unroll
        for (int m = 0; m < 4; ++m) {
          const float r = rsqrtf(ss[ai][m] * (1.f / 256.f) + EPS);
          float* of = ofb + (size_t)(rl0 + ai * 128 + m * 16) * 256; u16* rp = base + (size_t)(row0 + ai * 128 + m * 16) * 256;
#pragma unroll
          for (int bj = 0; bj < 2; ++bj) {
            const f32x4 a = acc[ai][bj][m][0] * r * gv[bj][0], b = acc[ai][bj][m][1] * r * gv[bj][1];
            *(f32x4*)(of + bj * 128) = a; *(f32x4*)(of + bj * 128 + 4) = b;
            *(u32x4*)(rp + bj * 128) = pack8(a, b);
          }
        }
    }
  }
};

struct EpiG2 {
  static constexpr bool PERM = false;
  P p;
  DI void operator()(const acc_t& acc, const Unit& u, int, int, int, int) const {
    int t_ = threadIdx.x; asm volatile("" : "+v"(t_));
    const int wid_ = __builtin_amdgcn_readfirstlane(t_ >> 6), wr = wid_ >> 2, wc = wid_ & 3, fr = t_ & 15, fq = (t_ >> 4) & 3;
    char* ws_ = p.ws; float* out_ = p.out; asm volatile("" : "+s"(ws_), "+s"(out_));
    (void)out_;
    const bool samp = u.pm >= 256;
    const int row0 = u.pm * 256 + wr * 64 + fr;
    const float* cqss = (const float*)(ws_ + OFF_CQSS);
    const float* tab = (const float*)(ws_ + OFF_ROPE);
    u16* dst = (u16*)(ws_ + OFF_QMLA);
#pragma unroll
    for (int ai = 0; ai < 2; ++ai)
#pragma unroll
      for (int m = 0; m < 4; ++m) {
        const int row = row0 + ai * 128 + m * 16;
        const float r = rsqrtf((cqss[row] + cqss[NTOK + row]) * (1.f / 384.f) + EPS) * QS_MLA;
        const int ridx = samp ? 2048 + ((row - NTOK_P) & 63) : (row & 2047);
#pragma unroll
        for (int bj = 0; bj < 2; ++bj) {
          const int gi = u.pn * 8 + bj * 4 + wc;
          f32x4 x1 = acc[ai][bj][m][0] * r, x2 = acc[ai][bj][m][1] * r;
          if (gi % 3 == 2) {
            const f32x4 cs = *(const f32x4*)(tab + ridx * 32 + 4 * fq), sn = *(const f32x4*)(tab + ridx * 32 + 16 + 4 * fq);
            const f32x4 o1 = x1 * cs - x2 * sn, o2 = x2 * cs + x1 * sn;
            x1 = o1; x2 = o2;
          }
          u16* rp = dst + (size_t)row * 768 + gi * 32 + 4 * fq;
          *(u32x2*)(rp) = (u32x2){pk2(x1.x, x1.y), pk2(x1.z, x1.w)};
          *(u32x2*)(rp + 16) = (u32x2){pk2(x2.x, x2.y), pk2(x2.z, x2.w)};
        }
        __builtin_amdgcn_sched_barrier(0);
      }
  }
};

struct EpiG3 {
  static constexpr bool PERM = true;
  P p;
  DI void operator()(const acc_t& acc, const Unit& u, int, int, int, int) const {
    int t_ = threadIdx.x; asm volatile("" : "+v"(t_));
    const int wid_ = __builtin_amdgcn_readfirstlane(t_ >> 6), wr = wid_ >> 2, wc = wid_ & 3, fr = t_ & 15, fq = (t_ >> 4) & 3;
    char* ws_ = p.ws; float* out_ = p.out; asm volatile("" : "+s"(ws_), "+s"(out_));
    (void)out_;
    u16* base = (u16*)(ws_ + OFF_KV) + u.pn * 256 + wc * 32 + 8 * fq;
    const int row0 = u.pm * 256 + wr * 64 + fr;
#pragma unroll
    for (int ai = 0; ai < 2; ++ai)
#pragma unroll
      for (int m = 0; m < 4; ++m) { u16* rp = base + (size_t)(row0 + ai * 128 + m * 16) * 1024;
#pragma unroll
        for (int bj = 0; bj < 2; ++bj) *(u32x4*)(rp + bj * 128) = pack8(acc[ai][bj][m][0], acc[ai][bj][m][1]); }
  }
};

struct EpiG4 {
  static constexpr bool PERM = true;
  P p; LAS unsigned char* lds;
  DI void operator()(const acc_t& acc, const Unit& u, int, int, int, int) const {
    int t_ = threadIdx.x; asm volatile("" : "+v"(t_));
    const int wid_ = __builtin_amdgcn_readfirstlane(t_ >> 6), wr = wid_ >> 2, wc = wid_ & 3, fr = t_ & 15, fq = (t_ >> 4) & 3;
    char* ws_ = p.ws; float* out_ = p.out; asm volatile("" : "+s"(ws_), "+s"(out_));
    (void)out_;
    const int row0 = u.pm * 256 + wr * 64 + fr;
    float ss[2][4];
#pragma unroll
    for (int ai = 0; ai < 2; ++ai)
#pragma unroll
      for (int m = 0; m < 4; ++m) ss[ai][m] = (sq4(acc[ai][0][m][0]) + sq4(acc[ai][0][m][1])) + (sq4(acc[ai][1][m][0]) + sq4(acc[ai][1][m][1]));
    rowsum_xch(ss, (LAS float*)(lds + XCH_OFF), wr, wc, fr, fq);
    float* rss = (float*)(ws_ + OFF_ROWSS) + (size_t)u.pn * NTOK;
    if (wc == 0 && fq == 0) {
#pragma unroll
      for (int ai = 0; ai < 2; ++ai)
#pragma unroll
        for (int m = 0; m < 4; ++m) rss[row0 + ai * 128 + m * 16] = ss[ai][m];
    }
    u16* base = (u16*)(ws_ + OFF_GATES) + u.pn * 256 + wc * 32 + 8 * fq;
#pragma unroll
    for (int ai = 0; ai < 2; ++ai)
#pragma unroll
      for (int m = 0; m < 4; ++m) { u16* rp = base + (size_t)(row0 + ai * 128 + m * 16) * 1024;
#pragma unroll
        for (int bj = 0; bj < 2; ++bj) *(u32x4*)(rp + bj * 128) = pack8(acc[ai][bj][m][0], acc[ai][bj][m][1]); }
  }
};

DI void gemm_g1(const P& p, char* smem) {
  StaticOrder S; S.init(NTOK, NPAD, gridDim.x, blockIdx.x);
  EpiG1 E{p, (LAS unsigned char*)smem};
  gemm_phase((LAS unsigned char*)smem, (const u16*)(p.ws + OFF_H), (const u16*)(p.ws + OFF_WIN), 1024, S, E);
}
DI void gemm_g23(const P& p, char* smem) {
  { StaticOrder S; S.init(NTOK, 768, gridDim.x, blockIdx.x);
    EpiG2 E{p};
    gemm_phase((LAS unsigned char*)smem, (const u16*)(p.ws + OFF_CQ), (const u16*)(p.ws + OFF_WUQ), 384, S, E); }
  { StaticOrder S; S.init(NKV, 1024, gridDim.x, (blockIdx.x + 128) % gridDim.x);
    EpiG3 E{p};
    gemm_phase((LAS unsigned char*)smem, (const u16*)(p.ws + OFF_CKV), (const u16*)(p.ws + OFF_WUKV), 256, S, E); }
}
DI void gemm_g4(const P& p, char* smem) {
  StaticOrder S; S.init(NTOK, 1024, gridDim.x, blockIdx.x);
  EpiG4 E{p, (LAS unsigned char*)smem};
  gemm_phase((LAS unsigned char*)smem, (const u16*)(p.ws + OFF_H), (const u16*)(p.ws + OFF_WOUT), 1024, S, E);
}

constexpr int KS_SB = 144, KS_MLA = 208, VS = 144;
constexpr int MLA_STAGE = 64 * KS_MLA + 64 * VS;
constexpr int SB_STAGE = 64 * KS_SB + 64 * VS;
constexpr int FLAG_OFF = 49152;

DI void pv_step(const char* Vt, const bf16x8 (&pb)[4], f32x16 (&o)[2], int lane) {
  const int lh = lane >> 5, q4 = (lane & 15) >> 2, p4 = lane & 3, g1 = (lane >> 4) & 1;
  const char* vb = Vt + (4 * lh + q4) * VS + 32 * g1 + 8 * p4;
#pragma unroll
  for (int ks = 0; ks < 4; ++ks) {
#pragma unroll
    for (int dvt = 0; dvt < 2; ++dvt) {
      const s16x4 lo = tr_read(vb + (ks * 16) * VS + dvt * 64);
      const s16x4 hi = tr_read(vb + (ks * 16 + 8) * VS + dvt * 64);
      const bf16x8 vf = __builtin_shufflevector(lo, hi, 0, 1, 2, 3, 4, 5, 6, 7);
      o[dvt] = MFMA32(vf, pb[ks], o[dvt]);
    }
  }
}

DI void pack_p(const f32x16 (&s)[2], bf16x8 (&pb)[4]) {
#pragma unroll
  for (int mt = 0; mt < 2; ++mt)
#pragma unroll
    for (int h = 0; h < 2; ++h) {
      u32x4 t = {pk2(s[mt][8 * h + 0], s[mt][8 * h + 1]), pk2(s[mt][8 * h + 2], s[mt][8 * h + 3]),
                 pk2(s[mt][8 * h + 4], s[mt][8 * h + 5]), pk2(s[mt][8 * h + 6], s[mt][8 * h + 7])};
      pb[mt * 2 + h] = __builtin_bit_cast(bf16x8, t);
    }
}

DI void store_o(const P& p, const f32x16 (&o)[2], float inv, size_t tok, int colbase, int lh) {
  const u16* gates = (const u16*)(p.ws + OFF_GATES);
  u16* mixed = (u16*)(p.ws + OFF_H);
#pragma unroll
  for (int dvt = 0; dvt < 2; ++dvt)
#pragma unroll
    for (int g = 0; g < 4; ++g) {
      const size_t off = tok * 1024 + colbase + dvt * 32 + g * 8 + lh * 4;
      const u32x2 gt = *(const u32x2*)(gates + off);
      u32x2 ov = {pk2(o[dvt][4 * g + 0] * inv * bflo(gt.x), o[dvt][4 * g + 1] * inv * bfhi(gt.x)),
                  pk2(o[dvt][4 * g + 2] * inv * bflo(gt.y), o[dvt][4 * g + 3] * inv * bfhi(gt.y))};
      *(u32x2*)(mixed + off) = ov;
    }
}

DI void mla_item(const P& p, char* smem, int b, int hd, int q0, bool samp) {
  const int tid = threadIdx.x, w = tid >> 6, lane = tid & 63, l32 = lane & 31, lh = lane >> 5;
  const int nq = samp ? 64 : 256;
  const bool active = (w * 32 < nq);
  const int qw0 = q0 + w * 32;
  const size_t tokrow0 = samp ? (size_t)(NTOK_P + b * 64) : (size_t)b * 2048;
  const int nkb_blk = samp ? 65 : (q0 / 64 + 4);
  const int nkb_w = samp ? 65 : (qw0 / 64 + 1);
  const u16* kv = (const u16*)(p.ws + OFF_KV);
  const u16* krope = (const u16*)(p.ws + OFF_KROPE);
  bf16x8 qf[6];
  if (active) {
    const u16* qp = (const u16*)(p.ws + OFF_QMLA) + (tokrow0 + qw0 + l32) * 768 + hd * 96 + lh * 8;
#pragma unroll
    for (int ks = 0; ks < 6; ++ks) qf[ks] = *(const bf16x8*)(qp + ks * 16);
  } else {
#pragma unroll
    for (int ks = 0; ks < 6; ++ks) qf[ks] = (bf16x8){0, 0, 0, 0, 0, 0, 0, 0};
  }
  u32x4 rkn, rvv, rkr;
  rkr = (u32x4){0, 0, 0, 0};
  auto gload = [&](int kb) {
    const size_t trow0 = samp ? (kb < 64 ? (size_t)(NTOK + b * PAST + kb * 64) : (size_t)(NTOK_P + b * 64)) : (size_t)(b * 2048 + kb * 64);
    const size_t row = trow0 + (tid >> 3);
    const u16* base = kv + row * 1024 + hd * 128 + (tid & 7) * 8;
    rkn = *(const u32x4*)base;
    rvv = *(const u32x4*)(base + 64);
    if (tid < 256) rkr = *(const u32x4*)(krope + (trow0 + (tid >> 2)) * 32 + (tid & 3) * 8);
  };
  auto lstore = [&](int buf) {
    char* Kt = smem + buf * MLA_STAGE; char* Vt = Kt + 64 * KS_MLA;
    *(u32x4*)(Kt + (tid >> 3) * KS_MLA + (tid & 7) * 16) = rkn;
    *(u32x4*)(Vt + (tid >> 3) * VS + (tid & 7) * 16) = rvv;
    if (tid < 256) *(u32x4*)(Kt + (tid >> 2) * KS_MLA + 128 + (tid & 3) * 16) = rkr;
  };
  f32x16 o[2];
#pragma unroll
  for (int i = 0; i < 16; ++i) { o[0][i] = 0.f; o[1][i] = 0.f; }
  float mrun = -1e30f, lsum = 0.f;
  gload(0); lstore(0);
  __syncthreads();
  for (int kb = 0; kb < nkb_blk; ++kb) {
    const bool has_next = kb + 1 < nkb_blk;
    if (has_next) gload(kb + 1);
    if (active && kb < nkb_w) {
      const char* Kt = smem + (kb & 1) * MLA_STAGE; const char* Vt = Kt + 64 * KS_MLA;
      f32x16 s[2];
#pragma unroll
      for (int i = 0; i < 16; ++i) { s[0][i] = 0.f; s[1][i] = 0.f; }
      const char* kp = Kt + l32 * KS_MLA + lh * 16;
#pragma unroll
      for (int ks = 0; ks < 6; ++ks) {
        const bf16x8 a0 = *(const bf16x8*)(kp + ks * 32);
        const bf16x8 a1 = *(const bf16x8*)(kp + 32 * KS_MLA + ks * 32);
        s[0] = MFMA32(a0, qf[ks], s[0]);
        s[1] = MFMA32(a1, qf[ks], s[1]);
      }
      float mx = s[0][0];
#pragma unroll
      for (int i = 1; i < 16; ++i) mx = fmaxf(mx, s[0][i]);
#pragma unroll
      for (int i = 0; i < 16; ++i) mx = fmaxf(mx, s[1][i]);
      mx = fmaxf(mx, __shfl_xor(mx, 32));
      const float mn = fmaxf(mrun, mx);
      const float alpha = ex2(mrun - mn);
      mrun = mn;
      float ps = 0.f;
#pragma unroll
      for (int i = 0; i < 16; ++i) { s[0][i] = ex2(s[0][i] - mn); s[1][i] = ex2(s[1][i] - mn); ps += s[0][i] + s[1][i]; }
      lsum = lsum * alpha + ps;
#pragma unroll
      for (int i = 0; i < 16; ++i) { o[0][i] *= alpha; o[1][i] *= alpha; }
      bf16x8 pb[4];
      pack_p(s, pb);
      pv_step(Vt, pb, o, lane);
    }
    if (has_next) lstore((kb + 1) & 1);
    __syncthreads();
  }
  if (active) {
    const float lt = lsum + __shfl_xor(lsum, 32);
    store_o(p, o, 1.f / lt, tokrow0 + qw0 + l32, 512 + hd * 64, lh);
  }
}

DI void sb_item(const P& p, char* smem, int b, int hd, int q0, bool samp) {
  const int tid = threadIdx.x, w = tid >> 6, lane = tid & 63, l32 = lane & 31, lh = lane >> 5;
  const int nq = samp ? 64 : 256;
  const bool active = (w * 32 < nq);
  const int qw0 = q0 + w * 32;
  const int qpos_w0 = samp ? PAST + qw0 : qw0;
  const size_t tokrow0 = samp ? (size_t)(NTOK_P + b * 64) : (size_t)b * 2048;
  const int kb_hi = samp ? 64 : (q0 / 64 + 3);
  const u16* sbk = (const u16*)(p.ws + OFF_SBK);
  const u16* sbv = (const u16*)(p.ws + OFF_SBV);
  int* flags = (int*)(smem + FLAG_OFF);
  bf16x8 qf[4];
  if (active) {
    const u16* qp = (const u16*)(p.ws + OFF_SBQ) + (tokrow0 + qw0 + l32) * 512 + hd * 64 + lh * 8;
#pragma unroll
    for (int ks = 0; ks < 4; ++ks) qf[ks] = *(const bf16x8*)(qp + ks * 16);
  } else {
#pragma unroll
    for (int ks = 0; ks < 4; ++ks) qf[ks] = (bf16x8){0, 0, 0, 0, 0, 0, 0, 0};
  }
  f32x4 fk0, fk1, fv0, fv1;
  fk0 = fk1 = fv0 = fv1 = (f32x4){0.f, 0.f, 0.f, 0.f};
  auto gload = [&](int kb) {
    const int r = tid >> 3, c = tid & 7;
    if (samp && kb < 64) {
      const size_t off = ((size_t)(b * PAST + kb * 64 + r) * 8 + hd) * 64 + c * 8;
      const f32x4* ks = (const f32x4*)(p.cache_sb_k + off);
      const f32x4* vs = (const f32x4*)(p.cache_sb_v + off);
      fk0 = ks[0]; fk1 = ks[1]; fv0 = vs[0]; fv1 = vs[1];
    } else {
      const size_t row = samp ? (size_t)(NTOK_P + b * 64 + r) : (size_t)b * 2048 + (size_t)kb * 64 + r;
      fk0 = *(const f32x4*)(sbk + row * 512 + hd * 64 + c * 8);
      fv0 = *(const f32x4*)(sbv + row * 512 + hd * 64 + c * 8);
    }
  };
  auto lstore = [&](int buf, int kb) {
    char* Kt = smem + buf * SB_STAGE; char* Vt = Kt + 64 * KS_SB;
    const int r = tid >> 3, c = tid & 7;
    if (samp && kb < 64) {
      u32x4 k = {pk2(fk0.x, fk0.y), pk2(fk0.z, fk0.w), pk2(fk1.x, fk1.y), pk2(fk1.z, fk1.w)};
      u32x4 v = {pk2(fv0.x, fv0.y), pk2(fv0.z, fv0.w), pk2(fv1.x, fv1.y), pk2(fv1.z, fv1.w)};
      *(u32x4*)(Kt + r * KS_SB + c * 16) = k;
      *(u32x4*)(Vt + r * VS + c * 16) = v;
    } else {
      *(f32x4*)(Kt + r * KS_SB + c * 16) = fk0;
      *(f32x4*)(Vt + r * VS + c * 16) = fv0;
    }
  };
  f32x16 o[2];
#pragma unroll
  for (int i = 0; i < 16; ++i) { o[0][i] = 0.f; o[1][i] = 0.f; }
  float T = 0.f;
  bool done = false;
  gload(kb_hi); lstore(0, kb_hi);
  __syncthreads();
  int kb = kb_hi, it = 0;
  for (;;) {
    const bool has_next = kb > 0;
    if (has_next) gload(kb - 1);
    if (active && !done && (kb * 64 <= qpos_w0 + 30)) {
      const char* Kt = smem + (it & 1) * SB_STAGE; const char* Vt = Kt + 64 * KS_SB;
      f32x16 s[2];
#pragma unroll
      for (int i = 0; i < 16; ++i) { s[0][i] = 0.f; s[1][i] = 0.f; }
      const char* kp = Kt + l32 * KS_SB + lh * 16;
#pragma unroll
      for (int ks = 0; ks < 4; ++ks) {
        const bf16x8 a0 = *(const bf16x8*)(kp + ks * 32);
        const bf16x8 a1 = *(const bf16x8*)(kp + 32 * KS_SB + ks * 32);
        s[0] = MFMA32(a0, qf[ks], s[0]);
        s[1] = MFMA32(a1, qf[ks], s[1]);
      }
      const int qpos = qpos_w0 + l32;
      const int kt0 = kb * 64 + lh * 4;
      const bool diag = (kb * 64 + 63 >= qpos_w0);
      f32x16 lr[2];
#pragma unroll
      for (int mt = 0; mt < 2; ++mt)
#pragma unroll
        for (int i = 0; i < 16; ++i) {
          const float z = s[mt][i];
          const float e = ex2(-fabsf(z));
          const float lp = lg2(1.f + e);
          float lbv = fminf(z, 0.f) - lp;
          float lrv = fminf(-z, 0.f) - lp;
          if (diag) {
            const bool c = (kt0 + mt * 32 + (i >> 2) * 8 + (i & 3)) < qpos;
            lbv = c ? lbv : -1e30f;
            lrv = c ? lrv : 0.f;
          }
          s[mt][i] = lbv; lr[mt][i] = lrv;
        }
      float R[8], Ro[8];
#pragma unroll
      for (int k8 = 0; k8 < 8; ++k8) {
        const int mt = k8 >> 2, g = k8 & 3;
        R[k8] = (lr[mt][4 * g] + lr[mt][4 * g + 1]) + (lr[mt][4 * g + 2] + lr[mt][4 * g + 3]);
      }
#pragma unroll
      for (int k8 = 0; k8 < 8; ++k8) Ro[k8] = __shfl_xor(R[k8], 32);
      float Pg = T;
#pragma unroll
      for (int k8 = 7; k8 >= 0; --k8) {
        const int mt = k8 >> 2, g = k8 & 3;
        const float t3 = Pg + (lh == 0 ? Ro[k8] : 0.f);
        const float t2 = t3 + lr[mt][4 * g + 3];
        const float t1 = t2 + lr[mt][4 * g + 2];
        const float t0 = t1 + lr[mt][4 * g + 1];
        s[mt][4 * g + 3] = ex2(s[mt][4 * g + 3] + t3);
        s[mt][4 * g + 2] = ex2(s[mt][4 * g + 2] + t2);
        s[mt][4 * g + 1] = ex2(s[mt][4 * g + 1] + t1);
        s[mt][4 * g + 0] = ex2(s[mt][4 * g + 0] + t0);
        Pg += R[k8] + Ro[k8];
      }
      T = Pg;
      bf16x8 pb[4];
      pack_p(s, pb);
      pv_step(Vt, pb, o, lane);
      done = (__builtin_amdgcn_ballot_w64(T < SB_DONE) == ~0ull);
    }
    if (lane == 0) flags[(it & 1) * 8 + w] = (!active || done) ? 1 : 0;
    if (has_next) lstore((it + 1) & 1, kb - 1);
    __syncthreads();
    if (!has_next) break;
    int alld = 1;
#pragma unroll
    for (int i = 0; i < 8; ++i) alld &= flags[(it & 1) * 8 + i];
    if (alld) break;
    --kb; ++it;
  }
  if (active) store_o(p, o, 1.f, tokrow0 + qw0 + l32, hd * 64, lh);
}

DI void attn_phase(const P& p, char* smem) {
  __shared__ int s_item;
  int* ctr = (int*)(p.ws + OFF_CTR);
  constexpr int N_MS = 128, N_SS = 128, N_MP = 2048, N_SP = 2048;
  for (;;) {
    __syncthreads();
    if (threadIdx.x == 0) s_item = atomicAdd(ctr, 1);
    __syncthreads();
    int item = s_item;
    if (item >= N_MS + N_SS + N_MP + N_SP) break;
    if (item < N_MS) { mla_item(p, smem, item >> 3, item & 7, 0, true); continue; }
    item -= N_MS;
    if (item < N_SS) { sb_item(p, smem, item >> 3, item & 7, 0, true); continue; }
    item -= N_SS;
    if (item < N_MP) { const int qt = 7 - (item >> 8), bh = item & 255; mla_item(p, smem, bh >> 3, bh & 7, qt * 256, false); continue; }
    item -= N_MP;
    { const int qt = 7 - (item >> 8), bh = item & 255; sb_item(p, smem, bh >> 3, bh & 7, qt * 256, false); }
  }
}

DI void phase_fin(const P& p) {
  const int lane = threadIdx.x & 63, gw = blockIdx.x * 8 + (threadIdx.x >> 6), ngw = gridDim.x * 8;
  const float* mod = (const float*)(p.ws + OFF_MOD);
  const float* rss = (const float*)(p.ws + OFF_ROWSS);
  const u16* outp = (const u16*)(p.ws + OFF_GATES);
  for (int row = gw; row < NTOK; row += ngw) {
    const float* xr; int bm;
    if (row < NTOK_P) { xr = p.x_prompt + (size_t)row * 1024; bm = row >> 11; }
    else { xr = p.x_sample + (size_t)(row - NTOK_P) * 1024; bm = 32 + ((row - NTOK_P) >> 6); }
    const float ss = (rss[row] + rss[NTOK + row]) + (rss[2 * NTOK + row] + rss[3 * NTOK + row]);
    const float r = rsqrtf(ss * (1.f / 1024.f) + EPS);
    const f32x4* x4 = (const f32x4*)xr;
    const f32x4* gt4 = (const f32x4*)(mod + bm * 3072 + 2048);
    const f32x4* pg4 = (const f32x4*)p.post_g;
    const u32x2* o2 = (const u32x2*)(outp + (size_t)row * 1024);
    f32x4* y4 = (f32x4*)(p.out + (size_t)row * 1024);
#pragma unroll
    for (int j = 0; j < 4; ++j) {
      const int c4 = lane + 64 * j;
      const f32x4 x = x4[c4], gt = gt4[c4], pg = pg4[c4];
      const u32x2 ov = o2[c4];
      f32x4 y;
      y.x = x.x + gt.x * (bflo(ov.x) * r * pg.x);
      y.y = x.y + gt.y * (bfhi(ov.x) * r * pg.y);
      y.z = x.z + gt.z * (bflo(ov.y) * r * pg.z);
      y.w = x.w + gt.w * (bfhi(ov.y) * r * pg.w);
      y4[c4] = y;
    }
  }
}

__global__ void __launch_bounds__(512) sbmla_fwd(P p, int ph_lo, int ph_hi) {
  extern __shared__ __attribute__((aligned(16))) char smem[];
  cg::grid_group grid = cg::this_grid();
#define PHASE(i, call) if (ph_lo <= (i) && (i) < ph_hi) { call; if ((i) + 1 < ph_hi) grid.sync(); }
  PHASE(0, phase0(p, smem))
  PHASE(1, phase1(p))
  PHASE(2, gemm_g1(p, smem))
  PHASE(3, gemm_g23(p, smem))
  PHASE(4, attn_phase(p, smem))
  PHASE(5, gemm_g4(p, smem))
  PHASE(6, phase_fin(p))
#undef PHASE
}

#ifndef N_LAUNCH_SPLIT
#define N_LAUNCH_SPLIT 0
#endif

extern "C" void kernel_launch(void* const* d_in, const int* in_sizes, int n_in, void* d_out, int out_size, void* d_ws, size_t ws_size,
                              hipStream_t stream) {
  static int grid_blocks = 0;
  if (grid_blocks == 0) {
    if (n_in != 18 || ws_size < WS_END) { fprintf(stderr, "kernel_launch: unexpected n_in %d or ws_size %zu (need %zu)\n", n_in, ws_size, (size_t)WS_END); grid_blocks = -1; return; }
    int dev = 0, cus = 0, per_cu = 0;
    hipGetDevice(&dev);
    hipDeviceGetAttribute(&cus, hipDeviceAttributeMultiprocessorCount, dev);
    if (hipFuncSetAttribute((const void*)sbmla_fwd, hipFuncAttributeMaxDynamicSharedMemorySize, LDS_BYTES) != hipSuccess)
      fprintf(stderr, "kernel_launch: hipFuncSetAttribute failed\n");
    if (hipOccupancyMaxActiveBlocksPerMultiprocessor(&per_cu, (const void*)sbmla_fwd, 512, LDS_BYTES) != hipSuccess || per_cu < 1) {
      fprintf(stderr, "kernel_launch: occupancy query gave %d\n", per_cu); per_cu = 1;
    }
    (void)hipGetLastError();
    grid_blocks = cus * per_cu;
    if (grid_blocks > 256) grid_blocks = 256;
    fprintf(stderr, "kernel_launch: grid %d (cus %d per_cu %d)\n", grid_blocks, cus, per_cu);
  }
  if (grid_blocks < 0) return;
  P p{};
  const float** pp = (const float**)&p;
  for (int i = 0; i < 18; ++i) pp[i] = (const float*)d_in[i];
  p.out = (float*)d_out;
  p.ws = (char*)d_ws;
#if N_LAUNCH_SPLIT
  for (int ph = 0; ph < 7; ++ph) {
    int lo = ph, hi = ph + 1;
    hipLaunchKernelGGL(sbmla_fwd, dim3(grid_blocks), dim3(512), LDS_BYTES, stream, p, lo, hi);
  }
#else
  int lo = 0, hi = 7;
  void* args[] = {&p, &lo, &hi};
  hipError_t e = hipLaunchCooperativeKernel((const void*)sbmla_fwd, dim3(grid_blocks), dim3(512), args, LDS_BYTES, stream);
  if (e != hipSuccess) fprintf(stderr, "cooperative launch failed: %s (grid %d)\n", hipGetErrorString(e), grid_blocks);
#endif
}
```

```cpp
#include <hip/hip_runtime.h>
#include <hip/hip_cooperative_groups.h>
#include <cstdio>
namespace cg = cooperative_groups;

#define DI __device__ __forceinline__
typedef unsigned short u16;
typedef short bf16x8 __attribute__((ext_vector_type(8)));
typedef short s16x4 __attribute__((ext_vector_type(4)));
typedef float f32x4 __attribute__((ext_vector_type(4)));
typedef float f32x16 __attribute__((ext_vector_type(16)));
typedef unsigned u32x4 __attribute__((ext_vector_type(4)));
typedef unsigned u32x2 __attribute__((ext_vector_type(2)));

constexpr int T_P = 2048, T_S = 64, PAST = 4096;
constexpr int NTOK_P = 65536, NTOK = 66560;
constexpr int TKS = PAST + T_S;
constexpr int NKV = NTOK_P + 16 * TKS;
constexpr int IN_COLS = 3232, NPAD = 3328;
constexpr float EPS = 1e-6f;
constexpr float LOG2E = 1.4426950408889634f;
constexpr float QS_SB = 0.125f * LOG2E;
constexpr float QS_MLA = 0.10206207261596575f * LOG2E;
constexpr float SB_DONE = 7.5e-37f;

constexpr size_t O_YP = 0, O_YS = 67108864, O_SKP = 68157440, O_SVP = 101711872, O_CKVP = 135266304, O_KRP = 152043520,
                 O_SKS = 154140672, O_SVS = 154664960, O_CKVS = 155189248, O_KRS = 155451392;

constexpr size_t OFF_CTR = 0;
constexpr size_t OFF_MOD = 256;
constexpr size_t OFF_ROPE = OFF_MOD + 589824;
constexpr size_t OFF_WIN = OFF_ROPE + 270336;
constexpr size_t OFF_WUQ = OFF_WIN + 6815744;
constexpr size_t OFF_WUKV = OFF_WUQ + 589824;
constexpr size_t OFF_WOUT = OFF_WUKV + 524288;
constexpr size_t OFF_CQSS = OFF_WOUT + 2097152;
constexpr size_t OFF_ROWSS = OFF_CQSS + 532480;
constexpr size_t OFF_H = OFF_ROWSS + 1064960;
constexpr size_t OFF_GATES = OFF_H + 136314880;
constexpr size_t OFF_SBQ = OFF_GATES + 136314880;
constexpr size_t OFF_SBK = OFF_SBQ + 68157440;
constexpr size_t OFF_SBV = OFF_SBK + 68157440;
constexpr size_t OFF_CQ = OFF_SBV + 68157440;
constexpr size_t OFF_CKV = OFF_CQ + 51118080;
constexpr size_t OFF_KROPE = OFF_CKV + 67633152;
constexpr size_t OFF_QMLA = OFF_KROPE + 8454144;
constexpr size_t OFF_KV = OFF_QMLA + 102236160;
constexpr size_t WS_END = OFF_KV + 270532608;

constexpr int LDS_BYTES = 131072 + 4096;

struct P {
  const float *x_prompt, *x_sample, *cache_sb_k, *cache_sb_v, *cache_ckv, *cache_krope, *c_prompt, *c_sample,
      *ada_w, *ada_b, *pre_g, *w_in, *q_norm_g, *w_uq, *kv_norm_g, *w_ukv, *w_out, *post_g;
  float* out;
  char* ws;
};

DI unsigned pk2(float a, float b) {
  typedef __bf16 bf2 __attribute__((ext_vector_type(2)));
  typedef float f2 __attribute__((ext_vector_type(2)));
  f2 v = {a, b};
  bf2 r = __builtin_convertvector(v, bf2);
  return __builtin_bit_cast(unsigned, r);
}
DI u16 bf1(float a) { return (u16)(pk2(a, 0.f) & 0xffffu); }
DI float bflo(unsigned v) { return __uint_as_float(v << 16); }
DI float bfhi(unsigned v) { return __uint_as_float(v & 0xffff0000u); }
DI float silu_f(float x) { return x / (1.f + __expf(-x)); }
DI float ex2(float x) { return __builtin_amdgcn_exp2f(x); }
DI float lg2(float x) { return __builtin_amdgcn_logf(x); }
DI float wave_sum(float v) {
#pragma unroll
  for (int o = 1; o < 64; o <<= 1) v += __shfl_xor(v, o);
  return v;
}
#define MFMA32(a, b, c) __builtin_amdgcn_mfma_f32_32x32x16_bf16((a), (b), (c), 0, 0, 0)
#define MFMA16(a, b, c) __builtin_amdgcn_mfma_f32_16x16x32_bf16((a), (b), (c), 0, 0, 0)

typedef __attribute__((address_space(3))) s16x4* lds_s16x4_ptr;
DI s16x4 tr_read(const char* ptr) {
  return __builtin_amdgcn_ds_read_tr16_b64_v4i16((lds_s16x4_ptr)(unsigned)(size_t)ptr);
}

DI int win_src_col(int p) {
  if (p < 2432) return p;
  if (p < 2464) return 2688 + (p - 2432);
  if (p < 2560) return -1;
  if (p < 2816) return 2432 + (p - 2560);
  return 2720 + (p - 2816);
}

DI void transpose_w(const float* __restrict__ W, int K, int N, int NP, u16* __restrict__ Wt, const float* __restrict__ kscale,
                    bool perm, int gtid, int gstride) {
  const int nk8 = K / 8;
  for (int e = gtid; e < NP * nk8; e += gstride) {
    const int pcol = e % NP, k8 = e / NP;
    const int c = perm ? win_src_col(pcol) : pcol;
    float v[8];
#pragma unroll
    for (int i = 0; i < 8; ++i) {
      float x = (c >= 0) ? W[(size_t)(k8 * 8 + i) * N + c] : 0.f;
      if (kscale) x *= kscale[k8 * 8 + i];
      v[i] = x;
    }
    u32x4 o = {pk2(v[0], v[1]), pk2(v[2], v[3]), pk2(v[4], v[5]), pk2(v[6], v[7])};
    *(u32x4*)(Wt + (size_t)pcol * K + k8 * 8) = o;
  }
}

DI void mod_job(const P& p, int job, float* lds) {
  const int cc = job % 48, bh = job / 48;
  const int tid = threadIdx.x, lane = tid & 63, w = tid >> 6;
  float* mod = (float*)(p.ws + OFF_MOD);
  __syncthreads();
  for (int e = tid; e < 24 * 1024; e += 512) {
    const int bl = e >> 10, k = e & 1023;
    const int b = bh * 24 + bl;
    const float cv = b < 32 ? p.c_prompt[b * 1024 + k] : p.c_sample[(b - 32) * 1024 + k];
    lds[k * 24 + bl] = silu_f(cv);
  }
  __syncthreads();
  float acc[24];
#pragma unroll
  for (int i = 0; i < 24; ++i) acc[i] = 0.f;
  const int col = cc * 64 + lane;
  for (int k = w * 128; k < w * 128 + 128; ++k) {
    const float wv = p.ada_w[(size_t)k * 3072 + col];
    const f32x4* s4 = (const f32x4*)(lds + k * 24);
#pragma unroll
    for (int q = 0; q < 6; ++q) {
      const f32x4 s = s4[q];
      acc[q * 4 + 0] += s.x * wv; acc[q * 4 + 1] += s.y * wv; acc[q * 4 + 2] += s.z * wv; acc[q * 4 + 3] += s.w * wv;
    }
  }
  __syncthreads();
#pragma unroll
  for (int i = 0; i < 24; ++i) lds[(w * 24 + i) * 64 + lane] = acc[i];
  __syncthreads();
  for (int e = tid; e < 24 * 64; e += 512) {
    const int bl = e >> 6, l = e & 63;
    float s = 0.f;
#pragma unroll
    for (int ww = 0; ww < 8; ++ww) s += lds[(ww * 24 + bl) * 64 + l];
    const int b = bh * 24 + bl, c = cc * 64 + l;
    mod[b * 3072 + c] = s + p.ada_b[c];
  }
  __syncthreads();
}

DI void phase0(const P& p, char* smem) {
  const int tid = threadIdx.x;
  const int gtid = blockIdx.x * 512 + tid, gstride = gridDim.x * 512;
  if (gtid == 0) { *(int*)(p.ws + OFF_CTR) = 0; }
  for (int job = blockIdx.x; job < 96; job += gridDim.x) mod_job(p, job, (float*)smem);
  transpose_w(p.w_in, 1024, IN_COLS, NPAD, (u16*)(p.ws + OFF_WIN), nullptr, true, gtid, gstride);
  transpose_w(p.w_uq, 384, 768, 768, (u16*)(p.ws + OFF_WUQ), p.q_norm_g, false, gtid, gstride);
  transpose_w(p.w_ukv, 256, 1024, 1024, (u16*)(p.ws + OFF_WUKV), nullptr, false, gtid, gstride);
  transpose_w(p.w_out, 1024, 1024, 1024, (u16*)(p.ws + OFF_WOUT), nullptr, false, gtid, gstride);
  {
    u16* ckv = (u16*)(p.ws + OFF_CKV);
    for (int e = gtid; e < 16 * PAST * 32; e += gstride) {
      const int c8 = e & 31, s = (e >> 5) & 4095, b = e >> 17;
      const f32x4* src = (const f32x4*)(p.cache_ckv + ((size_t)(b * PAST + s) * 256 + c8 * 8));
      const f32x4 a = src[0], c = src[1];
      u32x4 o = {pk2(a.x, a.y), pk2(a.z, a.w), pk2(c.x, c.y), pk2(c.z, c.w)};
      *(u32x4*)(ckv + ((size_t)(NTOK + b * PAST + s) * 256 + c8 * 8)) = o;
    }
    u16* kr = (u16*)(p.ws + OFF_KROPE);
    for (int e = gtid; e < 16 * PAST * 4; e += gstride) {
      const int c8 = e & 3, s = (e >> 2) & 4095, b = e >> 14;
      const f32x4* src = (const f32x4*)(p.cache_krope + ((size_t)(b * PAST + s) * 32 + c8 * 8));
      const f32x4 a = src[0], c = src[1];
      u32x4 o = {pk2(a.x, a.y), pk2(a.z, a.w), pk2(c.x, c.y), pk2(c.z, c.w)};
      *(u32x4*)(kr + ((size_t)(NTOK + b * PAST + s) * 32 + c8 * 8)) = o;
    }
  }
  {
    float* tab = (float*)(p.ws + OFF_ROPE);
    for (int e = gtid; e < 2112 * 16; e += gstride) {
      const int idx = e >> 4, i = e & 15;
      const int pos = idx < 2048 ? idx : PAST + (idx - 2048);
      const float inv = exp2f(-(float)i * (13.287712379549449f / 16.f));
      const float ang = (float)pos * inv;
      tab[idx * 32 + i] = cosf(ang);
      tab[idx * 32 + 16 + i] = sinf(ang);
    }
  }
}

DI void phase1(const P& p) {
  const int lane = threadIdx.x & 63, gw = blockIdx.x * 8 + (threadIdx.x >> 6), ngw = gridDim.x * 8;
  const float* mod = (const float*)(p.ws + OFF_MOD);
  u16* hb = (u16*)(p.ws + OFF_H);
  for (int row = gw; row < NTOK; row += ngw) {
    const float* xr; int bm;
    if (row < NTOK_P) { xr = p.x_prompt + (size_t)row * 1024; bm = row >> 11; }
    else { xr = p.x_sample + (size_t)(row - NTOK_P) * 1024; bm = 32 + ((row - NTOK_P) >> 6); }
    const f32x4* x4 = (const f32x4*)xr;
    const f32x4* sh4 = (const f32x4*)(mod + bm * 3072);
    const f32x4* sc4 = (const f32x4*)(mod + bm * 3072 + 1024);
    const f32x4* g4 = (const f32x4*)p.pre_g;
    f32x4 v[4]; float ss = 0.f;
#pragma unroll
    for (int j = 0; j < 4; ++j) { v[j] = x4[lane + 64 * j]; ss += v[j].x * v[j].x + v[j].y * v[j].y + v[j].z * v[j].z + v[j].w * v[j].w; }
    ss = wave_sum(ss);
    const float r = rsqrtf(ss * (1.f / 1024.f) + EPS);
#pragma unroll
    for (int j = 0; j < 4; ++j) {
      const int c4 = lane + 64 * j;
      const f32x4 g = g4[c4], sc = sc4[c4], sh = sh4[c4];
      const float o0 = v[j].x * r * g.x * (1.f + sc.x) + sh.x;
      const float o1 = v[j].y * r * g.y * (1.f + sc.y) + sh.y;
      const float o2 = v[j].z * r * g.z * (1.f + sc.z) + sh.z;
      const float o3 = v[j].w * r * g.w * (1.f + sc.w) + sh.w;
      u32x2 o = {pk2(o0, o1), pk2(o2, o3)};
      *(u32x2*)(hb + (size_t)row * 1024 + c4 * 4) = o;
    }
  }
}

#define LAS __attribute__((address_space(3)))
constexpr int BM = 256, BK = 64, HALF = 128, HTB = HALF * BK * 2, NXCD = 8, WGM = 8;
constexpr int XCH_OFF = 131072;
DI int lds_byte(int r, int c) { const int st = (r >> 4) * 2 + (c >> 5), rr = r & 15, cc = c & 31, ob = rr * 64 + cc * 2; return st * 1024 + (ob ^ (((ob >> 9) & 1) << 5)); }
DI void stage_rc(int b, int& R, int& C) { const int st = b / 1024, sb = b % 1024, swz = sb ^ (((sb >> 9) & 1) << 5); R = (st >> 1) * 16 + swz / 64; C = (st & 1) * 32 + (swz % 64) / 2; }
DI int perm32(int rho) { const int n = rho >> 4, i = rho & 15; return 8 * (i >> 2) + 4 * n + (i & 3); }

struct Unit { int pm, pn; };
struct StaticOrder {
  int nM, nN, nwg, G, c;
  DI void init(int M, int N, int G_, int c_) { nM = M / BM; nN = N / BM; nwg = nM * nN; G = G_; c = c_; }
  DI bool next(int i, Unit& u) const {
    const long L = (long)i * G + c; if (L >= nwg) return false;
    int wgid = (int)L; { const int q = nwg / NXCD, r = nwg % NXCD, xcd = wgid % NXCD, off = wgid / NXCD; wgid = (xcd < r ? xcd * (q + 1) : r * (q + 1) + (xcd - r) * q) + off; }
    const int nig = WGM * nN, gid = wgid / nig, fm = gid * WGM, gsz = (nM - fm) < WGM ? (nM - fm) : WGM;
    u.pm = fm + ((wgid % nig) % gsz); u.pn = (wgid % nig) / gsz; return true;
  }
};

typedef f32x4 acc_t[2][2][4][2];
template <class Epi>
DI void gemm_phase(LAS unsigned char* lds, const u16* Ag, const u16* Btg, const int K, const StaticOrder& S, const Epi& E) {
  int tid = threadIdx.x; asm volatile("" : "+v"(tid));
  const int wid = __builtin_amdgcn_readfirstlane(tid >> 6), lane = tid & 63, wr = wid >> 2, wc = wid & 3, fr = lane & 15, fq = lane >> 4;
  const int nt = K / BK;
  unsigned voffA[2], voffB[2];
#pragma unroll
  for (int i = 0; i < 2; ++i) { int R, C; stage_rc(tid * 16 + i * 8192, R, C); const int Rb = Epi::PERM ? ((R & ~31) + perm32(R & 31)) : R;
    voffA[i] = (unsigned)(R * K + C) * 2u; voffB[i] = (unsigned)(Rb * K + C) * 2u; }
  const size_t kstep = (size_t)(BK * 2);
  const size_t hstep = (size_t)HALF * K * 2;
  const size_t tstep = 2 * hstep;
  const unsigned ldsw = (unsigned)wid * 1024u;
  const int aoff = lds_byte(wr * 64 + fr, fq * 8), boff = lds_byte(wc * 32 + fr, fq * 8);
#define PG8_SA(b, h) (((b) * 2 + (h)) * HTB)
#define PG8_SB(b, h) ((4 + (b) * 2 + (h)) * HTB)
#define PG8_STAGE(bufoff, gbase, voff) do { _Pragma("unroll") for (int _i = 0; _i < 2; ++_i) \
    __builtin_amdgcn_global_load_lds((const unsigned*)((const char*)(gbase) + (voff)[_i]), (LAS unsigned*)(lds + (bufoff) + ldsw + _i * 8192), 16, 0, 0); } while (0)
#define PG8_LDA(dst, b, h) do { _Pragma("unroll") for (int m = 0; m < 4; ++m) _Pragma("unroll") for (int k = 0; k < 2; ++k) dst[m][k] = *(const LAS bf16x8*)(lds + PG8_SA(b, h) + aoff + m * 2048 + k * 1024); } while (0)
#define PG8_LDB(dst, b, h) do { _Pragma("unroll") for (int n = 0; n < 2; ++n) _Pragma("unroll") for (int k = 0; k < 2; ++k) dst[n][k] = *(const LAS bf16x8*)(lds + PG8_SB(b, h) + boff + n * 2048 + k * 1024); } while (0)
#define PG8_MMA(ai, bj, At, Bt) do { __builtin_amdgcn_s_setprio(1); _Pragma("unroll") for (int m = 0; m < 4; ++m) _Pragma("unroll") for (int n = 0; n < 2; ++n) _Pragma("unroll") for (int k = 0; k < 2; ++k) \
    acc[ai][bj][m][n] = __builtin_amdgcn_mfma_f32_16x16x32_bf16(Bt[n][k], At[m][k], acc[ai][bj][m][n], 0, 0, 0); __builtin_amdgcn_s_setprio(0); } while (0)
#define PG8_WAIT_V(n) asm volatile("s_waitcnt vmcnt(" #n ")" ::: "memory")
#define PG8_WAIT_L(n) asm volatile("s_waitcnt lgkmcnt(" #n ")" ::: "memory")
#define PG8_BAR __builtin_amdgcn_s_barrier()
#define PG8_SCHED __builtin_amdgcn_sched_barrier(0)
  Unit cur, nxt; int ui = 0;
  if (!S.next(0, cur)) return;
  f32x4 acc[2][2][4][2];
#pragma unroll
  for (int a = 0; a < 2; ++a)
#pragma unroll
    for (int b = 0; b < 2; ++b)
#pragma unroll
      for (int m = 0; m < 4; ++m)
#pragma unroll
        for (int n = 0; n < 2; ++n) acc[a][b][m][n] = (f32x4){0.f, 0.f, 0.f, 0.f};
  bf16x8 At[4][2], B0[2][2], B1[2][2];
  const char* cA = (const char*)Ag + (size_t)cur.pm * tstep; const char* cB = (const char*)Btg + (size_t)cur.pn * tstep;
  PG8_STAGE(PG8_SB(0, 0), cB, voffB); PG8_STAGE(PG8_SA(0, 0), cA, voffA); PG8_STAGE(PG8_SB(0, 1), cB + hstep, voffB); PG8_STAGE(PG8_SA(0, 1), cA + hstep, voffA);
  if (wr == 1) PG8_BAR;
  PG8_WAIT_V(4); PG8_BAR;
  PG8_STAGE(PG8_SB(1, 0), cB + kstep, voffB); PG8_STAGE(PG8_SA(1, 0), cA + kstep, voffA); PG8_STAGE(PG8_SB(1, 1), cB + hstep + kstep, voffB);
  PG8_WAIT_V(6); PG8_BAR;
  for (;;) {
    const bool has_next = S.next(ui + 1, nxt);
    const char* nA = has_next ? (const char*)Ag + (size_t)nxt.pm * tstep : cA; const char* nB = has_next ? (const char*)Btg + (size_t)nxt.pn * tstep : cB;
#pragma unroll 1
    for (int t = 0; t < nt; t += 2) {
      const bool last = (t == nt - 2);
      const char* a1 = cA + (size_t)(t + 1) * kstep;
      const char* a2 = last ? nA : cA + (size_t)(t + 2) * kstep; const char* b2 = last ? nB : cB + (size_t)(t + 2) * kstep;
      const char* a3 = a2 + kstep; const char* b3 = b2 + kstep;
      PG8_LDB(B0, 0, 0); PG8_SCHED; PG8_LDA(At, 0, 0); PG8_STAGE(PG8_SA(1, 1), a1 + hstep, voffA);
      PG8_WAIT_L(8); PG8_BAR; PG8_WAIT_L(0); PG8_MMA(0, 0, At, B0); PG8_BAR; PG8_SCHED;
      PG8_LDB(B1, 0, 1); PG8_STAGE(PG8_SB(0, 0), b2, voffB);
      PG8_BAR; PG8_WAIT_L(0); PG8_MMA(0, 1, At, B1); PG8_BAR;
      PG8_LDA(At, 0, 1); PG8_STAGE(PG8_SA(0, 0), a2, voffA);
      PG8_BAR; PG8_WAIT_L(0); PG8_MMA(1, 0, At, B0); PG8_BAR; PG8_SCHED;
      PG8_STAGE(PG8_SB(0, 1), b2 + hstep, voffB);
      PG8_WAIT_V(6); PG8_BAR; PG8_MMA(1, 1, At, B1); PG8_BAR;
      PG8_LDB(B0, 1, 0); PG8_SCHED; PG8_LDA(At, 1, 0); PG8_STAGE(PG8_SA(0, 1), a2 + hstep, voffA);
      PG8_WAIT_L(8); PG8_BAR; PG8_WAIT_L(0); PG8_MMA(0, 0, At, B0); PG8_BAR; PG8_SCHED;
      PG8_LDB(B1, 1, 1); PG8_STAGE(PG8_SB(1, 0), b3, voffB);
      PG8_BAR; PG8_WAIT_L(0); PG8_MMA(0, 1, At, B1); PG8_BAR;
      PG8_LDA(At, 1, 1); PG8_STAGE(PG8_SA(1, 0), a3, voffA);
      PG8_BAR; PG8_WAIT_L(0); PG8_MMA(1, 0, At, B0); PG8_BAR; PG8_SCHED;
      PG8_STAGE(PG8_SB(1, 1), b3 + hstep, voffB);
      PG8_WAIT_V(6); PG8_BAR; PG8_MMA(1, 1, At, B1); PG8_BAR;
    }
    E(acc, cur, wr, wc, fr, fq);
    if (!has_next) break;
#pragma unroll
    for (int a = 0; a < 2; ++a)
#pragma unroll
      for (int b = 0; b < 2; ++b)
#pragma unroll
        for (int m = 0; m < 4; ++m)
#pragma unroll
          for (int n = 0; n < 2; ++n) acc[a][b][m][n] = (f32x4){0.f, 0.f, 0.f, 0.f};
    cur = nxt; cA = nA; cB = nB; ++ui;
  }
  PG8_WAIT_V(0);
  if (wr == 0) PG8_BAR;
  PG8_BAR;
#undef PG8_SA
#undef PG8_SB
#undef PG8_STAGE
#undef PG8_LDA
#undef PG8_LDB
#undef PG8_MMA
#undef PG8_WAIT_V
#undef PG8_WAIT_L
#undef PG8_BAR
#undef PG8_SCHED
}

DI u32x4 pack8(const f32x4 a, const f32x4 b) { return (u32x4){pk2(a.x, a.y), pk2(a.z, a.w), pk2(b.x, b.y), pk2(b.z, b.w)}; }
DI float sq4(const f32x4 a) { return (a.x * a.x + a.y * a.y) + (a.z * a.z + a.w * a.w); }

DI void rowsum_xch(float (&ss)[2][4], LAS float* xch, int wr, int wc, int fr, int fq) {
#pragma unroll
  for (int ai = 0; ai < 2; ++ai)
#pragma unroll
    for (int m = 0; m < 4; ++m) { float s = ss[ai][m]; s += __shfl_xor(s, 16); s += __shfl_xor(s, 32); ss[ai][m] = s; }
  if (fq == 0) {
#pragma unroll
    for (int ai = 0; ai < 2; ++ai)
#pragma unroll
      for (int m = 0; m < 4; ++m) xch[(128 * ai + 64 * wr + 16 * m + fr) * 4 + wc] = ss[ai][m];
  }
  __syncthreads();
#pragma unroll
  for (int ai = 0; ai < 2; ++ai)
#pragma unroll
    for (int m = 0; m < 4; ++m) { const f32x4 t = *(const LAS f32x4*)(xch + (128 * ai + 64 * wr + 16 * m + fr) * 4); ss[ai][m] = (t.x + t.y) + (t.z + t.w); }
}

struct EpiG1 {
  static constexpr bool PERM = true;
  P p; LAS unsigned char* lds;
  DI void operator()(const acc_t& acc, const Unit& u, int, int, int, int) const {
    int t_ = threadIdx.x; asm volatile("" : "+v"(t_));
    const int wid_ = __builtin_amdgcn_readfirstlane(t_ >> 6), wr = wid_ >> 2, wc = wid_ & 3, fr = t_ & 15, fq = (t_ >> 4) & 3;
    char* ws_ = p.ws; float* out_ = p.out; asm volatile("" : "+s"(ws_), "+s"(out_));
    (void)out_;
    const int nt = u.pn;
    const bool samp = u.pm >= 256;
    const int row0 = u.pm * 256 + wr * 64 + fr;
    const int rl0 = samp ? row0 - NTOK_P : row0;
    const int c8 = wc * 32 + 8 * fq;
    if (nt < 2) {
      u16* base = (u16*)(ws_ + OFF_SBQ) + nt * 256 + c8;
#pragma unroll
      for (int ai = 0; ai < 2; ++ai)
#pragma unroll
        for (int m = 0; m < 4; ++m) { u16* rp = base + (size_t)(row0 + ai * 128 + m * 16) * 512;
#pragma unroll
          for (int bj = 0; bj < 2; ++bj) *(u32x4*)(rp + bj * 128) = pack8(acc[ai][bj][m][0] * QS_SB, acc[ai][bj][m][1] * QS_SB); }
    } else if (nt < 6) {
      const bool isv = nt >= 4;
      const int cb = (nt & 1) * 256 + c8;
      float* ofb = out_ + (samp ? (isv ? O_SVS : O_SKS) : (isv ? O_SVP : O_SKP)) + cb;
      u16* base = (u16*)(ws_ + (isv ? OFF_SBV : OFF_SBK)) + cb;
#pragma unroll
      for (int ai = 0; ai < 2; ++ai)
#pragma unroll
        for (int m = 0; m < 4; ++m) { u16* rp = base + (size_t)(row0 + ai * 128 + m * 16) * 512; float* of = ofb + (size_t)(rl0 + ai * 128 + m * 16) * 512;
#pragma unroll
          for (int bj = 0; bj < 2; ++bj) { *(f32x4*)(of + bj * 128) = acc[ai][bj][m][0]; *(f32x4*)(of + bj * 128 + 4) = acc[ai][bj][m][1];
            *(u32x4*)(rp + bj * 128) = pack8(acc[ai][bj][m][0], acc[ai][bj][m][1]); } }
    } else if (nt < 8 || nt >= 11) {
      const int cb = (nt < 8 ? (nt - 6) * 256 : 512 + (nt - 11) * 256) + c8;
      u16* base = (u16*)(ws_ + OFF_GATES) + cb;
#pragma unroll
      for (int ai = 0; ai < 2; ++ai)
#pragma unroll
        for (int m = 0; m < 4; ++m) { u16* rp = base + (size_t)(row0 + ai * 128 + m * 16) * 1024;
#pragma unroll
          for (int bj = 0; bj < 2; ++bj) { f32x4 a = acc[ai][bj][m][0], b = acc[ai][bj][m][1];
            a.x = silu_f(a.x); a.y = silu_f(a.y); a.z = silu_f(a.z); a.w = silu_f(a.w); b.x = silu_f(b.x); b.y = silu_f(b.y); b.z = silu_f(b.z); b.w = silu_f(b.w);
            *(u32x4*)(rp + bj * 128) = pack8(a, b); } }
    } else if (nt == 8 || nt == 9) {
      const int part = nt - 8;
      float ss[2][4];
#pragma unroll
      for (int ai = 0; ai < 2; ++ai)
#pragma unroll
        for (int m = 0; m < 4; ++m) { float s = sq4(acc[ai][0][m][0]) + sq4(acc[ai][0][m][1]); if (part == 0) s += sq4(acc[ai][1][m][0]) + sq4(acc[ai][1][m][1]); ss[ai][m] = s; }
      rowsum_xch(ss, (LAS float*)(lds + XCH_OFF), wr, wc, fr, fq);
      float* cqss = (float*)(ws_ + OFF_CQSS) + (size_t)part * NTOK;
      if (wc == 0 && fq == 0) {
#pragma unroll
        for (int ai = 0; ai < 2; ++ai)
#pragma unroll
          for (int m = 0; m < 4; ++m) cqss[row0 + ai * 128 + m * 16] = ss[ai][m];
      }
      u16* base = (u16*)(ws_ + OFF_CQ) + part * 256 + c8;
#pragma unroll
      for (int ai = 0; ai < 2; ++ai)
#pragma unroll
        for (int m = 0; m < 4; ++m) { u16* rp = base + (size_t)(row0 + ai * 128 + m * 16) * 384;
          *(u32x4*)(rp) = pack8(acc[ai][0][m][0], acc[ai][0][m][1]);
          if (part == 0) *(u32x4*)(rp + 128) = pack8(acc[ai][1][m][0], acc[ai][1][m][1]); }
      if (part == 1 && wc == 0) {
        const float* tab = (const float*)(ws_ + OFF_ROPE);
        float* okr = out_ + (samp ? O_KRS : O_KRP);
        u16* kr = (u16*)(ws_ + OFF_KROPE);
        const int i0 = (8 * fq) & 15;
#pragma unroll
        for (int ai = 0; ai < 2; ++ai)
#pragma unroll
          for (int m = 0; m < 4; ++m) {
            const int row = row0 + ai * 128 + m * 16, rl = rl0 + ai * 128 + m * 16;
            const int ridx = samp ? 2048 + (rl & 63) : (rl & 2047);
            f32x4 o[2];
#pragma unroll
            for (int n = 0; n < 2; ++n) {
              const f32x4 cs = *(const f32x4*)(tab + ridx * 32 + i0 + 4 * n), sn = *(const f32x4*)(tab + ridx * 32 + 16 + i0 + 4 * n);
              const f32x4 mine = acc[ai][1][m][n];
              f32x4 oth; oth.x = __shfl_xor(mine.x, 32); oth.y = __shfl_xor(mine.y, 32); oth.z = __shfl_xor(mine.z, 32); oth.w = __shfl_xor(mine.w, 32);
              o[n] = (fq < 2) ? (mine * cs - oth * sn) : (mine * cs + oth * sn);
            }
            *(f32x4*)(okr + (size_t)rl * 32 + 8 * fq) = o[0]; *(f32x4*)(okr + (size_t)rl * 32 + 8 * fq + 4) = o[1];
            *(u32x4*)(kr + (size_t)row * 32 + 8 * fq) = pack8(o[0], o[1]);
          }
      }
    } else {
      float ss[2][4];
#pragma unroll
      for (int ai = 0; ai < 2; ++ai)
#pragma unroll
        for (int m = 0; m < 4; ++m) ss[ai][m] = (sq4(acc[ai][0][m][0]) + sq4(acc[ai][0][m][1])) + (sq4(acc[ai][1][m][0]) + sq4(acc[ai][1][m][1]));
      rowsum_xch(ss, (LAS float*)(lds + XCH_OFF), wr, wc, fr, fq);
      float* ofb = out_ + (samp ? O_CKVS : O_CKVP) + c8;
      u16* base = (u16*)(ws_ + OFF_CKV) + c8;
      f32x4 gv[2][2];
#pragma unroll
      for (int bj = 0; bj < 2; ++bj)
#pragma unroll
        for (int n = 0; n < 2; ++n) gv[bj][n] = *(const f32x4*)(p.kv_norm_g + bj * 128 + c8 + 4 * n);
#pragma unroll
      for (int ai = 0; ai < 2; ++ai)
#pragma unroll
        for (int m = 0; m < 4; ++m) {
          const float r = rsqrtf(ss[ai][m] * (1.f / 256.f) + EPS);
          float* of = ofb + (size_t)(rl0 + ai * 128 + m * 16) * 256; u16* rp = base + (size_t)(row0 + ai * 128 + m * 16) * 256;
#pragma unroll
          for (int bj = 0; bj < 2; ++bj) {
            const f32x4 a = acc[ai][bj][m][0] * r * gv[bj][0], b = acc[ai][bj][m][1] * r * gv[bj][1];
            *(f32x4*)(of + bj * 128) = a; *(f32x4*)(of + bj * 128 + 4) = b;
            *(u32x4*)(rp + bj * 128) = pack8(a, b);
          }
        }
    }
  }
};

struct EpiG2 {
  static constexpr bool PERM = false;
  P p;
  DI void operator()(const acc_t& acc, const Unit& u, int, int, int, int) const {
    int t_ = threadIdx.x; asm volatile("" : "+v"(t_));
    const int wid_ = __builtin_amdgcn_readfirstlane(t_ >> 6), wr = wid_ >> 2, wc = wid_ & 3, fr = t_ & 15, fq = (t_ >> 4) & 3;
    char* ws_ = p.ws; float* out_ = p.out; asm volatile("" : "+s"(ws_), "+s"(out_));
    (void)out_;
    const bool samp = u.pm >= 256;
    const int row0 = u.pm * 256 + wr * 64 + fr;
    const float* cqss = (const float*)(ws_ + OFF_CQSS);
    const float* tab = (const float*)(ws_ + OFF_ROPE);
    u16* dst = (u16*)(ws_ + OFF_QMLA);
#pragma unroll
    for (int ai = 0; ai < 2; ++ai)
#pragma unroll
      for (int m = 0; m < 4; ++m) {
        const int row = row0 + ai * 128 + m * 16;
        const float r = rsqrtf((cqss[row] + cqss[NTOK + row]) * (1.f / 384.f) + EPS) * QS_MLA;
        const int ridx = samp ? 2048 + ((row - NTOK_P) & 63) : (row & 2047);
#pragma unroll
        for (int bj = 0; bj < 2; ++bj) {
          const int gi = u.pn * 8 + bj * 4 + wc;
          f32x4 x1 = acc[ai][bj][m][0] * r, x2 = acc[ai][bj][m][1] * r;
          if (gi % 3 == 2) {
            const f32x4 cs = *(const f32x4*)(tab + ridx * 32 + 4 * fq), sn = *(const f32x4*)(tab + ridx * 32 + 16 + 4 * fq);
            const f32x4 o1 = x1 * cs - x2 * sn, o2 = x2 * cs + x1 * sn;
            x1 = o1; x2 = o2;
          }
          u16* rp = dst + (size_t)row * 768 + gi * 32 + 4 * fq;
          *(u32x2*)(rp) = (u32x2){pk2(x1.x, x1.y), pk2(x1.z, x1.w)};
          *(u32x2*)(rp + 16) = (u32x2){pk2(x2.x, x2.y), pk2(x2.z, x2.w)};
        }
        __builtin_amdgcn_sched_barrier(0);
      }
  }
};

struct EpiG3 {
  static constexpr bool PERM = true;
  P p;
  DI void operator()(const acc_t& acc, const Unit& u, int, int, int, int) const {
    int t_ = threadIdx.x; asm volatile("" : "+v"(t_));
    const int wid_ = __builtin_amdgcn_readfirstlane(t_ >> 6), wr = wid_ >> 2, wc = wid_ & 3, fr = t_ & 15, fq = (t_ >> 4) & 3;
    char* ws_ = p.ws; float* out_ = p.out; asm volatile("" : "+s"(ws_), "+s"(out_));
    (void)out_;
    u16* base = (u16*)(ws_ + OFF_KV) + u.pn * 256 + wc * 32 + 8 * fq;
    const int row0 = u.pm * 256 + wr * 64 + fr;
#pragma unroll
    for (int ai = 0; ai < 2; ++ai)
#pragma unroll
      for (int m = 0; m < 4; ++m) { u16* rp = base + (size_t)(row0 + ai * 128 + m * 16) * 1024;
#pragma unroll
        for (int bj = 0; bj < 2; ++bj) *(u32x4*)(rp + bj * 128) = pack8(acc[ai][bj][m][0], acc[ai][bj][m][1]); }
  }
};

struct EpiG4 {
  static constexpr bool PERM = true;
  P p; LAS unsigned char* lds;
  DI void operator()(const acc_t& acc, const Unit& u, int, int, int, int) const {
    int t_ = threadIdx.x; asm volatile("" : "+v"(t_));
    const int wid_ = __builtin_amdgcn_readfirstlane(t_ >> 6), wr = wid_ >> 2, wc = wid_ & 3, fr = t_ & 15, fq = (t_ >> 4) & 3;
    char* ws_ = p.ws; float* out_ = p.out; asm volatile("" : "+s"(ws_), "+s"(out_));
    (void)out_;
    const int row0 = u.pm * 256 + wr * 64 + fr;
    float ss[2][4];
#pragma unroll
    for (int ai = 0; ai < 2; ++ai)
#pragma unroll
      for (int m = 0; m < 4; ++m) ss[ai][m] = (sq4(acc[ai][0][m][0]) + sq4(acc[ai][0][m][1])) + (sq4(acc[ai][1][m][0]) + sq4(acc[ai][1][m][1]));
    rowsum_xch(ss, (LAS float*)(lds + XCH_OFF), wr, wc, fr, fq);
    float* rss = (float*)(ws_ + OFF_ROWSS) + (size_t)u.pn * NTOK;
    if (wc == 0 && fq == 0) {
#pragma unroll
      for (int ai = 0; ai < 2; ++ai)
#pragma unroll
        for (int m = 0; m < 4; ++m) rss[row0 + ai * 128 + m * 16] = ss[ai][m];
    }
    u16* base = (u16*)(ws_ + OFF_GATES) + u.pn * 256 + wc * 32 + 8 * fq;
#pragma unroll
    for (int ai = 0; ai < 2; ++ai)
#pragma unroll
      for (int m = 0; m < 4; ++m) { u16* rp = base + (size_t)(row0 + ai * 128 + m * 16) * 1024;
#pragma unroll
        for (int bj = 0; bj < 2; ++bj) *(u32x4*)(rp + bj * 128) = pack8(acc[ai][bj][m][0], acc[ai][bj][m][1]); }
  }
};

DI void gemm_g1(const P& p, char* smem) {
  StaticOrder S; S.init(NTOK, NPAD, gridDim.x, blockIdx.x);
  EpiG1 E{p, (LAS unsigned char*)smem};
  gemm_phase((LAS unsigned char*)smem, (const u16*)(p.ws + OFF_H), (const u16*)(p.ws + OFF_WIN), 1024, S, E);
}
DI void gemm_g23(const P& p, char* smem) {
  { StaticOrder S; S.init(NTOK, 768, gridDim.x, blockIdx.x);
    EpiG2 E{p};
    gemm_phase((LAS unsigned char*)smem, (const u16*)(p.ws + OFF_CQ), (const u16*)(p.ws + OFF_WUQ), 384, S, E); }
  { StaticOrder S; S.init(NKV, 1024, gridDim.x, (blockIdx.x + 128) % gridDim.x);
    EpiG3 E{p};
    gemm_phase((LAS unsigned char*)smem, (const u16*)(p.ws + OFF_CKV), (const u16*)(p.ws + OFF_WUKV), 256, S, E); }
}
DI void gemm_g4(const P& p, char* smem) {
  StaticOrder S; S.init(NTOK, 1024, gridDim.x, blockIdx.x);
  EpiG4 E{p, (LAS unsigned char*)smem};
  gemm_phase((LAS unsigned char*)smem, (const u16*)(p.ws + OFF_H), (const u16*)(p.ws + OFF_WOUT), 1024, S, E);
}

constexpr int KS_SB = 144, KS_MLA = 208, VS = 192;
constexpr int MLA_STAGE = 64 * KS_MLA + 64 * VS;
constexpr int SB_STAGE = 64 * KS_SB + 64 * VS;
constexpr int FLAG_OFF = 65536;

DI void pv_step(const char* Vt, const bf16x8 (&pb)[4], f32x16 (&o)[2], int lane) {
  const int lh = lane >> 5, q4 = (lane & 15) >> 2, p4 = lane & 3, g1 = (lane >> 4) & 1;
  const char* vb = Vt + (4 * lh + q4) * VS + 32 * g1 + 8 * p4;
#pragma unroll
  for (int ks = 0; ks < 4; ++ks) {
#pragma unroll
    for (int dvt = 0; dvt < 2; ++dvt) {
      const s16x4 lo = tr_read(vb + (ks * 16) * VS + dvt * 64);
      const s16x4 hi = tr_read(vb + (ks * 16 + 8) * VS + dvt * 64);
      const bf16x8 vf = __builtin_shufflevector(lo, hi, 0, 1, 2, 3, 4, 5, 6, 7);
      o[dvt] = MFMA32(vf, pb[ks], o[dvt]);
    }
  }
}

DI void pack_p(const f32x16 (&s)[2], bf16x8 (&pb)[4]) {
#pragma unroll
  for (int mt = 0; mt < 2; ++mt)
#pragma unroll
    for (int h = 0; h < 2; ++h) {
      u32x4 t = {pk2(s[mt][8 * h + 0], s[mt][8 * h + 1]), pk2(s[mt][8 * h + 2], s[mt][8 * h + 3]),
                 pk2(s[mt][8 * h + 4], s[mt][8 * h + 5]), pk2(s[mt][8 * h + 6], s[mt][8 * h + 7])};
      pb[mt * 2 + h] = __builtin_bit_cast(bf16x8, t);
    }
}

DI void store_o(const P& p, const f32x16 (&o)[2], float inv, size_t tok, int colbase, int lh) {
  const u16* gates = (const u16*)(p.ws + OFF_GATES);
  u16* mixed = (u16*)(p.ws + OFF_H);
#pragma unroll
  for (int dvt = 0; dvt < 2; ++dvt)
#pragma unroll
    for (int g = 0; g < 4; ++g) {
      const size_t off = tok * 1024 + colbase + dvt * 32 + g * 8 + lh * 4;
      const u32x2 gt = *(const u32x2*)(gates + off);
      u32x2 ov = {pk2(o[dvt][4 * g + 0] * inv * bflo(gt.x), o[dvt][4 * g + 1] * inv * bfhi(gt.x)),
                  pk2(o[dvt][4 * g + 2] * inv * bflo(gt.y), o[dvt][4 * g + 3] * inv * bfhi(gt.y))};
      *(u32x2*)(mixed + off) = ov;
    }
}

DI void mla_item(const P& p, char* smem, int b, int hd, int q0, bool samp) {
  int tid = threadIdx.x; asm volatile("" : "+v"(tid));
  const int w = __builtin_amdgcn_readfirstlane(tid >> 6), lane = tid & 63, l32 = lane & 31, lh = lane >> 5;
  const int nq = samp ? 64 : 256;
  const bool active = (w * 32 < nq);
  const int qw0 = q0 + w * 32;
  const size_t tokrow0 = samp ? (size_t)(NTOK_P + b * 64) : (size_t)b * 2048;
  const int nkb_blk = samp ? 65 : (q0 / 64 + 4);
  const int nkb_w = samp ? 65 : (qw0 / 64 + 1);
  const u16* kv = (const u16*)(p.ws + OFF_KV);
  const u16* krope = (const u16*)(p.ws + OFF_KROPE);
  bf16x8 qf[6];
  if (active) {
    const u16* qp = (const u16*)(p.ws + OFF_QMLA) + (tokrow0 + qw0 + l32) * 768 + hd * 96 + lh * 8;
#pragma unroll
    for (int ks = 0; ks < 6; ++ks) qf[ks] = *(const bf16x8*)(qp + ks * 16);
  } else {
#pragma unroll
    for (int ks = 0; ks < 6; ++ks) qf[ks] = (bf16x8){0, 0, 0, 0, 0, 0, 0, 0};
  }
  u32x4 rkn, rvv, rkr;
  rkr = (u32x4){0, 0, 0, 0};
  auto gload = [&](int kb) {
    const size_t trow0 = samp ? (kb < 64 ? (size_t)(NTOK + b * PAST + kb * 64) : (size_t)(NTOK_P + b * 64)) : (size_t)(b * 2048 + kb * 64);
    const size_t row = trow0 + (tid >> 3);
    const u16* base = kv + row * 1024 + hd * 128 + (tid & 7) * 8;
    rkn = *(const u32x4*)base;
    rvv = *(const u32x4*)(base + 64);
    if (tid < 256) rkr = *(const u32x4*)(krope + (trow0 + (tid >> 2)) * 32 + (tid & 3) * 8);
  };
  auto lstore = [&](int buf) {
    char* Kt = smem + buf * MLA_STAGE; char* Vt = Kt + 64 * KS_MLA;
    *(u32x4*)(Kt + (tid >> 3) * KS_MLA + (tid & 7) * 16) = rkn;
    *(u32x4*)(Vt + (tid >> 3) * VS + (tid & 7) * 16) = rvv;
    if (tid < 256) *(u32x4*)(Kt + (tid >> 2) * KS_MLA + 128 + (tid & 3) * 16) = rkr;
  };
  f32x16 o[2];
#pragma unroll
  for (int i = 0; i < 16; ++i) { o[0][i] = 0.f; o[1][i] = 0.f; }
  float mrun = -1e30f, lsum = 0.f;
  gload(0); lstore(0);
  __syncthreads();
  for (int kb = 0; kb < nkb_blk; ++kb) {
    const bool has_next = kb + 1 < nkb_blk;
    if (has_next) gload(kb + 1);
    if (active && kb < nkb_w) {
      const char* Kt = smem + (kb & 1) * MLA_STAGE; const char* Vt = Kt + 64 * KS_MLA;
      f32x16 s[2];
#pragma unroll
      for (int i = 0; i < 16; ++i) { s[0][i] = 0.f; s[1][i] = 0.f; }
      const char* kp = Kt + l32 * KS_MLA + lh * 16;
#pragma unroll
      for (int ks = 0; ks < 6; ++ks) {
        const bf16x8 a0 = *(const bf16x8*)(kp + ks * 32);
        const bf16x8 a1 = *(const bf16x8*)(kp + 32 * KS_MLA + ks * 32);
        s[0] = MFMA32(a0, qf[ks], s[0]);
        s[1] = MFMA32(a1, qf[ks], s[1]);
      }
      float mx = s[0][0];
#pragma unroll
      for (int i = 1; i < 16; ++i) mx = fmaxf(mx, s[0][i]);
#pragma unroll
      for (int i = 0; i < 16; ++i) mx = fmaxf(mx, s[1][i]);
      mx = fmaxf(mx, __shfl_xor(mx, 32));
      const float mn = fmaxf(mrun, mx);
      if (__builtin_amdgcn_ballot_w64(mn > mrun) != 0ull) {
        const float alpha = ex2(mrun - mn);
        lsum *= alpha;
#pragma unroll
        for (int i = 0; i < 16; ++i) { o[0][i] *= alpha; o[1][i] *= alpha; }
      }
      mrun = mn;
      float ps0 = 0.f, ps1 = 0.f;
#pragma unroll
      for (int i = 0; i < 16; ++i) { s[0][i] = ex2(s[0][i] - mn); s[1][i] = ex2(s[1][i] - mn); ps0 += s[0][i]; ps1 += s[1][i]; }
      lsum += ps0 + ps1;
      bf16x8 pb[4];
      pack_p(s, pb);
      pv_step(Vt, pb, o, lane);
    }
    if (has_next) lstore((kb + 1) & 1);
    __syncthreads();
  }
  if (active) {
    const float lt = lsum + __shfl_xor(lsum, 32);
    store_o(p, o, 1.f / lt, tokrow0 + qw0 + l32, 512 + hd * 64, lh);
  }
}

constexpr int SB_NS = 6;
DI void sb_item(const P& p, char* smem, int b, int hd, int q0, bool samp) {
  int tid = threadIdx.x; asm volatile("" : "+v"(tid));
  const int w = __builtin_amdgcn_readfirstlane(tid >> 6), lane = tid & 63, l32 = lane & 31, lh = lane >> 5;
  const int nq = samp ? 64 : 256;
  const bool active = (w * 32 < nq);
  const int qw0 = q0 + w * 32;
  const int qpos_w0 = samp ? PAST + qw0 : qw0;
  const size_t tokrow0 = samp ? (size_t)(NTOK_P + b * 64) : (size_t)b * 2048;
  const int dw = samp ? 64 : (q0 >> 6) + (w >> 1);
  const int d_min = samp ? 64 : (q0 >> 6), d_cnt = samp ? 1 : 4;
  const u16* sbk = (const u16*)(p.ws + OFF_SBK);
  const u16* sbv = (const u16*)(p.ws + OFF_SBV);
  int* flags = (int*)(smem + SB_NS * SB_STAGE);
  bf16x8 qf[4];
  if (active) {
    const u16* qp = (const u16*)(p.ws + OFF_SBQ) + (tokrow0 + qw0 + l32) * 512 + hd * 64 + lh * 8;
#pragma unroll
    for (int ks = 0; ks < 4; ++ks) qf[ks] = *(const bf16x8*)(qp + ks * 16);
  } else {
#pragma unroll
    for (int ks = 0; ks < 4; ++ks) qf[ks] = (bf16x8){0, 0, 0, 0, 0, 0, 0, 0};
  }
  const int r = tid >> 3, c = tid & 7;
  {
    f32x4 pk[4], pv[4];
#pragma unroll
    for (int i = 0; i < 4; ++i) {
      if (i < d_cnt) {
        const size_t row = samp ? (size_t)(NTOK_P + b * 64 + r) : (size_t)b * 2048 + (size_t)(d_min + i) * 64 + r;
        pk[i] = *(const f32x4*)(sbk + row * 512 + hd * 64 + c * 8);
        pv[i] = *(const f32x4*)(sbv + row * 512 + hd * 64 + c * 8);
      }
    }
#pragma unroll
    for (int i = 0; i < 4; ++i) {
      if (i < d_cnt) {
        char* Kt = smem + ((d_min + i) % SB_NS) * SB_STAGE; char* Vt = Kt + 64 * KS_SB;
        *(f32x4*)(Kt + r * KS_SB + c * 16) = pk[i];
        *(f32x4*)(Vt + r * VS + c * 16) = pv[i];
      }
    }
  }
  f32x4 fk0, fk1, fv0, fv1;
  fk0 = fk1 = fv0 = fv1 = (f32x4){0.f, 0.f, 0.f, 0.f};
  auto gload = [&](int kb) {
    if (samp) {
      const size_t off = ((size_t)(b * PAST + kb * 64 + r) * 8 + hd) * 64 + c * 8;
      const f32x4* ks = (const f32x4*)(p.cache_sb_k + off);
      const f32x4* vs = (const f32x4*)(p.cache_sb_v + off);
      fk0 = ks[0]; fk1 = ks[1]; fv0 = vs[0]; fv1 = vs[1];
    } else {
      const size_t row = (size_t)b * 2048 + (size_t)kb * 64 + r;
      fk0 = *(const f32x4*)(sbk + row * 512 + hd * 64 + c * 8);
      fv0 = *(const f32x4*)(sbv + row * 512 + hd * 64 + c * 8);
    }
  };
  auto lstore = [&](int kb) {
    char* Kt = smem + (kb % SB_NS) * SB_STAGE; char* Vt = Kt + 64 * KS_SB;
    if (samp) {
      u32x4 k = {pk2(fk0.x, fk0.y), pk2(fk0.z, fk0.w), pk2(fk1.x, fk1.y), pk2(fk1.z, fk1.w)};
      u32x4 v = {pk2(fv0.x, fv0.y), pk2(fv0.z, fv0.w), pk2(fv1.x, fv1.y), pk2(fv1.z, fv1.w)};
      *(u32x4*)(Kt + r * KS_SB + c * 16) = k;
      *(u32x4*)(Vt + r * VS + c * 16) = v;
    } else {
      *(f32x4*)(Kt + r * KS_SB + c * 16) = fk0;
      *(f32x4*)(Vt + r * VS + c * 16) = fv0;
    }
  };
  f32x16 o[2];
#pragma unroll
  for (int i = 0; i < 16; ++i) { o[0][i] = 0.f; o[1][i] = 0.f; }
  float Pg = 1.f;
  bool done = false;
  __syncthreads();
  for (int t = 0;; ++t) {
    const int kbn = d_min - (t + 1);
    const bool has_next = kbn >= 0;
    if (has_next) gload(kbn);
    const int kbw = dw - t;
    if (active && !done && kbw >= 0) {
      const char* Kt = smem + (kbw % SB_NS) * SB_STAGE; const char* Vt = Kt + 64 * KS_SB;
      f32x16 s[2];
#pragma unroll
      for (int i = 0; i < 16; ++i) { s[0][i] = 0.f; s[1][i] = 0.f; }
      const char* kp = Kt + l32 * KS_SB + lh * 16;
#pragma unroll
      for (int ks = 0; ks < 4; ++ks) {
        const bf16x8 a0 = *(const bf16x8*)(kp + ks * 32);
        const bf16x8 a1 = *(const bf16x8*)(kp + 32 * KS_SB + ks * 32);
        s[0] = MFMA32(a0, qf[ks], s[0]);
        s[1] = MFMA32(a1, qf[ks], s[1]);
      }
      const int qpos = qpos_w0 + l32;
      const int kt0 = kbw * 64 + lh * 4;
      const bool diag = (kbw * 64 + 63 >= qpos_w0);
      f32x16 om[2];
#pragma unroll
      for (int mt = 0; mt < 2; ++mt)
#pragma unroll
        for (int i = 0; i < 16; ++i) {
          const float z = __builtin_amdgcn_fmed3f(s[mt][i], -126.f, 126.f);
          const float e = ex2(-z);
          float bt = __builtin_amdgcn_rcpf(1.f + e);
          float omv = e * bt;
          if (diag) {
            const bool cz = (kt0 + mt * 32 + (i >> 2) * 8 + (i & 3)) < qpos;
            bt = cz ? bt : 0.f;
            omv = cz ? omv : 1.f;
          }
          s[mt][i] = bt; om[mt][i] = omv;
        }
      float R[8], Ro[8];
#pragma unroll
      for (int k8 = 0; k8 < 8; ++k8) {
        const int mt = k8 >> 2, g = k8 & 3;
        R[k8] = (om[mt][4 * g] * om[mt][4 * g + 1]) * (om[mt][4 * g + 2] * om[mt][4 * g + 3]);
      }
#pragma unroll
      for (int k8 = 0; k8 < 8; ++k8) Ro[k8] = __shfl_xor(R[k8], 32);
#pragma unroll
      for (int k8 = 7; k8 >= 0; --k8) {
        const int mt = k8 >> 2, g = k8 & 3;
        const float t3 = lh == 0 ? Pg * Ro[k8] : Pg;
        const float t2 = t3 * om[mt][4 * g + 3];
        const float t1 = t2 * om[mt][4 * g + 2];
        const float t0 = t1 * om[mt][4 * g + 1];
        s[mt][4 * g + 3] *= t3;
        s[mt][4 * g + 2] *= t2;
        s[mt][4 * g + 1] *= t1;
        s[mt][4 * g + 0] *= t0;
        Pg *= R[k8] * Ro[k8];
      }
      bf16x8 pb[4];
      pack_p(s, pb);
      pv_step(Vt, pb, o, lane);
      done = (__builtin_amdgcn_ballot_w64(Pg < SB_DONE) == ~0ull);
    }
    if (lane == 0) flags[(t & 1) * 8 + w] = (!active || done || kbw < 1) ? 1 : 0;
    if (has_next) lstore(kbn);
    __syncthreads();
    int alld = 1;
#pragma unroll
    for (int i = 0; i < 8; ++i) alld &= flags[(t & 1) * 8 + i];
    if (alld) break;
  }
  if (active) store_o(p, o, 1.f, tokrow0 + qw0 + l32, hd * 64, lh);
}

DI void attn_phase(const P& p, char* smem) {
  __shared__ int s_item;
  int* ctr = (int*)(p.ws + OFF_CTR);
  constexpr int N_MS = 128, N_SS = 128, N_MP = 2048, N_SP = 2048;
  for (;;) {
    __syncthreads();
    if (threadIdx.x == 0) s_item = atomicAdd(ctr, 1);
    __syncthreads();
    int item = s_item;
    if (item >= N_MS + N_SS + N_MP + N_SP) break;
    if (item < N_MS) { mla_item(p, smem, item >> 3, item & 7, 0, true); continue; }
    item -= N_MS;
    if (item < N_SS) { sb_item(p, smem, item >> 3, item & 7, 0, true); continue; }
    item -= N_SS;
    if (item < N_MP) { const int qt = 7 - (item >> 8), bh = item & 255; mla_item(p, smem, bh >> 3, bh & 7, qt * 256, false); continue; }
    item -= N_MP;
    { const int qt = 7 - (item >> 8), bh = item & 255; sb_item(p, smem, bh >> 3, bh & 7, qt * 256, false); }
  }
}

DI void phase_fin(const P& p) {
  const int lane = threadIdx.x & 63, gw = blockIdx.x * 8 + (threadIdx.x >> 6), ngw = gridDim.x * 8;
  const float* mod = (const float*)(p.ws + OFF_MOD);
  const float* rss = (const float*)(p.ws + OFF_ROWSS);
  const u16* outp = (const u16*)(p.ws + OFF_GATES);
  for (int row = gw; row < NTOK; row += ngw) {
    const float* xr; int bm;
    if (row < NTOK_P) { xr = p.x_prompt + (size_t)row * 1024; bm = row >> 11; }
    else { xr = p.x_sample + (size_t)(row - NTOK_P) * 1024; bm = 32 + ((row - NTOK_P) >> 6); }
    const float ss = (rss[row] + rss[NTOK + row]) + (rss[2 * NTOK + row] + rss[3 * NTOK + row]);
    const float r = rsqrtf(ss * (1.f / 1024.f) + EPS);
    const f32x4* x4 = (const f32x4*)xr;
    const f32x4* gt4 = (const f32x4*)(mod + bm * 3072 + 2048);
    const f32x4* pg4 = (const f32x4*)p.post_g;
    const u32x2* o2 = (const u32x2*)(outp + (size_t)row * 1024);
    f32x4* y4 = (f32x4*)(p.out + (size_t)row * 1024);
#pragma unroll
    for (int j = 0; j < 4; ++j) {
      const int c4 = lane + 64 * j;
      const f32x4 x = x4[c4], gt = gt4[c4], pg = pg4[c4];
      const u32x2 ov = o2[c4];
      f32x4 y;
      y.x = x.x + gt.x * (bflo(ov.x) * r * pg.x);
      y.y = x.y + gt.y * (bfhi(ov.x) * r * pg.y);
      y.z = x.z + gt.z * (bflo(ov.y) * r * pg.z);
      y.w = x.w + gt.w * (bfhi(ov.y) * r * pg.w);
      y4[c4] = y;
    }
  }
}

__global__ void __launch_bounds__(512) sbmla_fwd(P p, int ph_lo, int ph_hi) {
  extern __shared__ __attribute__((aligned(16))) char smem[];
  cg::grid_group grid = cg::this_grid();
#ifndef REP_PHASE
#define REP_PHASE -1
#endif
#define PHASE(i, call) if (ph_lo <= (i) && (i) < ph_hi) { call; \
    if (REP_PHASE == (i)) { grid.sync(); if ((i) == 4) { if (blockIdx.x == 0 && threadIdx.x == 0) *(int*)(p.ws + OFF_CTR) = 0; grid.sync(); } call; } \
    if ((i) + 1 < ph_hi) grid.sync(); }
  PHASE(0, phase0(p, smem))
  PHASE(1, phase1(p))
  PHASE(2, gemm_g1(p, smem))
  PHASE(3, gemm_g23(p, smem))
  PHASE(4, attn_phase(p, smem))
  PHASE(5, gemm_g4(p, smem))
  PHASE(6, phase_fin(p))
#undef PHASE
}

#ifndef N_LAUNCH_SPLIT
#define N_LAUNCH_SPLIT 0
#endif

extern "C" void kernel_launch(void* const* d_in, const int* in_sizes, int n_in, void* d_out, int out_size, void* d_ws, size_t ws_size,
                              hipStream_t stream) {
  static int grid_blocks = 0;
  if (grid_blocks == 0) {
    if (n_in != 18 || ws_size < WS_END) { fprintf(stderr, "kernel_launch: unexpected n_in %d or ws_size %zu (need %zu)\n", n_in, ws_size, (size_t)WS_END); grid_blocks = -1; return; }
    int dev = 0, cus = 0, per_cu = 0;
    hipGetDevice(&dev);
    hipDeviceGetAttribute(&cus, hipDeviceAttributeMultiprocessorCount, dev);
    if (hipFuncSetAttribute((const void*)sbmla_fwd, hipFuncAttributeMaxDynamicSharedMemorySize, LDS_BYTES) != hipSuccess)
      fprintf(stderr, "kernel_launch: hipFuncSetAttribute failed\n");
    if (hipOccupancyMaxActiveBlocksPerMultiprocessor(&per_cu, (const void*)sbmla_fwd, 512, LDS_BYTES) != hipSuccess || per_cu < 1) {
      fprintf(stderr, "kernel_launch: occupancy query gave %d\n", per_cu); per_cu = 1;
    }
    (void)hipGetLastError();
    grid_blocks = cus * per_cu;
    if (grid_blocks > 256) grid_blocks = 256;
    fprintf(stderr, "kernel_launch: grid %d (cus %d per_cu %d)\n", grid_blocks, cus, per_cu);
  }
  if (grid_blocks < 0) return;
  P p{};
  const float** pp = (const float**)&p;
  for (int i = 0; i < 18; ++i) pp[i] = (const float*)d_in[i];
  p.out = (float*)d_out;
  p.ws = (char*)d_ws;
#if N_LAUNCH_SPLIT
  for (int ph = 0; ph < 7; ++ph) {
    int lo = ph, hi = ph + 1;
    hipLaunchKernelGGL(sbmla_fwd, dim3(grid_blocks), dim3(512), LDS_BYTES, stream, p, lo, hi);
  }
#else
  int lo = 0, hi = 7;
  void* args[] = {&p, &lo, &hi};
  hipError_t e = hipLaunchCooperativeKernel((const void*)sbmla_fwd, dim3(grid_blocks), dim3(512), args, LDS_BYTES, stream);
  if (e != hipSuccess) fprintf(stderr, "cooperative launch failed: %s (grid %d)\n", hipGetErrorString(e), grid_blocks);
#endif
}
```

```cpp
#include <hip/hip_runtime.h>
#include <hip/hip_cooperative_groups.h>
#include <cstdio>
namespace cg = cooperative_groups;

#define DI __device__ __forceinline__
typedef unsigned short u16;
typedef short bf16x8 __attribute__((ext_vector_type(8)));
typedef short s16x4 __attribute__((ext_vector_type(4)));
typedef float f32x4 __attribute__((ext_vector_type(4)));
typedef float f32x16 __attribute__((ext_vector_type(16)));
typedef unsigned u32x4 __attribute__((ext_vector_type(4)));
typedef unsigned u32x2 __attribute__((ext_vector_type(2)));

constexpr int T_P = 2048, T_S = 64, PAST = 4096;
constexpr int NTOK_P = 65536, NTOK = 66560;
constexpr int TKS = PAST + T_S;
constexpr int NKV = NTOK_P + 16 * TKS;
constexpr int IN_COLS = 3232, NPAD = 3328;
constexpr float EPS = 1e-6f;
constexpr float LOG2E = 1.4426950408889634f;
constexpr float QS_SB = 0.125f * LOG2E;
constexpr float QS_MLA = 0.10206207261596575f * LOG2E;
constexpr float SB_DONE = 7.5e-37f;

constexpr size_t O_YP = 0, O_YS = 67108864, O_SKP = 68157440, O_SVP = 101711872, O_CKVP = 135266304, O_KRP = 152043520,
                 O_SKS = 154140672, O_SVS = 154664960, O_CKVS = 155189248, O_KRS = 155451392;

constexpr size_t OFF_CTR = 0;
constexpr size_t OFF_MOD = 256;
constexpr size_t OFF_ROPE = OFF_MOD + 589824;
constexpr size_t OFF_WIN = OFF_ROPE + 270336;
constexpr size_t OFF_WUQ = OFF_WIN + 6815744;
constexpr size_t OFF_WUKV = OFF_WUQ + 589824;
constexpr size_t OFF_WOUT = OFF_WUKV + 524288;
constexpr size_t OFF_CQSS = OFF_WOUT + 2097152;
constexpr size_t OFF_ROWSS = OFF_CQSS + 532480;
constexpr size_t OFF_H = OFF_ROWSS + 1064960;
constexpr size_t OFF_GATES = OFF_H + 136314880;
constexpr size_t OFF_SBQ = OFF_GATES + 136314880;
constexpr size_t OFF_SBK = OFF_SBQ + 68157440;
constexpr size_t OFF_SBV = OFF_SBK + 68157440;
constexpr size_t OFF_CQ = OFF_SBV + 68157440;
constexpr size_t OFF_CKV = OFF_CQ + 51118080;
constexpr size_t OFF_KROPE = OFF_CKV + 67633152;
constexpr size_t OFF_QMLA = OFF_KROPE + 8454144;
constexpr size_t OFF_KV = OFF_QMLA + 102236160;
constexpr size_t WS_END = OFF_KV + 270532608;

constexpr int LDS_BYTES = 131072 + 4096;

struct P {
  const float *x_prompt, *x_sample, *cache_sb_k, *cache_sb_v, *cache_ckv, *cache_krope, *c_prompt, *c_sample,
      *ada_w, *ada_b, *pre_g, *w_in, *q_norm_g, *w_uq, *kv_norm_g, *w_ukv, *w_out, *post_g;
  float* out;
  char* ws;
};

DI unsigned pk2(float a, float b) {
  typedef __bf16 bf2 __attribute__((ext_vector_type(2)));
  typedef float f2 __attribute__((ext_vector_type(2)));
  f2 v = {a, b};
  bf2 r = __builtin_convertvector(v, bf2);
  return __builtin_bit_cast(unsigned, r);
}
DI u16 bf1(float a) { return (u16)(pk2(a, 0.f) & 0xffffu); }
DI float bflo(unsigned v) { return __uint_as_float(v << 16); }
DI float bfhi(unsigned v) { return __uint_as_float(v & 0xffff0000u); }
DI float silu_f(float x) { return x / (1.f + __expf(-x)); }
DI float ex2(float x) { return __builtin_amdgcn_exp2f(x); }
DI float lg2(float x) { return __builtin_amdgcn_logf(x); }
DI float wave_sum(float v) {
#pragma unroll
  for (int o = 1; o < 64; o <<= 1) v += __shfl_xor(v, o);
  return v;
}
#define MFMA32(a, b, c) __builtin_amdgcn_mfma_f32_32x32x16_bf16((a), (b), (c), 0, 0, 0)
#define MFMA16(a, b, c) __builtin_amdgcn_mfma_f32_16x16x32_bf16((a), (b), (c), 0, 0, 0)

typedef __attribute__((address_space(3))) s16x4* lds_s16x4_ptr;
DI s16x4 tr_read(const char* ptr) {
  return __builtin_amdgcn_ds_read_tr16_b64_v4i16((lds_s16x4_ptr)(unsigned)(size_t)ptr);
}

DI int win_src_col(int p) {
  if (p < 2432) return p;
  if (p < 2464) return 2688 + (p - 2432);
  if (p < 2560) return -1;
  if (p < 2816) return 2432 + (p - 2560);
  return 2720 + (p - 2816);
}

DI void transpose_w(const float* __restrict__ W, int K, int N, int NP, u16* __restrict__ Wt, const float* __restrict__ kscale,
                    bool perm, int gtid, int gstride) {
  const int nk8 = K / 8;
  for (int e = gtid; e < NP * nk8; e += gstride) {
    const int pcol = e % NP, k8 = e / NP;
    const int c = perm ? win_src_col(pcol) : pcol;
    float v[8];
#pragma unroll
    for (int i = 0; i < 8; ++i) {
      float x = (c >= 0) ? W[(size_t)(k8 * 8 + i) * N + c] : 0.f;
      if (kscale) x *= kscale[k8 * 8 + i];
      v[i] = x;
    }
    u32x4 o = {pk2(v[0], v[1]), pk2(v[2], v[3]), pk2(v[4], v[5]), pk2(v[6], v[7])};
    *(u32x4*)(Wt + (size_t)pcol * K + k8 * 8) = o;
  }
}

DI void mod_job(const P& p, int job, float* lds) {
  const int cc = job % 48, bh = job / 48;
  const int tid = threadIdx.x, lane = tid & 63, w = tid >> 6;
  float* mod = (float*)(p.ws + OFF_MOD);
  __syncthreads();
  for (int e = tid; e < 24 * 1024; e += 512) {
    const int bl = e >> 10, k = e & 1023;
    const int b = bh * 24 + bl;
    const float cv = b < 32 ? p.c_prompt[b * 1024 + k] : p.c_sample[(b - 32) * 1024 + k];
    lds[k * 24 + bl] = silu_f(cv);
  }
  __syncthreads();
  float acc[24];
#pragma unroll
  for (int i = 0; i < 24; ++i) acc[i] = 0.f;
  const int col = cc * 64 + lane;
  for (int k = w * 128; k < w * 128 + 128; k += 16) {
    float wv[16];
#pragma unroll
    for (int u = 0; u < 16; ++u) wv[u] = p.ada_w[(size_t)(k + u) * 3072 + col];
#pragma unroll
    for (int u = 0; u < 16; ++u) {
      const f32x4* s4 = (const f32x4*)(lds + (k + u) * 24);
#pragma unroll
      for (int q = 0; q < 6; ++q) {
        const f32x4 s = s4[q];
        acc[q * 4 + 0] += s.x * wv[u]; acc[q * 4 + 1] += s.y * wv[u]; acc[q * 4 + 2] += s.z * wv[u]; acc[q * 4 + 3] += s.w * wv[u];
      }
    }
  }
  __syncthreads();
#pragma unroll
  for (int i = 0; i < 24; ++i) lds[(w * 24 + i) * 64 + lane] = acc[i];
  __syncthreads();
  for (int e = tid; e < 24 * 64; e += 512) {
    const int bl = e >> 6, l = e & 63;
    float s = 0.f;
#pragma unroll
    for (int ww = 0; ww < 8; ++ww) s += lds[(ww * 24 + bl) * 64 + l];
    const int b = bh * 24 + bl, c = cc * 64 + l;
    mod[b * 3072 + c] = s + p.ada_b[c];
  }
  __syncthreads();
}

DI void phase0(const P& p, char* smem) {
  const int tid = threadIdx.x;
  if (blockIdx.x == 0 && tid < 32) { ((int*)(p.ws + OFF_CTR))[tid] = 0; }
  for (int job = blockIdx.x; job < 96; job += gridDim.x) mod_job(p, job, (float*)smem);
  const bool split = gridDim.x >= 192;
  if (split && blockIdx.x < 96) return;
  const int gtid = (split ? blockIdx.x - 96 : blockIdx.x) * 512 + tid, gstride = (split ? gridDim.x - 96 : gridDim.x) * 512;
  transpose_w(p.w_in, 1024, IN_COLS, NPAD, (u16*)(p.ws + OFF_WIN), nullptr, true, gtid, gstride);
  transpose_w(p.w_uq, 384, 768, 768, (u16*)(p.ws + OFF_WUQ), p.q_norm_g, false, gtid, gstride);
  transpose_w(p.w_ukv, 256, 1024, 1024, (u16*)(p.ws + OFF_WUKV), nullptr, false, gtid, gstride);
  transpose_w(p.w_out, 1024, 1024, 1024, (u16*)(p.ws + OFF_WOUT), nullptr, false, gtid, gstride);
  {
    u16* ckv = (u16*)(p.ws + OFF_CKV);
    for (int e = gtid; e < 16 * PAST * 32; e += gstride) {
      const int c8 = e & 31, s = (e >> 5) & 4095, b = e >> 17;
      const f32x4* src = (const f32x4*)(p.cache_ckv + ((size_t)(b * PAST + s) * 256 + c8 * 8));
      const f32x4 a = src[0], c = src[1];
      u32x4 o = {pk2(a.x, a.y), pk2(a.z, a.w), pk2(c.x, c.y), pk2(c.z, c.w)};
      *(u32x4*)(ckv + ((size_t)(NTOK + b * PAST + s) * 256 + c8 * 8)) = o;
    }
    u16* kr = (u16*)(p.ws + OFF_KROPE);
    for (int e = gtid; e < 16 * PAST * 4; e += gstride) {
      const int c8 = e & 3, s = (e >> 2) & 4095, b = e >> 14;
      const f32x4* src = (const f32x4*)(p.cache_krope + ((size_t)(b * PAST + s) * 32 + c8 * 8));
      const f32x4 a = src[0], c = src[1];
      u32x4 o = {pk2(a.x, a.y), pk2(a.z, a.w), pk2(c.x, c.y), pk2(c.z, c.w)};
      *(u32x4*)(kr + ((size_t)(NTOK + b * PAST + s) * 32 + c8 * 8)) = o;
    }
  }
  {
    float* tab = (float*)(p.ws + OFF_ROPE);
    for (int e = gtid; e < 2112 * 16; e += gstride) {
      const int idx = e >> 4, i = e & 15;
      const int pos = idx < 2048 ? idx : PAST + (idx - 2048);
      const float inv = exp2f(-(float)i * (13.287712379549449f / 16.f));
      const float ang = (float)pos * inv;
      tab[idx * 32 + i] = cosf(ang);
      tab[idx * 32 + 16 + i] = sinf(ang);
    }
  }
}

DI void phase1(const P& p) {
  const int lane = threadIdx.x & 63, gw = blockIdx.x * 8 + (threadIdx.x >> 6), ngw = gridDim.x * 8;
  const float* mod = (const float*)(p.ws + OFF_MOD);
  u16* hb = (u16*)(p.ws + OFF_H);
  const f32x4* g4 = (const f32x4*)p.pre_g;
  for (int row = gw * 2; row < NTOK; row += ngw * 2) {
    const float* xr; int bm;
    if (row < NTOK_P) { xr = p.x_prompt + (size_t)row * 1024; bm = row >> 11; }
    else { xr = p.x_sample + (size_t)(row - NTOK_P) * 1024; bm = 32 + ((row - NTOK_P) >> 6); }
    const f32x4* x4 = (const f32x4*)xr;
    const f32x4* sh4 = (const f32x4*)(mod + bm * 3072);
    const f32x4* sc4 = (const f32x4*)(mod + bm * 3072 + 1024);
    f32x4 v[2][4]; float ss0 = 0.f, ss1 = 0.f;
#pragma unroll
    for (int j = 0; j < 4; ++j) { v[0][j] = x4[lane + 64 * j]; v[1][j] = x4[256 + lane + 64 * j]; }
#pragma unroll
    for (int j = 0; j < 4; ++j) {
      ss0 += v[0][j].x * v[0][j].x + v[0][j].y * v[0][j].y + v[0][j].z * v[0][j].z + v[0][j].w * v[0][j].w;
      ss1 += v[1][j].x * v[1][j].x + v[1][j].y * v[1][j].y + v[1][j].z * v[1][j].z + v[1][j].w * v[1][j].w;
    }
#pragma unroll
    for (int o = 1; o < 64; o <<= 1) { ss0 += __shfl_xor(ss0, o); ss1 += __shfl_xor(ss1, o); }
    const float r0 = rsqrtf(ss0 * (1.f / 1024.f) + EPS), r1 = rsqrtf(ss1 * (1.f / 1024.f) + EPS);
#pragma unroll
    for (int j = 0; j < 4; ++j) {
      const int c4 = lane + 64 * j;
      const f32x4 g = g4[c4], sc = sc4[c4], sh = sh4[c4];
      const f32x4 m = g * (sc + 1.f);
      const f32x4 a = v[0][j] * r0 * m + sh, bq = v[1][j] * r1 * m + sh;
      *(u32x2*)(hb + (size_t)row * 1024 + c4 * 4) = (u32x2){pk2(a.x, a.y), pk2(a.z, a.w)};
      *(u32x2*)(hb + (size_t)(row + 1) * 1024 + c4 * 4) = (u32x2){pk2(bq.x, bq.y), pk2(bq.z, bq.w)};
    }
  }
}

#define LAS __attribute__((address_space(3)))
constexpr int BM = 256, BK = 64, HALF = 128, HTB = HALF * BK * 2, NXCD = 8, WGM = 8;
constexpr int XCH_OFF = 131072;
DI int lds_byte(int r, int c) { const int st = (r >> 4) * 2 + (c >> 5), rr = r & 15, cc = c & 31, ob = rr * 64 + cc * 2; return st * 1024 + (ob ^ (((ob >> 9) & 1) << 5)); }
DI void stage_rc(int b, int& R, int& C) { const int st = b / 1024, sb = b % 1024, swz = sb ^ (((sb >> 9) & 1) << 5); R = (st >> 1) * 16 + swz / 64; C = (st & 1) * 32 + (swz % 64) / 2; }
DI int perm32(int rho) { const int n = rho >> 4, i = rho & 15; return 8 * (i >> 2) + 4 * n + (i & 3); }

struct Unit { int pm, pn; };
struct StaticOrder {
  int nM, nN, nwg, G, c;
  DI void init(int M, int N, int G_, int c_) { nM = M / BM; nN = N / BM; nwg = nM * nN; G = G_; c = c_; }
  DI bool next(int i, Unit& u) const {
    const long L = (long)i * G + c; if (L >= nwg) return false;
    int wgid = (int)L; { const int q = nwg / NXCD, r = nwg % NXCD, xcd = wgid % NXCD, off = wgid / NXCD; wgid = (xcd < r ? xcd * (q + 1) : r * (q + 1) + (xcd - r) * q) + off; }
    const int nig = WGM * nN, gid = wgid / nig, fm = gid * WGM, gsz = (nM - fm) < WGM ? (nM - fm) : WGM;
    u.pm = fm + ((wgid % nig) % gsz); u.pn = (wgid % nig) / gsz; return true;
  }
};

typedef f32x4 acc_t[2][2][4][2];
template <class Epi>
DI void gemm_phase(LAS unsigned char* lds, const u16* Ag, const u16* Btg, const int K, const StaticOrder& S, const Epi& E) {
  int tid = threadIdx.x; asm volatile("" : "+v"(tid));
  const int wid = __builtin_amdgcn_readfirstlane(tid >> 6), lane = tid & 63, wr = wid >> 2, wc = wid & 3, fr = lane & 15, fq = lane >> 4;
  const int nt = K / BK;
  unsigned voffA[2], voffB[2];
#pragma unroll
  for (int i = 0; i < 2; ++i) { int R, C; stage_rc(tid * 16 + i * 8192, R, C); const int Rb = Epi::PERM ? ((R & ~31) + perm32(R & 31)) : R;
    voffA[i] = (unsigned)(R * K + C) * 2u; voffB[i] = (unsigned)(Rb * K + C) * 2u; }
  const size_t kstep = (size_t)(BK * 2);
  const size_t hstep = (size_t)HALF * K * 2;
  const size_t tstep = 2 * hstep;
  const unsigned ldsw = (unsigned)wid * 1024u;
  const int aoff = lds_byte(wr * 64 + fr, fq * 8), boff = lds_byte(wc * 32 + fr, fq * 8);
#define PG8_SA(b, h) (((b) * 2 + (h)) * HTB)
#define PG8_SB(b, h) ((4 + (b) * 2 + (h)) * HTB)
#define PG8_STAGE(bufoff, gbase, voff) do { _Pragma("unroll") for (int _i = 0; _i < 2; ++_i) \
    __builtin_amdgcn_global_load_lds((const unsigned*)((const char*)(gbase) + (voff)[_i]), (LAS unsigned*)(lds + (bufoff) + ldsw + _i * 8192), 16, 0, 0); } while (0)
#define PG8_LDA(dst, b, h) do { _Pragma("unroll") for (int m = 0; m < 4; ++m) _Pragma("unroll") for (int k = 0; k < 2; ++k) dst[m][k] = *(const LAS bf16x8*)(lds + PG8_SA(b, h) + aoff + m * 2048 + k * 1024); } while (0)
#define PG8_LDB(dst, b, h) do { _Pragma("unroll") for (int n = 0; n < 2; ++n) _Pragma("unroll") for (int k = 0; k < 2; ++k) dst[n][k] = *(const LAS bf16x8*)(lds + PG8_SB(b, h) + boff + n * 2048 + k * 1024); } while (0)
#define PG8_MMA(ai, bj, At, Bt) do { __builtin_amdgcn_s_setprio(1); _Pragma("unroll") for (int m = 0; m < 4; ++m) _Pragma("unroll") for (int n = 0; n < 2; ++n) _Pragma("unroll") for (int k = 0; k < 2; ++k) \
    acc[ai][bj][m][n] = __builtin_amdgcn_mfma_f32_16x16x32_bf16(Bt[n][k], At[m][k], acc[ai][bj][m][n], 0, 0, 0); __builtin_amdgcn_s_setprio(0); } while (0)
#define PG8_WAIT_V(n) asm volatile("s_waitcnt vmcnt(" #n ")" ::: "memory")
#define PG8_WAIT_L(n) asm volatile("s_waitcnt lgkmcnt(" #n ")" ::: "memory")
#define PG8_BAR __builtin_amdgcn_s_barrier()
#define PG8_SCHED __builtin_amdgcn_sched_barrier(0)
  Unit cur, nxt; int ui = 0;
  if (!S.next(0, cur)) return;
  f32x4 acc[2][2][4][2];
#pragma unroll
  for (int a = 0; a < 2; ++a)
#pragma unroll
    for (int b = 0; b < 2; ++b)
#pragma unroll
      for (int m = 0; m < 4; ++m)
#pragma unroll
        for (int n = 0; n < 2; ++n) acc[a][b][m][n] = (f32x4){0.f, 0.f, 0.f, 0.f};
  bf16x8 At[4][2], B0[2][2], B1[2][2];
  const char* cA = (const char*)Ag + (size_t)cur.pm * tstep; const char* cB = (const char*)Btg + (size_t)cur.pn * tstep;
  PG8_STAGE(PG8_SB(0, 0), cB, voffB); PG8_STAGE(PG8_SA(0, 0), cA, voffA); PG8_STAGE(PG8_SB(0, 1), cB + hstep, voffB); PG8_STAGE(PG8_SA(0, 1), cA + hstep, voffA);
  if (wr == 1) PG8_BAR;
  PG8_WAIT_V(4); PG8_BAR;
  PG8_STAGE(PG8_SB(1, 0), cB + kstep, voffB); PG8_STAGE(PG8_SA(1, 0), cA + kstep, voffA); PG8_STAGE(PG8_SB(1, 1), cB + hstep + kstep, voffB);
  PG8_WAIT_V(6); PG8_BAR;
  for (;;) {
    const bool has_next = S.next(ui + 1, nxt);
    const char* nA = has_next ? (const char*)Ag + (size_t)nxt.pm * tstep : cA; const char* nB = has_next ? (const char*)Btg + (size_t)nxt.pn * tstep : cB;
#pragma unroll 1
    for (int t = 0; t < nt; t += 2) {
      const bool last = (t == nt - 2);
      const char* a1 = cA + (size_t)(t + 1) * kstep;
      const char* a2 = last ? nA : cA + (size_t)(t + 2) * kstep; const char* b2 = last ? nB : cB + (size_t)(t + 2) * kstep;
      const char* a3 = a2 + kstep; const char* b3 = b2 + kstep;
      PG8_LDB(B0, 0, 0); PG8_SCHED; PG8_LDA(At, 0, 0); PG8_STAGE(PG8_SA(1, 1), a1 + hstep, voffA);
      PG8_WAIT_L(8); PG8_BAR; PG8_WAIT_L(0); PG8_MMA(0, 0, At, B0); PG8_BAR; PG8_SCHED;
      PG8_LDB(B1, 0, 1); PG8_STAGE(PG8_SB(0, 0), b2, voffB);
      PG8_BAR; PG8_WAIT_L(0); PG8_MMA(0, 1, At, B1); PG8_BAR;
      PG8_LDA(At, 0, 1); PG8_STAGE(PG8_SA(0, 0), a2, voffA);
      PG8_BAR; PG8_WAIT_L(0); PG8_MMA(1, 0, At, B0); PG8_BAR; PG8_SCHED;
      PG8_STAGE(PG8_SB(0, 1), b2 + hstep, voffB);
      PG8_WAIT_V(6); PG8_BAR; PG8_MMA(1, 1, At, B1); PG8_BAR;
      PG8_LDB(B0, 1, 0); PG8_SCHED; PG8_LDA(At, 1, 0); PG8_STAGE(PG8_SA(0, 1), a2 + hstep, voffA);
      PG8_WAIT_L(8); PG8_BAR; PG8_WAIT_L(0); PG8_MMA(0, 0, At, B0); PG8_BAR; PG8_SCHED;
      PG8_LDB(B1, 1, 1); PG8_STAGE(PG8_SB(1, 0), b3, voffB);
      PG8_BAR; PG8_WAIT_L(0); PG8_MMA(0, 1, At, B1); PG8_BAR;
      PG8_LDA(At, 1, 1); PG8_STAGE(PG8_SA(1, 0), a3, voffA);
      PG8_BAR; PG8_WAIT_L(0); PG8_MMA(1, 0, At, B0); PG8_BAR; PG8_SCHED;
      PG8_STAGE(PG8_SB(1, 1), b3 + hstep, voffB);
      PG8_WAIT_V(6); PG8_BAR; PG8_MMA(1, 1, At, B1); PG8_BAR;
    }
    E(acc, cur, wr, wc, fr, fq);
    if (!has_next) break;
#pragma unroll
    for (int a = 0; a < 2; ++a)
#pragma unroll
      for (int b = 0; b < 2; ++b)
#pragma unroll
        for (int m = 0; m < 4; ++m)
#pragma unroll
          for (int n = 0; n < 2; ++n) acc[a][b][m][n] = (f32x4){0.f, 0.f, 0.f, 0.f};
    cur = nxt; cA = nA; cB = nB; ++ui;
  }
  PG8_WAIT_V(0);
  if (wr == 0) PG8_BAR;
  PG8_BAR;
#undef PG8_SA
#undef PG8_SB
#undef PG8_STAGE
#undef PG8_LDA
#undef PG8_LDB
#undef PG8_MMA
#undef PG8_WAIT_V
#undef PG8_WAIT_L
#undef PG8_BAR
#undef PG8_SCHED
}

DI u32x4 pack8(const f32x4 a, const f32x4 b) { return (u32x4){pk2(a.x, a.y), pk2(a.z, a.w), pk2(b.x, b.y), pk2(b.z, b.w)}; }
DI float sq4(const f32x4 a) { return (a.x * a.x + a.y * a.y) + (a.z * a.z + a.w * a.w); }

DI void rowsum_xch(float (&ss)[2][4], LAS float* xch, int wr, int wc, int fr, int fq) {
#pragma unroll
  for (int ai = 0; ai < 2; ++ai)
#pragma unroll
    for (int m = 0; m < 4; ++m) { float s = ss[ai][m]; s += __shfl_xor(s, 16); s += __shfl_xor(s, 32); ss[ai][m] = s; }
  if (fq == 0) {
#pragma unroll
    for (int ai = 0; ai < 2; ++ai)
#pragma unroll
      for (int m = 0; m < 4; ++m) xch[(128 * ai + 64 * wr + 16 * m + fr) * 4 + wc] = ss[ai][m];
  }
  __syncthreads();
#pragma unroll
  for (int ai = 0; ai < 2; ++ai)
#pragma unroll
    for (int m = 0; m < 4; ++m) { const f32x4 t = *(const LAS f32x4*)(xch + (128 * ai + 64 * wr + 16 * m + fr) * 4); ss[ai][m] = (t.x + t.y) + (t.z + t.w); }
}

struct EpiG1 {
  static constexpr bool PERM = true;
  P p; LAS unsigned char* lds;
  DI void operator()(const acc_t& acc, const Unit& u, int, int, int, int) const {
    int t_ = threadIdx.x; asm volatile("" : "+v"(t_));
    const int wid_ = __builtin_amdgcn_readfirstlane(t_ >> 6), wr = wid_ >> 2, wc = wid_ & 3, fr = t_ & 15, fq = (t_ >> 4) & 3;
    char* ws_ = p.ws; float* out_ = p.out; asm volatile("" : "+s"(ws_), "+s"(out_));
    (void)out_;
    const int nt = u.pn;
    const bool samp = u.pm >= 256;
    const int row0 = u.pm * 256 + wr * 64 + fr;
    const int rl0 = samp ? row0 - NTOK_P : row0;
    const int c8 = wc * 32 + 8 * fq;
    if (nt < 2) {
      u16* base = (u16*)(ws_ + OFF_SBQ) + nt * 256 + c8;
#pragma unroll
      for (int ai = 0; ai < 2; ++ai)
#pragma unroll
        for (int m = 0; m < 4; ++m) { u16* rp = base + (size_t)(row0 + ai * 128 + m * 16) * 512;
#pragma unroll
          for (int bj = 0; bj < 2; ++bj) *(u32x4*)(rp + bj * 128) = pack8(acc[ai][bj][m][0] * QS_SB, acc[ai][bj][m][1] * QS_SB); }
    } else if (nt < 6) {
      const bool isv = nt >= 4;
      const int cb = (nt & 1) * 256 + c8;
      float* ofb = out_ + (samp ? (isv ? O_SVS : O_SKS) : (isv ? O_SVP : O_SKP)) + cb;
#pragma unroll
      for (int ai = 0; ai < 2; ++ai)
#pragma unroll
        for (int m = 0; m < 4; ++m) { float* of = ofb + (size_t)(rl0 + ai * 128 + m * 16) * 512;
#pragma unroll
          for (int bj = 0; bj < 2; ++bj) { *(f32x4*)(of + bj * 128) = acc[ai][bj][m][0]; *(f32x4*)(of + bj * 128 + 4) = acc[ai][bj][m][1];
          } }
    } else if (nt < 8 || nt >= 11) {
      const int cb = (nt < 8 ? (nt - 6) * 256 : 512 + (nt - 11) * 256) + c8;
      u16* base = (u16*)(ws_ + OFF_GATES) + cb;
#pragma unroll
      for (int ai = 0; ai < 2; ++ai)
#pragma unroll
        for (int m = 0; m < 4; ++m) { u16* rp = base + (size_t)(row0 + ai * 128 + m * 16) * 1024;
#pragma unroll
          for (int bj = 0; bj < 2; ++bj) { f32x4 a = acc[ai][bj][m][0], b = acc[ai][bj][m][1];
            a.x = silu_f(a.x); a.y = silu_f(a.y); a.z = silu_f(a.z); a.w = silu_f(a.w); b.x = silu_f(b.x); b.y = silu_f(b.y); b.z = silu_f(b.z); b.w = silu_f(b.w);
            *(u32x4*)(rp + bj * 128) = pack8(a, b); } }
    } else if (nt == 8 || nt == 9) {
      const int part = nt - 8;
      float ss[2][4];
#pragma unroll
      for (int ai = 0; ai < 2; ++ai)
#pragma unroll
        for (int m = 0; m < 4; ++m) { float s = sq4(acc[ai][0][m][0]) + sq4(acc[ai][0][m][1]); if (part == 0) s += sq4(acc[ai][1][m][0]) + sq4(acc[ai][1][m][1]); ss[ai][m] = s; }
      rowsum_xch(ss, (LAS float*)(lds + XCH_OFF), wr, wc, fr, fq);
      float* cqss = (float*)(ws_ + OFF_CQSS) + (size_t)part * NTOK;
      if (wc == 0 && fq == 0) {
#pragma unroll
        for (int ai = 0; ai < 2; ++ai)
#pragma unroll
          for (int m = 0; m < 4; ++m) cqss[row0 + ai * 128 + m * 16] = ss[ai][m];
      }
      u16* base = (u16*)(ws_ + OFF_CQ) + part * 256 + c8;
#pragma unroll
      for (int ai = 0; ai < 2; ++ai)
#pragma unroll
        for (int m = 0; m < 4; ++m) { u16* rp = base + (size_t)(row0 + ai * 128 + m * 16) * 384;
          *(u32x4*)(rp) = pack8(acc[ai][0][m][0], acc[ai][0][m][1]);
          if (part == 0) *(u32x4*)(rp + 128) = pack8(acc[ai][1][m][0], acc[ai][1][m][1]); }
      if (part == 1 && wc == 0) {
        const float* tab = (const float*)(ws_ + OFF_ROPE);
        float* okr = out_ + (samp ? O_KRS : O_KRP);
        u16* kr = (u16*)(ws_ + OFF_KROPE);
        const int i0 = (8 * fq) & 15;
#pragma unroll
        for (int ai = 0; ai < 2; ++ai)
#pragma unroll
          for (int m = 0; m < 4; ++m) {
            const int row = row0 + ai * 128 + m * 16, rl = rl0 + ai * 128 + m * 16;
            const int ridx = samp ? 2048 + (rl & 63) : (rl & 2047);
            f32x4 o[2];
#pragma unroll
            for (int n = 0; n < 2; ++n) {
              const f32x4 cs = *(const f32x4*)(tab + ridx * 32 + i0 + 4 * n), sn = *(const f32x4*)(tab + ridx * 32 + 16 + i0 + 4 * n);
              const f32x4 mine = acc[ai][1][m][n];
              f32x4 oth; oth.x = __shfl_xor(mine.x, 32); oth.y = __shfl_xor(mine.y, 32); oth.z = __shfl_xor(mine.z, 32); oth.w = __shfl_xor(mine.w, 32);
              o[n] = (fq < 2) ? (mine * cs - oth * sn) : (mine * cs + oth * sn);
            }
            *(f32x4*)(okr + (size_t)rl * 32 + 8 * fq) = o[0]; *(f32x4*)(okr + (size_t)rl * 32 + 8 * fq + 4) = o[1];
            *(u32x4*)(kr + (size_t)row * 32 + 8 * fq) = pack8(o[0], o[1]);
          }
      }
    } else {
      float ss[2][4];
#pragma unroll
      for (int ai = 0; ai < 2; ++ai)
#pragma unroll
        for (int m = 0; m < 4; ++m) ss[ai][m] = (sq4(acc[ai][0][m][0]) + sq4(acc[ai][0][m][1])) + (sq4(acc[ai][1][m][0]) + sq4(acc[ai][1][m][1]));
      rowsum_xch(ss, (LAS float*)(lds + XCH_OFF), wr, wc, fr, fq);
      float* ofb = out_ + (samp ? O_CKVS : O_CKVP) + c8;
      u16* base = (u16*)(ws_ + OFF_CKV) + c8;
      f32x4 gv[2][2];
#pragma unroll
      for (int bj = 0; bj < 2; ++bj)
#pragma unroll
        for (int n = 0; n < 2; ++n) gv[bj][n] = *(const f32x4*)(p.kv_norm_g + bj * 128 + c8 + 4 * n);
#pragma unroll
      for (int ai = 0; ai < 2; ++ai)
#pragma unroll
        for (int m = 0; m < 4; ++m) {
          const float r = rsqrtf(ss[ai][m] * (1.f / 256.f) + EPS);
          float* of = ofb + (size_t)(rl0 + ai * 128 + m * 16) * 256; u16* rp = base + (size_t)(row0 + ai * 128 + m * 16) * 256;
#pragma unroll
          for (int bj = 0; bj < 2; ++bj) {
            const f32x4 a = acc[ai][bj][m][0] * r * gv[bj][0], b = acc[ai][bj][m][1] * r * gv[bj][1];
            *(f32x4*)(of + bj * 128) = a; *(f32x4*)(of + bj * 128 + 4) = b;
            *(u32x4*)(rp + bj * 128) = pack8(a, b);
          }
        }
    }
  }
};

struct EpiG2 {
  static constexpr bool PERM = false;
  P p;
  DI void operator()(const acc_t& acc, const Unit& u, int, int, int, int) const {
    int t_ = threadIdx.x; asm volatile("" : "+v"(t_));
    const int wid_ = __builtin_amdgcn_readfirstlane(t_ >> 6), wr = wid_ >> 2, wc = wid_ & 3, fr = t_ & 15, fq = (t_ >> 4) & 3;
    char* ws_ = p.ws; float* out_ = p.out; asm volatile("" : "+s"(ws_), "+s"(out_));
    (void)out_;
    const bool samp = u.pm >= 256;
    const int row0 = u.pm * 256 + wr * 64 + fr;
    const float* cqss = (const float*)(ws_ + OFF_CQSS);
    const float* tab = (const float*)(ws_ + OFF_ROPE);
    u16* dst = (u16*)(ws_ + OFF_QMLA);
#pragma unroll
    for (int ai = 0; ai < 2; ++ai)
#pragma unroll
      for (int m = 0; m < 4; ++m) {
        const int row = row0 + ai * 128 + m * 16;
        const float r = rsqrtf((cqss[row] + cqss[NTOK + row]) * (1.f / 384.f) + EPS) * QS_MLA;
        const int ridx = samp ? 2048 + ((row - NTOK_P) & 63) : (row & 2047);
#pragma unroll
        for (int bj = 0; bj < 2; ++bj) {
          const int gi = u.pn * 8 + bj * 4 + wc;
          f32x4 x1 = acc[ai][bj][m][0] * r, x2 = acc[ai][bj][m][1] * r;
          if (gi % 3 == 2) {
            const f32x4 cs = *(const f32x4*)(tab + ridx * 32 + 4 * fq), sn = *(const f32x4*)(tab + ridx * 32 + 16 + 4 * fq);
            const f32x4 o1 = x1 * cs - x2 * sn, o2 = x2 * cs + x1 * sn;
            x1 = o1; x2 = o2;
          }
          u16* rp = dst + (size_t)row * 768 + gi * 32 + 4 * fq;
          *(u32x2*)(rp) = (u32x2){pk2(x1.x, x1.y), pk2(x1.z, x1.w)};
          *(u32x2*)(rp + 16) = (u32x2){pk2(x2.x, x2.y), pk2(x2.z, x2.w)};
        }
        __builtin_amdgcn_sched_barrier(0);
      }
  }
};

struct EpiG3 {
  static constexpr bool PERM = true;
  P p;
  DI void operator()(const acc_t& acc, const Unit& u, int, int, int, int) const {
    int t_ = threadIdx.x; asm volatile("" : "+v"(t_));
    const int wid_ = __builtin_amdgcn_readfirstlane(t_ >> 6), wr = wid_ >> 2, wc = wid_ & 3, fr = t_ & 15, fq = (t_ >> 4) & 3;
    char* ws_ = p.ws; float* out_ = p.out; asm volatile("" : "+s"(ws_), "+s"(out_));
    (void)out_;
    u16* base = (u16*)(ws_ + OFF_KV) + u.pn * 256 + wc * 32 + 8 * fq;
    const int row0 = u.pm * 256 + wr * 64 + fr;
#pragma unroll
    for (int ai = 0; ai < 2; ++ai)
#pragma unroll
      for (int m = 0; m < 4; ++m) { u16* rp = base + (size_t)(row0 + ai * 128 + m * 16) * 1024;
#pragma unroll
        for (int bj = 0; bj < 2; ++bj) *(u32x4*)(rp + bj * 128) = pack8(acc[ai][bj][m][0], acc[ai][bj][m][1]); }
  }
};

struct EpiG4 {
  static constexpr bool PERM = true;
  P p; LAS unsigned char* lds;
  DI void operator()(const acc_t& acc, const Unit& u, int, int, int, int) const {
    int t_ = threadIdx.x; asm volatile("" : "+v"(t_));
    const int wid_ = __builtin_amdgcn_readfirstlane(t_ >> 6), wr = wid_ >> 2, wc = wid_ & 3, fr = t_ & 15, fq = (t_ >> 4) & 3;
    char* ws_ = p.ws; float* out_ = p.out; asm volatile("" : "+s"(ws_), "+s"(out_));
    (void)out_;
    const int row0 = u.pm * 256 + wr * 64 + fr;
    float ss[2][4];
#pragma unroll
    for (int ai = 0; ai < 2; ++ai)
#pragma unroll
      for (int m = 0; m < 4; ++m) ss[ai][m] = (sq4(acc[ai][0][m][0]) + sq4(acc[ai][0][m][1])) + (sq4(acc[ai][1][m][0]) + sq4(acc[ai][1][m][1]));
    rowsum_xch(ss, (LAS float*)(lds + XCH_OFF), wr, wc, fr, fq);
    float* rss = (float*)(ws_ + OFF_ROWSS) + (size_t)u.pn * NTOK;
    if (wc == 0 && fq == 0) {
#pragma unroll
      for (int ai = 0; ai < 2; ++ai)
#pragma unroll
        for (int m = 0; m < 4; ++m) rss[row0 + ai * 128 + m * 16] = ss[ai][m];
    }
    u16* base = (u16*)(ws_ + OFF_GATES) + u.pn * 256 + wc * 32 + 8 * fq;
#pragma unroll
    for (int ai = 0; ai < 2; ++ai)
#pragma unroll
      for (int m = 0; m < 4; ++m) { u16* rp = base + (size_t)(row0 + ai * 128 + m * 16) * 1024;
#pragma unroll
        for (int bj = 0; bj < 2; ++bj) *(u32x4*)(rp + bj * 128) = pack8(acc[ai][bj][m][0], acc[ai][bj][m][1]); }
  }
};

DI void gemm_g1(const P& p, char* smem) {
  StaticOrder S; S.init(NTOK, NPAD, gridDim.x, blockIdx.x);
  EpiG1 E{p, (LAS unsigned char*)smem};
  gemm_phase((LAS unsigned char*)smem, (const u16*)(p.ws + OFF_H), (const u16*)(p.ws + OFF_WIN), 1024, S, E);
}
DI void gemm_g23(const P& p, char* smem) {
  { StaticOrder S; S.init(NTOK, 768, gridDim.x, blockIdx.x);
    EpiG2 E{p};
    gemm_phase((LAS unsigned char*)smem, (const u16*)(p.ws + OFF_CQ), (const u16*)(p.ws + OFF_WUQ), 384, S, E); }
  { StaticOrder S; S.init(NKV, 1024, gridDim.x, (blockIdx.x + 128) % gridDim.x);
    EpiG3 E{p};
    gemm_phase((LAS unsigned char*)smem, (const u16*)(p.ws + OFF_CKV), (const u16*)(p.ws + OFF_WUKV), 256, S, E); }
}
DI void gemm_g4(const P& p, char* smem) {
  StaticOrder S; S.init(NTOK, 1024, gridDim.x, blockIdx.x);
  EpiG4 E{p, (LAS unsigned char*)smem};
  gemm_phase((LAS unsigned char*)smem, (const u16*)(p.ws + OFF_H), (const u16*)(p.ws + OFF_WOUT), 1024, S, E);
}

constexpr int KS_SB = 144, KS_MLA = 208, VS = 192;
constexpr int MLA_STAGE = 64 * KS_MLA + 64 * VS;
constexpr int SB_STAGE = 64 * KS_SB + 64 * VS;
constexpr int FLAG_OFF = 65536;

DI void pv_step(const char* Vt, const bf16x8 (&pb)[4], f32x16 (&o)[2], int lane) {
  const int lh = lane >> 5, q4 = (lane & 15) >> 2, p4 = lane & 3, g1 = (lane >> 4) & 1;
  const char* vb = Vt + (4 * lh + q4) * VS + 32 * g1 + 8 * p4;
#pragma unroll
  for (int ks = 0; ks < 4; ++ks) {
#pragma unroll
    for (int dvt = 0; dvt < 2; ++dvt) {
      const s16x4 lo = tr_read(vb + (ks * 16) * VS + dvt * 64);
      const s16x4 hi = tr_read(vb + (ks * 16 + 8) * VS + dvt * 64);
      const bf16x8 vf = __builtin_shufflevector(lo, hi, 0, 1, 2, 3, 4, 5, 6, 7);
      o[dvt] = MFMA32(vf, pb[ks], o[dvt]);
    }
  }
}

DI void pack_p(const f32x16 (&s)[2], bf16x8 (&pb)[4]) {
#pragma unroll
  for (int mt = 0; mt < 2; ++mt)
#pragma unroll
    for (int h = 0; h < 2; ++h) {
      u32x4 t = {pk2(s[mt][8 * h + 0], s[mt][8 * h + 1]), pk2(s[mt][8 * h + 2], s[mt][8 * h + 3]),
                 pk2(s[mt][8 * h + 4], s[mt][8 * h + 5]), pk2(s[mt][8 * h + 6], s[mt][8 * h + 7])};
      pb[mt * 2 + h] = __builtin_bit_cast(bf16x8, t);
    }
}

DI void store_o(const P& p, const f32x16 (&o)[2], float inv, size_t tok, int colbase, int lh) {
  const u16* gates = (const u16*)(p.ws + OFF_GATES);
  u16* mixed = (u16*)(p.ws + OFF_H);
#pragma unroll
  for (int dvt = 0; dvt < 2; ++dvt)
#pragma unroll
    for (int g = 0; g < 4; ++g) {
      const size_t off = tok * 1024 + colbase + dvt * 32 + g * 8 + lh * 4;
      const u32x2 gt = *(const u32x2*)(gates + off);
      u32x2 ov = {pk2(o[dvt][4 * g + 0] * inv * bflo(gt.x), o[dvt][4 * g + 1] * inv * bfhi(gt.x)),
                  pk2(o[dvt][4 * g + 2] * inv * bflo(gt.y), o[dvt][4 * g + 3] * inv * bfhi(gt.y))};
      *(u32x2*)(mixed + off) = ov;
    }
}

DI void mla_item(const P& p, char* smem, int b, int hd, int q0, bool samp) {
  int tid = threadIdx.x; asm volatile("" : "+v"(tid));
  const int w = __builtin_amdgcn_readfirstlane(tid >> 6), lane = tid & 63, l32 = lane & 31, lh = lane >> 5;
  const int nq = samp ? 64 : 256;
  const bool active = (w * 32 < nq);
  const int qw0 = q0 + w * 32;
  const size_t tokrow0 = samp ? (size_t)(NTOK_P + b * 64) : (size_t)b * 2048;
  const int nkb_blk = samp ? 65 : (q0 / 64 + 4);
  const int nkb_w = samp ? 65 : (qw0 / 64 + 1);
  const u16* kv = (const u16*)(p.ws + OFF_KV);
  const u16* krope = (const u16*)(p.ws + OFF_KROPE);
  bf16x8 qf[6];
  if (active) {
    const u16* qp = (const u16*)(p.ws + OFF_QMLA) + (tokrow0 + qw0 + l32) * 768 + hd * 96 + lh * 8;
#pragma unroll
    for (int ks = 0; ks < 6; ++ks) qf[ks] = *(const bf16x8*)(qp + ks * 16);
  } else {
#pragma unroll
    for (int ks = 0; ks < 6; ++ks) qf[ks] = (bf16x8){0, 0, 0, 0, 0, 0, 0, 0};
  }
  u32x4 rkn, rvv, rkr;
  rkr = (u32x4){0, 0, 0, 0};
  auto gload = [&](int kb) {
    const size_t trow0 = samp ? (kb < 64 ? (size_t)(NTOK + b * PAST + kb * 64) : (size_t)(NTOK_P + b * 64)) : (size_t)(b * 2048 + kb * 64);
    const size_t row = trow0 + (tid >> 3);
    const u16* base = kv + row * 1024 + hd * 128 + (tid & 7) * 8;
    rkn = *(const u32x4*)base;
    rvv = *(const u32x4*)(base + 64);
    if (tid < 256) rkr = *(const u32x4*)(krope + (trow0 + (tid >> 2)) * 32 + (tid & 3) * 8);
  };
  auto lstore = [&](int buf) {
    char* Kt = smem + buf * MLA_STAGE; char* Vt = Kt + 64 * KS_MLA;
    *(u32x4*)(Kt + (tid >> 3) * KS_MLA + (tid & 7) * 16) = rkn;
    *(u32x4*)(Vt + (tid >> 3) * VS + (tid & 7) * 16) = rvv;
    if (tid < 256) *(u32x4*)(Kt + (tid >> 2) * KS_MLA + 128 + (tid & 3) * 16) = rkr;
  };
  f32x16 o[2];
#pragma unroll
  for (int i = 0; i < 16; ++i) { o[0][i] = 0.f; o[1][i] = 0.f; }
  float mrun = -1e30f, lsum = 0.f;
  gload(0); lstore(0);
  __syncthreads();
  for (int kb = 0; kb < nkb_blk; ++kb) {
    const bool has_next = kb + 1 < nkb_blk;
    if (has_next) gload(kb + 1);
    if (active && kb < nkb_w) {
      const char* Kt = smem + (kb & 1) * MLA_STAGE; const char* Vt = Kt + 64 * KS_MLA;
      f32x16 s[2];
#pragma unroll
      for (int i = 0; i < 16; ++i) { s[0][i] = 0.f; s[1][i] = 0.f; }
      const char* kp = Kt + l32 * KS_MLA + lh * 16;
#pragma unroll
      for (int ks = 0; ks < 6; ++ks) {
        const bf16x8 a0 = *(const bf16x8*)(kp + ks * 32);
        const bf16x8 a1 = *(const bf16x8*)(kp + 32 * KS_MLA + ks * 32);
        s[0] = MFMA32(a0, qf[ks], s[0]);
        s[1] = MFMA32(a1, qf[ks], s[1]);
      }
      f32x16 e[2];
      float ps0 = 0.f, ps1 = 0.f;
      bool redo = (kb == 0);
      if (!redo) {
#pragma unroll
        for (int i = 0; i < 16; ++i) { e[0][i] = ex2(s[0][i] - mrun); e[1][i] = ex2(s[1][i] - mrun); ps0 += e[0][i]; ps1 += e[1][i]; }
        redo = (__builtin_amdgcn_ballot_w64(!(ps0 + ps1 < 1e18f)) != 0ull);
      }
      if (redo) {
        float mx = fmaxf(s[0][0], s[1][0]);
#pragma unroll
        for (int i = 1; i < 16; ++i) mx = fmaxf(mx, fmaxf(s[0][i], s[1][i]));
        mx = fmaxf(mx, __shfl_xor(mx, 32));
        const float mn = fmaxf(mrun, mx);
        const float alpha = ex2(mrun - mn);
        lsum *= alpha;
#pragma unroll
        for (int i = 0; i < 16; ++i) { o[0][i] *= alpha; o[1][i] *= alpha; }
        mrun = mn;
        ps0 = 0.f; ps1 = 0.f;
#pragma unroll
        for (int i = 0; i < 16; ++i) { e[0][i] = ex2(s[0][i] - mn); e[1][i] = ex2(s[1][i] - mn); ps0 += e[0][i]; ps1 += e[1][i]; }
      }
      lsum += ps0 + ps1;
      bf16x8 pb[4];
      pack_p(e, pb);
      pv_step(Vt, pb, o, lane);
    }
    if (has_next) lstore((kb + 1) & 1);
    __syncthreads();
  }
  if (active) {
    const float lt = lsum + __shfl_xor(lsum, 32);
    store_o(p, o, 1.f / lt, tokrow0 + qw0 + l32, 512 + hd * 64, lh);
  }
}

constexpr int SB_NS = 6;
DI void sb_item(const P& p, char* smem, int b, int hd, int q0, bool samp) {
  int tid = threadIdx.x; asm volatile("" : "+v"(tid));
  const int w = __builtin_amdgcn_readfirstlane(tid >> 6), lane = tid & 63, l32 = lane & 31, lh = lane >> 5;
  const int nq = samp ? 64 : 256;
  const bool active = (w * 32 < nq);
  const int qw0 = q0 + w * 32;
  const int qpos_w0 = samp ? PAST + qw0 : qw0;
  const size_t tokrow0 = samp ? (size_t)(NTOK_P + b * 64) : (size_t)b * 2048;
  const int dw = samp ? 64 : (q0 >> 6) + (w >> 1);
  const int d_min = samp ? 64 : (q0 >> 6), d_cnt = samp ? 1 : 4;
  int* flags = (int*)(smem + SB_NS * SB_STAGE);
  bf16x8 qf[4];
  if (active) {
    const u16* qp = (const u16*)(p.ws + OFF_SBQ) + (tokrow0 + qw0 + l32) * 512 + hd * 64 + lh * 8;
#pragma unroll
    for (int ks = 0; ks < 4; ++ks) qf[ks] = *(const bf16x8*)(qp + ks * 16);
  } else {
#pragma unroll
    for (int ks = 0; ks < 4; ++ks) qf[ks] = (bf16x8){0, 0, 0, 0, 0, 0, 0, 0};
  }
  const int r = tid >> 3, c = tid & 7;
  const float* nk = p.out + (samp ? O_SKS : O_SKP);
  const float* nv = p.out + (samp ? O_SVS : O_SVP);
  auto src_off = [&](int kb) -> size_t {
    return samp ? (kb < 64 ? ((size_t)(b * PAST + kb * 64 + r) * 8 + hd) * 64 + c * 8 : (size_t)(b * 64 + r) * 512 + hd * 64 + c * 8)
                : ((size_t)b * 2048 + (size_t)kb * 64 + r) * 512 + hd * 64 + c * 8;
  };
  {
    f32x4 pk[4][2], pv[4][2];
#pragma unroll
    for (int i = 0; i < 4; ++i) {
      if (i < d_cnt) {
        const size_t off = src_off(d_min + i);
        const f32x4* ks = (const f32x4*)(nk + off); const f32x4* vs = (const f32x4*)(nv + off);
        pk[i][0] = ks[0]; pk[i][1] = ks[1]; pv[i][0] = vs[0]; pv[i][1] = vs[1];
      }
    }
#pragma unroll
    for (int i = 0; i < 4; ++i) {
      if (i < d_cnt) {
        char* Kt = smem + ((d_min + i) % SB_NS) * SB_STAGE; char* Vt = Kt + 64 * KS_SB;
        *(u32x4*)(Kt + r * KS_SB + c * 16) = pack8(pk[i][0], pk[i][1]);
        *(u32x4*)(Vt + r * VS + c * 16) = pack8(pv[i][0], pv[i][1]);
      }
    }
  }
  f32x4 fk0, fk1, fv0, fv1;
  fk0 = fk1 = fv0 = fv1 = (f32x4){0.f, 0.f, 0.f, 0.f};
  auto gload = [&](int kb) {
    const size_t off = src_off(kb);
    const f32x4* ks = (const f32x4*)((samp ? p.cache_sb_k : nk) + off);
    const f32x4* vs = (const f32x4*)((samp ? p.cache_sb_v : nv) + off);
    fk0 = ks[0]; fk1 = ks[1]; fv0 = vs[0]; fv1 = vs[1];
  };
  auto lstore = [&](int kb) {
    char* Kt = smem + (kb % SB_NS) * SB_STAGE; char* Vt = Kt + 64 * KS_SB;
    *(u32x4*)(Kt + r * KS_SB + c * 16) = pack8(fk0, fk1);
    *(u32x4*)(Vt + r * VS + c * 16) = pack8(fv0, fv1);
  };
  f32x16 o[2];
#pragma unroll
  for (int i = 0; i < 16; ++i) { o[0][i] = 0.f; o[1][i] = 0.f; }
  float Pg = 1.f;
  bool done = false;
  __syncthreads();
  for (int t = 0;; ++t) {
    const int kbn = d_min - (t + 1);
    const bool has_next = kbn >= 0;
    if (has_next) gload(kbn);
    const int kbw = dw - t;
    if (active && !done && kbw >= 0) {
      const char* Kt = smem + (kbw % SB_NS) * SB_STAGE; const char* Vt = Kt + 64 * KS_SB;
      f32x16 s[2];
#pragma unroll
      for (int i = 0; i < 16; ++i) { s[0][i] = 0.f; s[1][i] = 0.f; }
      const char* kp = Kt + l32 * KS_SB + lh * 16;
#pragma unroll
      for (int ks = 0; ks < 4; ++ks) {
        const bf16x8 a0 = *(const bf16x8*)(kp + ks * 32);
        const bf16x8 a1 = *(const bf16x8*)(kp + 32 * KS_SB + ks * 32);
        s[0] = MFMA32(a0, qf[ks], s[0]);
        s[1] = MFMA32(a1, qf[ks], s[1]);
      }
      const int qpos = qpos_w0 + l32;
      const int kt0 = kbw * 64 + lh * 4;
      const bool diag = (kbw * 64 + 63 >= qpos_w0);
      f32x16 om[2];
#pragma unroll
      for (int mt = 0; mt < 2; ++mt)
#pragma unroll
        for (int i = 0; i < 16; ++i) {
          const float z = __builtin_amdgcn_fmed3f(s[mt][i], -126.f, 126.f);
          const float e = ex2(-z);
          const float bt = __builtin_amdgcn_rcpf(1.f + e);
          s[mt][i] = bt; om[mt][i] = e * bt;
        }
      if (__builtin_amdgcn_readfirstlane((int)diag)) {
#pragma unroll
        for (int mt = 0; mt < 2; ++mt)
#pragma unroll
          for (int i = 0; i < 16; ++i) {
            const bool cz = (kt0 + mt * 32 + (i >> 2) * 8 + (i & 3)) < qpos;
            s[mt][i] = cz ? s[mt][i] : 0.f;
            om[mt][i] = cz ? om[mt][i] : 1.f;
          }
      }
      float R[8], Ro[8];
#pragma unroll
      for (int k8 = 0; k8 < 8; ++k8) {
        const int mt = k8 >> 2, g = k8 & 3;
        R[k8] = (om[mt][4 * g] * om[mt][4 * g + 1]) * (om[mt][4 * g + 2] * om[mt][4 * g + 3]);
      }
#pragma unroll
      for (int k8 = 0; k8 < 8; ++k8) Ro[k8] = __shfl_xor(R[k8], 32);
#pragma unroll
      for (int k8 = 7; k8 >= 0; --k8) {
        const int mt = k8 >> 2, g = k8 & 3;
        const float t3 = lh == 0 ? Pg * Ro[k8] : Pg;
        const float t2 = t3 * om[mt][4 * g + 3];
        const float t1 = t2 * om[mt][4 * g + 2];
        const float t0 = t1 * om[mt][4 * g + 1];
        s[mt][4 * g + 3] *= t3;
        s[mt][4 * g + 2] *= t2;
        s[mt][4 * g + 1] *= t1;
        s[mt][4 * g + 0] *= t0;
        Pg *= R[k8] * Ro[k8];
      }
      bf16x8 pb[4];
      pack_p(s, pb);
      pv_step(Vt, pb, o, lane);
      done = (__builtin_amdgcn_ballot_w64(Pg < SB_DONE) == ~0ull);
    }
    if (lane == 0) flags[(t & 1) * 8 + w] = (!active || done || kbw < 1) ? 1 : 0;
    if (has_next) lstore(kbn);
    __syncthreads();
    int alld = 1;
#pragma unroll
    for (int i = 0; i < 8; ++i) alld &= flags[(t & 1) * 8 + i];
    if (alld) break;
  }
  if (active) store_o(p, o, 1.f, tokrow0 + qw0 + l32, hd * 64, lh);
}

DI void attn_phase(const P& p, char* smem) {
  __shared__ int s_item;
  int* ctr = (int*)(p.ws + OFF_CTR);
  constexpr int N_MS = 128, N_SS = 128, N_MP = 2048, N_SP = 2048, N_ALL = N_MS + N_SS + N_MP + N_SP;
  if (threadIdx.x == 0) s_item = atomicAdd(ctr, 1);
  __syncthreads();
  int item = s_item;
  while (item < N_ALL) {
    __syncthreads();
    int nxt = 0;
    if (threadIdx.x == 0) nxt = atomicAdd(ctr, 1);
    int it = item;
    if (it < N_MS) { mla_item(p, smem, it >> 3, it & 7, 0, true); }
    else if ((it -= N_MS) < N_SS) { sb_item(p, smem, it >> 3, it & 7, 0, true); }
    else if ((it -= N_SS) < N_MP) { const int qt = 7 - (it >> 8), bh = it & 255; mla_item(p, smem, bh >> 3, bh & 7, qt * 256, false); }
    else { it -= N_MP; const int qt = 7 - (it >> 8), bh = it & 255; sb_item(p, smem, bh >> 3, bh & 7, qt * 256, false); }
    if (threadIdx.x == 0) s_item = nxt;
    __syncthreads();
    item = s_item;
  }
}

DI void phase_fin(const P& p) {
  const int lane = threadIdx.x & 63, gw = blockIdx.x * 8 + (threadIdx.x >> 6), ngw = gridDim.x * 8;
  const float* mod = (const float*)(p.ws + OFF_MOD);
  const float* rss = (const float*)(p.ws + OFF_ROWSS);
  const u16* outp = (const u16*)(p.ws + OFF_GATES);
  const f32x4* pg4 = (const f32x4*)p.post_g;
  for (int row = gw * 2; row < NTOK; row += ngw * 2) {
    const float* xr; int bm;
    if (row < NTOK_P) { xr = p.x_prompt + (size_t)row * 1024; bm = row >> 11; }
    else { xr = p.x_sample + (size_t)(row - NTOK_P) * 1024; bm = 32 + ((row - NTOK_P) >> 6); }
    const f32x4* x4 = (const f32x4*)xr;
    const u32x2* o2 = (const u32x2*)(outp + (size_t)row * 1024);
    f32x4 xv[2][4]; u32x2 ov[2][4];
#pragma unroll
    for (int j = 0; j < 4; ++j) { xv[0][j] = x4[lane + 64 * j]; xv[1][j] = x4[256 + lane + 64 * j]; ov[0][j] = o2[lane + 64 * j]; ov[1][j] = o2[256 + lane + 64 * j]; }
    const float s0 = (rss[row] + rss[NTOK + row]) + (rss[2 * NTOK + row] + rss[3 * NTOK + row]);
    const float s1 = (rss[row + 1] + rss[NTOK + row + 1]) + (rss[2 * NTOK + row + 1] + rss[3 * NTOK + row + 1]);
    const float r0 = rsqrtf(s0 * (1.f / 1024.f) + EPS), r1 = rsqrtf(s1 * (1.f / 1024.f) + EPS);
    const f32x4* gt4 = (const f32x4*)(mod + bm * 3072 + 2048);
    f32x4* y4 = (f32x4*)(p.out + (size_t)row * 1024);
#pragma unroll
    for (int j = 0; j < 4; ++j) {
      const int c4 = lane + 64 * j;
      const f32x4 m = gt4[c4] * pg4[c4];
      const f32x4 m0 = m * r0, m1 = m * r1;
      f32x4 y;
      y.x = xv[0][j].x + m0.x * bflo(ov[0][j].x); y.y = xv[0][j].y + m0.y * bfhi(ov[0][j].x);
      y.z = xv[0][j].z + m0.z * bflo(ov[0][j].y); y.w = xv[0][j].w + m0.w * bfhi(ov[0][j].y);
      y4[c4] = y;
      y.x = xv[1][j].x + m1.x * bflo(ov[1][j].x); y.y = xv[1][j].y + m1.y * bfhi(ov[1][j].x);
      y.z = xv[1][j].z + m1.z * bflo(ov[1][j].y); y.w = xv[1][j].w + m1.w * bfhi(ov[1][j].y);
      y4[256 + c4] = y;
    }
  }
}

__global__ void __launch_bounds__(512) sbmla_fwd(P p, int ph_lo, int ph_hi) {
  extern __shared__ __attribute__((aligned(16))) char smem[];
  cg::grid_group grid = cg::this_grid();
#ifndef REP_PHASE
#define REP_PHASE -1
#endif
#define PHASE(i, call) if (ph_lo <= (i) && (i) < ph_hi) { call; \
    if (REP_PHASE == (i)) { grid.sync(); if ((i) == 4) { if (blockIdx.x == 0 && threadIdx.x == 0) *(int*)(p.ws + OFF_CTR) = 0; grid.sync(); } call; } \
    if ((i) + 1 < ph_hi) grid.sync(); }
  PHASE(0, phase0(p, smem))
  PHASE(1, phase1(p))
  PHASE(2, gemm_g1(p, smem))
  PHASE(3, gemm_g23(p, smem))
  PHASE(4, attn_phase(p, smem))
  PHASE(5, gemm_g4(p, smem))
  PHASE(6, phase_fin(p))
#undef PHASE
}

#ifndef N_LAUNCH_SPLIT
#define N_LAUNCH_SPLIT 0
#endif

extern "C" void kernel_launch(void* const* d_in, const int* in_sizes, int n_in, void* d_out, int out_size, void* d_ws, size_t ws_size,
                              hipStream_t stream) {
  static int grid_blocks = 0;
  if (grid_blocks == 0) {
    if (n_in != 18 || ws_size < WS_END) { fprintf(stderr, "kernel_launch: unexpected n_in %d or ws_size %zu (need %zu)\n", n_in, ws_size, (size_t)WS_END); grid_blocks = -1; return; }
    int dev = 0, cus = 0, per_cu = 0;
    hipGetDevice(&dev);
    hipDeviceGetAttribute(&cus, hipDeviceAttributeMultiprocessorCount, dev);
    if (hipFuncSetAttribute((const void*)sbmla_fwd, hipFuncAttributeMaxDynamicSharedMemorySize, LDS_BYTES) != hipSuccess)
      fprintf(stderr, "kernel_launch: hipFuncSetAttribute failed\n");
    if (hipOccupancyMaxActiveBlocksPerMultiprocessor(&per_cu, (const void*)sbmla_fwd, 512, LDS_BYTES) != hipSuccess || per_cu < 1) {
      fprintf(stderr, "kernel_launch: occupancy query gave %d\n", per_cu); per_cu = 1;
    }
    (void)hipGetLastError();
    grid_blocks = cus * per_cu;
    if (grid_blocks > 256) grid_blocks = 256;
    fprintf(stderr, "kernel_launch: grid %d (cus %d per_cu %d)\n", grid_blocks, cus, per_cu);
  }
  if (grid_blocks < 0) return;
  P p{};
  const float** pp = (const float**)&p;
  for (int i = 0; i < 18; ++i) pp[i] = (const float*)d_in[i];
  p.out = (float*)d_out;
  p.ws = (char*)d_ws;
#if N_LAUNCH_SPLIT
  for (int ph = 0; ph < 7; ++ph) {
    int lo = ph, hi = ph + 1;
    hipLaunchKernelGGL(sbmla_fwd, dim3(grid_blocks), dim3(512), LDS_BYTES, stream, p, lo, hi);
  }
#else
  int lo = 0, hi = 7;
  void* args[] = {&p, &lo, &hi};
  hipError_t e = hipLaunchCooperativeKernel((const void*)sbmla_fwd, dim3(grid_blocks), dim3(512), args, LDS_BYTES, stream);
  if (e != hipSuccess) fprintf(stderr, "cooperative launch failed: %s (grid %d)\n", hipGetErrorString(e), grid_blocks);
#endif
}
```

```cpp
#include <hip/hip_runtime.h>
#include <hip/hip_cooperative_groups.h>
#include <cstdio>
namespace cg = cooperative_groups;

#define DI __device__ __forceinline__
typedef unsigned short u16;
typedef short bf16x8 __attribute__((ext_vector_type(8)));
typedef short s16x4 __attribute__((ext_vector_type(4)));
typedef float f32x4 __attribute__((ext_vector_type(4)));
typedef float f32x16 __attribute__((ext_vector_type(16)));
typedef unsigned u32x4 __attribute__((ext_vector_type(4)));
typedef unsigned u32x2 __attribute__((ext_vector_type(2)));

constexpr int T_P = 2048, T_S = 64, PAST = 4096;
constexpr int NTOK_P = 65536, NTOK = 66560;
constexpr int TKS = PAST + T_S;
constexpr int NKV = NTOK_P + 16 * TKS;
constexpr int IN_COLS = 3232, NPAD = 3328;
constexpr float EPS = 1e-6f;
constexpr float LOG2E = 1.4426950408889634f;
constexpr float QS_SB = 0.125f * LOG2E;
constexpr float QS_MLA = 0.10206207261596575f * LOG2E;
constexpr float SB_DONE = 7.5e-37f;

constexpr size_t O_YP = 0, O_YS = 67108864, O_SKP = 68157440, O_SVP = 101711872, O_CKVP = 135266304, O_KRP = 152043520,
                 O_SKS = 154140672, O_SVS = 154664960, O_CKVS = 155189248, O_KRS = 155451392;

constexpr size_t OFF_CTR = 0;
constexpr size_t OFF_MOD = 256;
constexpr size_t OFF_ROPE = OFF_MOD + 589824;
constexpr size_t OFF_WIN = OFF_ROPE + 270336;
constexpr size_t OFF_WUQ = OFF_WIN + 6815744;
constexpr size_t OFF_WUKV = OFF_WUQ + 589824;
constexpr size_t OFF_WOUT = OFF_WUKV + 524288;
constexpr size_t OFF_CQSS = OFF_WOUT + 2097152;
constexpr size_t OFF_ROWSS = OFF_CQSS + 532480;
constexpr size_t OFF_H = OFF_ROWSS + 1064960;
constexpr size_t OFF_GATES = OFF_H + 136314880;
constexpr size_t OFF_SBQ = OFF_GATES + 136314880;
constexpr size_t OFF_SBK = OFF_SBQ + 68157440;
constexpr size_t OFF_SBV = OFF_SBK + 68157440;
constexpr size_t OFF_CQ = OFF_SBV + 68157440;
constexpr size_t OFF_CKV = OFF_CQ + 51118080;
constexpr size_t OFF_KROPE = OFF_CKV + 67633152;
constexpr size_t OFF_QMLA = OFF_KROPE + 8454144;
constexpr size_t OFF_KV = OFF_QMLA + 102236160;
constexpr size_t WS_END = OFF_KV + 270532608;

constexpr int LDS_BYTES = 131072 + 4096;

struct P {
  const float *x_prompt, *x_sample, *cache_sb_k, *cache_sb_v, *cache_ckv, *cache_krope, *c_prompt, *c_sample,
      *ada_w, *ada_b, *pre_g, *w_in, *q_norm_g, *w_uq, *kv_norm_g, *w_ukv, *w_out, *post_g;
  float* out;
  char* ws;
};

DI unsigned pk2(float a, float b) {
  typedef __bf16 bf2 __attribute__((ext_vector_type(2)));
  typedef float f2 __attribute__((ext_vector_type(2)));
  f2 v = {a, b};
  bf2 r = __builtin_convertvector(v, bf2);
  return __builtin_bit_cast(unsigned, r);
}
DI u16 bf1(float a) { return (u16)(pk2(a, 0.f) & 0xffffu); }
DI float bflo(unsigned v) { return __uint_as_float(v << 16); }
DI float bfhi(unsigned v) { return __uint_as_float(v & 0xffff0000u); }
DI float silu_f(float x) { return x * __builtin_amdgcn_rcpf(1.f + __builtin_amdgcn_exp2f(-1.4426950408889634f * x)); }
DI float ex2(float x) { return __builtin_amdgcn_exp2f(x); }
DI float lg2(float x) { return __builtin_amdgcn_logf(x); }
DI float wave_sum(float v) {
#pragma unroll
  for (int o = 1; o < 64; o <<= 1) v += __shfl_xor(v, o);
  return v;
}
#define MFMA32(a, b, c) __builtin_amdgcn_mfma_f32_32x32x16_bf16((a), (b), (c), 0, 0, 0)
#define MFMA16(a, b, c) __builtin_amdgcn_mfma_f32_16x16x32_bf16((a), (b), (c), 0, 0, 0)

typedef __attribute__((address_space(3))) s16x4* lds_s16x4_ptr;
DI s16x4 tr_read(const char* ptr) {
  return __builtin_amdgcn_ds_read_tr16_b64_v4i16((lds_s16x4_ptr)(unsigned)(size_t)ptr);
}

DI int win_src_col(int p) {
  if (p < 2432) return p;
  if (p < 2464) return 2688 + (p - 2432);
  if (p < 2560) return -1;
  if (p < 2816) return 2432 + (p - 2560);
  return 2720 + (p - 2816);
}

DI void transpose_w(const float* __restrict__ W, int K, int N, int NP, u16* __restrict__ Wt, const float* __restrict__ kscale,
                    bool perm, int gtid, int gstride) {
  const int nk8 = K / 8;
  for (int e = gtid; e < NP * nk8; e += gstride) {
    const int pcol = e % NP, k8 = e / NP;
    const int c = perm ? win_src_col(pcol) : pcol;
    float v[8];
#pragma unroll
    for (int i = 0; i < 8; ++i) {
      float x = (c >= 0) ? W[(size_t)(k8 * 8 + i) * N + c] : 0.f;
      if (kscale) x *= kscale[k8 * 8 + i];
      v[i] = x;
    }
    u32x4 o = {pk2(v[0], v[1]), pk2(v[2], v[3]), pk2(v[4], v[5]), pk2(v[6], v[7])};
    *(u32x4*)(Wt + (size_t)pcol * K + k8 * 8) = o;
  }
}

DI void mod_job(const P& p, int job, float* lds) {
  const int cc = job % 48, bh = job / 48;
  const int tid = threadIdx.x, lane = tid & 63, w = tid >> 6;
  float* mod = (float*)(p.ws + OFF_MOD);
  __syncthreads();
  for (int e = tid; e < 24 * 1024; e += 512) {
    const int bl = e >> 10, k = e & 1023;
    const int b = bh * 24 + bl;
    const float cv = b < 32 ? p.c_prompt[b * 1024 + k] : p.c_sample[(b - 32) * 1024 + k];
    lds[k * 24 + bl] = silu_f(cv);
  }
  __syncthreads();
  float acc[24];
#pragma unroll
  for (int i = 0; i < 24; ++i) acc[i] = 0.f;
  const int col = cc * 64 + lane;
  for (int k = w * 128; k < w * 128 + 128; k += 16) {
    float wv[16];
#pragma unroll
    for (int u = 0; u < 16; ++u) wv[u] = p.ada_w[(size_t)(k + u) * 3072 + col];
#pragma unroll
    for (int u = 0; u < 16; ++u) {
      const f32x4* s4 = (const f32x4*)(lds + (k + u) * 24);
#pragma unroll
      for (int q = 0; q < 6; ++q) {
        const f32x4 s = s4[q];
        acc[q * 4 + 0] += s.x * wv[u]; acc[q * 4 + 1] += s.y * wv[u]; acc[q * 4 + 2] += s.z * wv[u]; acc[q * 4 + 3] += s.w * wv[u];
      }
    }
  }
  __syncthreads();
#pragma unroll
  for (int i = 0; i < 24; ++i) lds[(w * 24 + i) * 64 + lane] = acc[i];
  __syncthreads();
  for (int e = tid; e < 24 * 64; e += 512) {
    const int bl = e >> 6, l = e & 63;
    float s = 0.f;
#pragma unroll
    for (int ww = 0; ww < 8; ++ww) s += lds[(ww * 24 + bl) * 64 + l];
    const int b = bh * 24 + bl, c = cc * 64 + l;
    mod[b * 3072 + c] = s + p.ada_b[c];
  }
  __syncthreads();
}

DI void phase0(const P& p, char* smem) {
  const int tid = threadIdx.x;
  if (blockIdx.x == 0 && tid < 32) { ((int*)(p.ws + OFF_CTR))[tid] = 0; }
  for (int job = blockIdx.x; job < 96; job += gridDim.x) mod_job(p, job, (float*)smem);
  const bool split = gridDim.x >= 192;
  if (split && blockIdx.x < 96) return;
  const int gtid = (split ? blockIdx.x - 96 : blockIdx.x) * 512 + tid, gstride = (split ? gridDim.x - 96 : gridDim.x) * 512;
  transpose_w(p.w_in, 1024, IN_COLS, NPAD, (u16*)(p.ws + OFF_WIN), nullptr, true, gtid, gstride);
  transpose_w(p.w_uq, 384, 768, 768, (u16*)(p.ws + OFF_WUQ), p.q_norm_g, false, gtid, gstride);
  transpose_w(p.w_ukv, 256, 1024, 1024, (u16*)(p.ws + OFF_WUKV), nullptr, false, gtid, gstride);
  transpose_w(p.w_out, 1024, 1024, 1024, (u16*)(p.ws + OFF_WOUT), nullptr, false, gtid, gstride);
  {
    u16* ckv = (u16*)(p.ws + OFF_CKV);
    for (int e = gtid; e < 16 * PAST * 32; e += gstride) {
      const int c8 = e & 31, s = (e >> 5) & 4095, b = e >> 17;
      const f32x4* src = (const f32x4*)(p.cache_ckv + ((size_t)(b * PAST + s) * 256 + c8 * 8));
      const f32x4 a = src[0], c = src[1];
      u32x4 o = {pk2(a.x, a.y), pk2(a.z, a.w), pk2(c.x, c.y), pk2(c.z, c.w)};
      *(u32x4*)(ckv + ((size_t)(NTOK + b * PAST + s) * 256 + c8 * 8)) = o;
    }
    u16* kr = (u16*)(p.ws + OFF_KROPE);
    for (int e = gtid; e < 16 * PAST * 4; e += gstride) {
      const int c8 = e & 3, s = (e >> 2) & 4095, b = e >> 14;
      const f32x4* src = (const f32x4*)(p.cache_krope + ((size_t)(b * PAST + s) * 32 + c8 * 8));
      const f32x4 a = src[0], c = src[1];
      u32x4 o = {pk2(a.x, a.y), pk2(a.z, a.w), pk2(c.x, c.y), pk2(c.z, c.w)};
      *(u32x4*)(kr + ((size_t)(NTOK + b * PAST + s) * 32 + c8 * 8)) = o;
    }
  }
  {
    float* tab = (float*)(p.ws + OFF_ROPE);
    for (int e = gtid; e < 2112 * 16; e += gstride) {
      const int idx = e >> 4, i = e & 15;
      const int pos = idx < 2048 ? idx : PAST + (idx - 2048);
      const float inv = exp2f(-(float)i * (13.287712379549449f / 16.f));
      const float ang = (float)pos * inv;
      tab[idx * 32 + i] = cosf(ang);
      tab[idx * 32 + 16 + i] = sinf(ang);
    }
  }
}

DI void phase1(const P& p) {
  const int lane = threadIdx.x & 63, gw = blockIdx.x * 8 + (threadIdx.x >> 6), ngw = gridDim.x * 8;
  const float* mod = (const float*)(p.ws + OFF_MOD);
  u16* hb = (u16*)(p.ws + OFF_H);
  const f32x4* g4 = (const f32x4*)p.pre_g;
  for (int row = gw * 2; row < NTOK; row += ngw * 2) {
    const float* xr; int bm;
    if (row < NTOK_P) { xr = p.x_prompt + (size_t)row * 1024; bm = row >> 11; }
    else { xr = p.x_sample + (size_t)(row - NTOK_P) * 1024; bm = 32 + ((row - NTOK_P) >> 6); }
    const f32x4* x4 = (const f32x4*)xr;
    const f32x4* sh4 = (const f32x4*)(mod + bm * 3072);
    const f32x4* sc4 = (const f32x4*)(mod + bm * 3072 + 1024);
    f32x4 v[2][4]; float ss0 = 0.f, ss1 = 0.f;
#pragma unroll
    for (int j = 0; j < 4; ++j) { v[0][j] = x4[lane + 64 * j]; v[1][j] = x4[256 + lane + 64 * j]; }
#pragma unroll
    for (int j = 0; j < 4; ++j) {
      ss0 += v[0][j].x * v[0][j].x + v[0][j].y * v[0][j].y + v[0][j].z * v[0][j].z + v[0][j].w * v[0][j].w;
      ss1 += v[1][j].x * v[1][j].x + v[1][j].y * v[1][j].y + v[1][j].z * v[1][j].z + v[1][j].w * v[1][j].w;
    }
#pragma unroll
    for (int o = 1; o < 64; o <<= 1) { ss0 += __shfl_xor(ss0, o); ss1 += __shfl_xor(ss1, o); }
    const float r0 = rsqrtf(ss0 * (1.f / 1024.f) + EPS), r1 = rsqrtf(ss1 * (1.f / 1024.f) + EPS);
#pragma unroll
    for (int j = 0; j < 4; ++j) {
      const int c4 = lane + 64 * j;
      const f32x4 g = g4[c4], sc = sc4[c4], sh = sh4[c4];
      const f32x4 m = g * (sc + 1.f);
      const f32x4 a = v[0][j] * r0 * m + sh, bq = v[1][j] * r1 * m + sh;
      *(u32x2*)(hb + (size_t)row * 1024 + c4 * 4) = (u32x2){pk2(a.x, a.y), pk2(a.z, a.w)};
      *(u32x2*)(hb + (size_t)(row + 1) * 1024 + c4 * 4) = (u32x2){pk2(bq.x, bq.y), pk2(bq.z, bq.w)};
    }
  }
}

#define LAS __attribute__((address_space(3)))
#define GAS __attribute__((address_space(1)))
constexpr int BM = 256, BK = 64, HALF = 128, HTB = HALF * BK * 2, NXCD = 8, WGM = 8;
constexpr int XCH_OFF = 131072;
DI int lds_byte(int r, int c) { const int st = (r >> 4) * 2 + (c >> 5), rr = r & 15, cc = c & 31, ob = rr * 64 + cc * 2; return st * 1024 + (ob ^ (((ob >> 9) & 1) << 5)); }
DI void stage_rc(int b, int& R, int& C) { const int st = b / 1024, sb = b % 1024, swz = sb ^ (((sb >> 9) & 1) << 5); R = (st >> 1) * 16 + swz / 64; C = (st & 1) * 32 + (swz % 64) / 2; }
DI int perm32(int rho) { const int n = rho >> 4, i = rho & 15; return 8 * (i >> 2) + 4 * n + (i & 3); }

struct Unit { int pm, pn; };
struct StaticOrder {
  int nM, nN, nwg, G, c;
  DI void init(int M, int N, int G_, int c_) { nM = M / BM; nN = N / BM; nwg = nM * nN; G = G_; c = c_; }
  DI bool next(int i, Unit& u) const {
    const long L = (long)i * G + c; if (L >= nwg) return false;
    int wgid = (int)L; { const int q = nwg / NXCD, r = nwg % NXCD, xcd = wgid % NXCD, off = wgid / NXCD; wgid = (xcd < r ? xcd * (q + 1) : r * (q + 1) + (xcd - r) * q) + off; }
    const int nig = WGM * nN, gid = wgid / nig, fm = gid * WGM, gsz = (nM - fm) < WGM ? (nM - fm) : WGM;
    u.pm = fm + ((wgid % nig) % gsz); u.pn = (wgid % nig) / gsz; return true;
  }
};

typedef f32x4 acc_t[2][2][4][2];
template <class Epi>
DI void gemm_phase(LAS unsigned char* lds, const u16* Ag, const u16* Btg, const int K, const StaticOrder& S, const Epi& E) {
  int tid = threadIdx.x; asm volatile("" : "+v"(tid));
  const int wid = __builtin_amdgcn_readfirstlane(tid >> 6), lane = tid & 63, wr = wid >> 2, wc = wid & 3, fr = lane & 15, fq = lane >> 4;
  const int nt = K / BK;
  unsigned voffA[2], voffB[2];
#pragma unroll
  for (int i = 0; i < 2; ++i) { int R, C; stage_rc(tid * 16 + i * 8192, R, C); const int Rb = Epi::PERM ? ((R & ~31) + perm32(R & 31)) : R;
    voffA[i] = (unsigned)(R * K + C) * 2u; voffB[i] = (unsigned)(Rb * K + C) * 2u; }
  const size_t kstep = (size_t)(BK * 2);
  const size_t hstep = (size_t)HALF * K * 2;
  const size_t tstep = 2 * hstep;
  const unsigned ldsw = (unsigned)wid * 1024u;
  const int aoff = lds_byte(wr * 64 + fr, fq * 8), boff = lds_byte(wc * 32 + fr, fq * 8);
#define PG8_SA(b, h) (((b) * 2 + (h)) * HTB)
#define PG8_SB(b, h) ((4 + (b) * 2 + (h)) * HTB)
#define PG8_STAGE(bufoff, gbase, voff) do { _Pragma("unroll") for (int _i = 0; _i < 2; ++_i) \
    __builtin_amdgcn_global_load_lds((const unsigned*)((const char*)(gbase) + (voff)[_i]), (LAS unsigned*)(lds + (bufoff) + ldsw + _i * 8192), 16, 0, 0); } while (0)
#define PG8_LDA(dst, b, h) do { _Pragma("unroll") for (int m = 0; m < 4; ++m) _Pragma("unroll") for (int k = 0; k < 2; ++k) dst[m][k] = *(const LAS bf16x8*)(lds + PG8_SA(b, h) + aoff + m * 2048 + k * 1024); } while (0)
#define PG8_LDB(dst, b, h) do { _Pragma("unroll") for (int n = 0; n < 2; ++n) _Pragma("unroll") for (int k = 0; k < 2; ++k) dst[n][k] = *(const LAS bf16x8*)(lds + PG8_SB(b, h) + boff + n * 2048 + k * 1024); } while (0)
#define PG8_MMA(ai, bj, At, Bt) do { __builtin_amdgcn_s_setprio(1); _Pragma("unroll") for (int m = 0; m < 4; ++m) _Pragma("unroll") for (int n = 0; n < 2; ++n) _Pragma("unroll") for (int k = 0; k < 2; ++k) \
    acc[ai][bj][m][n] = __builtin_amdgcn_mfma_f32_16x16x32_bf16(Bt[n][k], At[m][k], acc[ai][bj][m][n], 0, 0, 0); __builtin_amdgcn_s_setprio(0); } while (0)
#define PG8_WAIT_V(n) asm volatile("s_waitcnt vmcnt(" #n ")" ::: "memory")
#define PG8_WAIT_L(n) asm volatile("s_waitcnt lgkmcnt(" #n ")" ::: "memory")
#define PG8_BAR __builtin_amdgcn_s_barrier()
#define PG8_SCHED __builtin_amdgcn_sched_barrier(0)
  Unit cur, nxt; int ui = 0;
  if (!S.next(0, cur)) return;
  f32x4 acc[2][2][4][2];
#pragma unroll
  for (int a = 0; a < 2; ++a)
#pragma unroll
    for (int b = 0; b < 2; ++b)
#pragma unroll
      for (int m = 0; m < 4; ++m)
#pragma unroll
        for (int n = 0; n < 2; ++n) acc[a][b][m][n] = (f32x4){0.f, 0.f, 0.f, 0.f};
  bf16x8 At[4][2], B0[2][2], B1[2][2];
  const char* cA = (const char*)Ag + (size_t)cur.pm * tstep; const char* cB = (const char*)Btg + (size_t)cur.pn * tstep;
  PG8_STAGE(PG8_SB(0, 0), cB, voffB); PG8_STAGE(PG8_SA(0, 0), cA, voffA); PG8_STAGE(PG8_SB(0, 1), cB + hstep, voffB); PG8_STAGE(PG8_SA(0, 1), cA + hstep, voffA);
  if (wr == 1) PG8_BAR;
  PG8_WAIT_V(4); PG8_BAR;
  PG8_STAGE(PG8_SB(1, 0), cB + kstep, voffB); PG8_STAGE(PG8_SA(1, 0), cA + kstep, voffA); PG8_STAGE(PG8_SB(1, 1), cB + hstep + kstep, voffB);
  PG8_WAIT_V(6); PG8_BAR;
  for (;;) {
    const bool has_next = S.next(ui + 1, nxt);
    const char* nA = has_next ? (const char*)Ag + (size_t)nxt.pm * tstep : cA; const char* nB = has_next ? (const char*)Btg + (size_t)nxt.pn * tstep : cB;
#pragma unroll 1
    for (int t = 0; t < nt; t += 2) {
      const bool last = (t == nt - 2);
      const char* a1 = cA + (size_t)(t + 1) * kstep;
      const char* a2 = last ? nA : cA + (size_t)(t + 2) * kstep; const char* b2 = last ? nB : cB + (size_t)(t + 2) * kstep;
      const char* a3 = a2 + kstep; const char* b3 = b2 + kstep;
      PG8_LDB(B0, 0, 0); PG8_SCHED; PG8_LDA(At, 0, 0); PG8_STAGE(PG8_SA(1, 1), a1 + hstep, voffA);
      PG8_WAIT_L(8); PG8_BAR; PG8_WAIT_L(0); PG8_MMA(0, 0, At, B0); PG8_BAR; PG8_SCHED;
      PG8_LDB(B1, 0, 1); PG8_STAGE(PG8_SB(0, 0), b2, voffB);
      PG8_BAR; PG8_WAIT_L(0); PG8_MMA(0, 1, At, B1); PG8_BAR;
      PG8_LDA(At, 0, 1); PG8_STAGE(PG8_SA(0, 0), a2, voffA);
      PG8_BAR; PG8_WAIT_L(0); PG8_MMA(1, 0, At, B0); PG8_BAR; PG8_SCHED;
      PG8_STAGE(PG8_SB(0, 1), b2 + hstep, voffB);
      PG8_WAIT_V(6); PG8_BAR; PG8_MMA(1, 1, At, B1); PG8_BAR;
      PG8_LDB(B0, 1, 0); PG8_SCHED; PG8_LDA(At, 1, 0); PG8_STAGE(PG8_SA(0, 1), a2 + hstep, voffA);
      PG8_WAIT_L(8); PG8_BAR; PG8_WAIT_L(0); PG8_MMA(0, 0, At, B0); PG8_BAR; PG8_SCHED;
      PG8_LDB(B1, 1, 1); PG8_STAGE(PG8_SB(1, 0), b3, voffB);
      PG8_BAR; PG8_WAIT_L(0); PG8_MMA(0, 1, At, B1); PG8_BAR;
      PG8_LDA(At, 1, 1); PG8_STAGE(PG8_SA(1, 0), a3, voffA);
      PG8_BAR; PG8_WAIT_L(0); PG8_MMA(1, 0, At, B0); PG8_BAR; PG8_SCHED;
      PG8_STAGE(PG8_SB(1, 1), b3 + hstep, voffB);
      PG8_WAIT_V(6); PG8_BAR; PG8_MMA(1, 1, At, B1); PG8_BAR;
    }
    E(acc, cur, wr, wc, fr, fq);
    if (!has_next) break;
#pragma unroll
    for (int a = 0; a < 2; ++a)
#pragma unroll
      for (int b = 0; b < 2; ++b)
#pragma unroll
        for (int m = 0; m < 4; ++m)
#pragma unroll
          for (int n = 0; n < 2; ++n) acc[a][b][m][n] = (f32x4){0.f, 0.f, 0.f, 0.f};
    cur = nxt; cA = nA; cB = nB; ++ui;
  }
  PG8_WAIT_V(0);
  if (wr == 0) PG8_BAR;
  PG8_BAR;
#undef PG8_SA
#undef PG8_SB
#undef PG8_STAGE
#undef PG8_LDA
#undef PG8_LDB
#undef PG8_MMA
#undef PG8_WAIT_V
#undef PG8_WAIT_L
#undef PG8_BAR
#undef PG8_SCHED
}

DI u32x4 pack8(const f32x4 a, const f32x4 b) { return (u32x4){pk2(a.x, a.y), pk2(a.z, a.w), pk2(b.x, b.y), pk2(b.z, b.w)}; }
DI float sq4(const f32x4 a) { return (a.x * a.x + a.y * a.y) + (a.z * a.z + a.w * a.w); }

DI void rowsum_xch(float (&ss)[2][4], LAS float* xch, int wr, int wc, int fr, int fq) {
#pragma unroll
  for (int ai = 0; ai < 2; ++ai)
#pragma unroll
    for (int m = 0; m < 4; ++m) { float s = ss[ai][m]; s += __shfl_xor(s, 16); s += __shfl_xor(s, 32); ss[ai][m] = s; }
  if (fq == 0) {
#pragma unroll
    for (int ai = 0; ai < 2; ++ai)
#pragma unroll
      for (int m = 0; m < 4; ++m) xch[(128 * ai + 64 * wr + 16 * m + fr) * 4 + wc] = ss[ai][m];
  }
  __syncthreads();
#pragma unroll
  for (int ai = 0; ai < 2; ++ai)
#pragma unroll
    for (int m = 0; m < 4; ++m) { const f32x4 t = *(const LAS f32x4*)(xch + (128 * ai + 64 * wr + 16 * m + fr) * 4); ss[ai][m] = (t.x + t.y) + (t.z + t.w); }
}

struct EpiG1 {
  static constexpr bool PERM = true;
  P p; LAS unsigned char* lds;
  DI void operator()(const acc_t& acc, const Unit& u, int, int, int, int) const {
    int t_ = threadIdx.x; asm volatile("" : "+v"(t_));
    const int wid_ = __builtin_amdgcn_readfirstlane(t_ >> 6), wr = wid_ >> 2, wc = wid_ & 3, fr = t_ & 15, fq = (t_ >> 4) & 3;
    GAS char* ws_ = (GAS char*)p.ws; GAS float* out_ = (GAS float*)p.out; asm volatile("" : "+s"(ws_), "+s"(out_));
    (void)out_;
    const int nt = u.pn;
    const bool samp = u.pm >= 256;
    const int row0 = u.pm * 256 + wr * 64 + fr;
    const int rl0 = samp ? row0 - NTOK_P : row0;
    const int c8 = wc * 32 + 8 * fq;
    if (nt < 2) {
      GAS u16* base = (GAS u16*)(ws_ + OFF_SBQ) + nt * 256 + c8;
#pragma unroll
      for (int ai = 0; ai < 2; ++ai)
#pragma unroll
        for (int m = 0; m < 4; ++m) { GAS u16* rp = base + (size_t)(row0 + ai * 128 + m * 16) * 512;
#pragma unroll
          for (int bj = 0; bj < 2; ++bj) *(GAS u32x4*)(rp + bj * 128) = pack8(acc[ai][bj][m][0] * QS_SB, acc[ai][bj][m][1] * QS_SB); }
    } else if (nt < 6) {
      const bool isv = nt >= 4;
      const int cb = (nt & 1) * 256 + c8;
      GAS float* ofb = out_ + (samp ? (isv ? O_SVS : O_SKS) : (isv ? O_SVP : O_SKP)) + cb;
#pragma unroll
      for (int ai = 0; ai < 2; ++ai)
#pragma unroll
        for (int m = 0; m < 4; ++m) { GAS float* of = ofb + (size_t)(rl0 + ai * 128 + m * 16) * 512;
#pragma unroll
          for (int bj = 0; bj < 2; ++bj) { *(GAS f32x4*)(of + bj * 128) = acc[ai][bj][m][0]; *(GAS f32x4*)(of + bj * 128 + 4) = acc[ai][bj][m][1];
          } }
    } else if (nt < 8 || nt >= 11) {
      const int cb = (nt < 8 ? (nt - 6) * 256 : 512 + (nt - 11) * 256) + c8;
      GAS u16* base = (GAS u16*)(ws_ + OFF_GATES) + cb;
#pragma unroll
      for (int ai = 0; ai < 2; ++ai)
#pragma unroll
        for (int m = 0; m < 4; ++m) { GAS u16* rp = base + (size_t)(row0 + ai * 128 + m * 16) * 1024;
#pragma unroll
          for (int bj = 0; bj < 2; ++bj) { f32x4 a = acc[ai][bj][m][0], b = acc[ai][bj][m][1];
            a.x = silu_f(a.x); a.y = silu_f(a.y); a.z = silu_f(a.z); a.w = silu_f(a.w); b.x = silu_f(b.x); b.y = silu_f(b.y); b.z = silu_f(b.z); b.w = silu_f(b.w);
            *(GAS u32x4*)(rp + bj * 128) = pack8(a, b); } }
    } else if (nt == 8 || nt == 9) {
      const int part = nt - 8;
      float ss[2][4];
#pragma unroll
      for (int ai = 0; ai < 2; ++ai)
#pragma unroll
        for (int m = 0; m < 4; ++m) { float s = sq4(acc[ai][0][m][0]) + sq4(acc[ai][0][m][1]); if (part == 0) s += sq4(acc[ai][1][m][0]) + sq4(acc[ai][1][m][1]); ss[ai][m] = s; }
      rowsum_xch(ss, (LAS float*)(lds + XCH_OFF), wr, wc, fr, fq);
      GAS float* cqss = (GAS float*)(ws_ + OFF_CQSS) + (size_t)part * NTOK;
      if (wc == 0 && fq == 0) {
#pragma unroll
        for (int ai = 0; ai < 2; ++ai)
#pragma unroll
          for (int m = 0; m < 4; ++m) cqss[row0 + ai * 128 + m * 16] = ss[ai][m];
      }
      GAS u16* base = (GAS u16*)(ws_ + OFF_CQ) + part * 256 + c8;
#pragma unroll
      for (int ai = 0; ai < 2; ++ai)
#pragma unroll
        for (int m = 0; m < 4; ++m) { GAS u16* rp = base + (size_t)(row0 + ai * 128 + m * 16) * 384;
          *(GAS u32x4*)(rp) = pack8(acc[ai][0][m][0], acc[ai][0][m][1]);
          if (part == 0) *(GAS u32x4*)(rp + 128) = pack8(acc[ai][1][m][0], acc[ai][1][m][1]); }
      if (part == 1 && wc == 0) {
        const GAS float* tab = (const GAS float*)(ws_ + OFF_ROPE);
        GAS float* okr = out_ + (samp ? O_KRS : O_KRP);
        GAS u16* kr = (GAS u16*)(ws_ + OFF_KROPE);
        const int i0 = (8 * fq) & 15;
#pragma unroll
        for (int ai = 0; ai < 2; ++ai)
#pragma unroll
          for (int m = 0; m < 4; ++m) {
            const int row = row0 + ai * 128 + m * 16, rl = rl0 + ai * 128 + m * 16;
            const int ridx = samp ? 2048 + (rl & 63) : (rl & 2047);
            f32x4 o[2];
#pragma unroll
            for (int n = 0; n < 2; ++n) {
              const f32x4 cs = *(const GAS f32x4*)(tab + ridx * 32 + i0 + 4 * n), sn = *(const GAS f32x4*)(tab + ridx * 32 + 16 + i0 + 4 * n);
              const f32x4 mine = acc[ai][1][m][n];
              f32x4 oth; oth.x = __shfl_xor(mine.x, 32); oth.y = __shfl_xor(mine.y, 32); oth.z = __shfl_xor(mine.z, 32); oth.w = __shfl_xor(mine.w, 32);
              o[n] = (fq < 2) ? (mine * cs - oth * sn) : (mine * cs + oth * sn);
            }
            *(GAS f32x4*)(okr + (size_t)rl * 32 + 8 * fq) = o[0]; *(GAS f32x4*)(okr + (size_t)rl * 32 + 8 * fq + 4) = o[1];
            *(GAS u32x4*)(kr + (size_t)row * 32 + 8 * fq) = pack8(o[0], o[1]);
          }
      }
    } else {
      float ss[2][4];
#pragma unroll
      for (int ai = 0; ai < 2; ++ai)
#pragma unroll
        for (int m = 0; m < 4; ++m) ss[ai][m] = (sq4(acc[ai][0][m][0]) + sq4(acc[ai][0][m][1])) + (sq4(acc[ai][1][m][0]) + sq4(acc[ai][1][m][1]));
      rowsum_xch(ss, (LAS float*)(lds + XCH_OFF), wr, wc, fr, fq);
      GAS float* ofb = out_ + (samp ? O_CKVS : O_CKVP) + c8;
      GAS u16* base = (GAS u16*)(ws_ + OFF_CKV) + c8;
      f32x4 gv[2][2];
#pragma unroll
      for (int bj = 0; bj < 2; ++bj)
#pragma unroll
        for (int n = 0; n < 2; ++n) gv[bj][n] = *(const f32x4*)(p.kv_norm_g + bj * 128 + c8 + 4 * n);
#pragma unroll
      for (int ai = 0; ai < 2; ++ai)
#pragma unroll
        for (int m = 0; m < 4; ++m) {
          const float r = rsqrtf(ss[ai][m] * (1.f / 256.f) + EPS);
          GAS float* of = ofb + (size_t)(rl0 + ai * 128 + m * 16) * 256; GAS u16* rp = base + (size_t)(row0 + ai * 128 + m * 16) * 256;
#pragma unroll
          for (int bj = 0; bj < 2; ++bj) {
            const f32x4 a = acc[ai][bj][m][0] * r * gv[bj][0], b = acc[ai][bj][m][1] * r * gv[bj][1];
            *(GAS f32x4*)(of + bj * 128) = a; *(GAS f32x4*)(of + bj * 128 + 4) = b;
            *(GAS u32x4*)(rp + bj * 128) = pack8(a, b);
          }
        }
    }
  }
};

struct EpiG2 {
  static constexpr bool PERM = false;
  P p;
  DI void operator()(const acc_t& acc, const Unit& u, int, int, int, int) const {
    int t_ = threadIdx.x; asm volatile("" : "+v"(t_));
    const int wid_ = __builtin_amdgcn_readfirstlane(t_ >> 6), wr = wid_ >> 2, wc = wid_ & 3, fr = t_ & 15, fq = (t_ >> 4) & 3;
    GAS char* ws_ = (GAS char*)p.ws; GAS float* out_ = (GAS float*)p.out; asm volatile("" : "+s"(ws_), "+s"(out_));
    (void)out_;
    const bool samp = u.pm >= 256;
    const int row0 = u.pm * 256 + wr * 64 + fr;
    const GAS float* cqss = (const GAS float*)(ws_ + OFF_CQSS);
    const GAS float* tab = (const GAS float*)(ws_ + OFF_ROPE);
    GAS u16* dst = (GAS u16*)(ws_ + OFF_QMLA);
#pragma unroll
    for (int ai = 0; ai < 2; ++ai)
#pragma unroll
      for (int m = 0; m < 4; ++m) {
        const int row = row0 + ai * 128 + m * 16;
        const float r = rsqrtf((cqss[row] + cqss[NTOK + row]) * (1.f / 384.f) + EPS) * QS_MLA;
        const int ridx = samp ? 2048 + ((row - NTOK_P) & 63) : (row & 2047);
#pragma unroll
        for (int bj = 0; bj < 2; ++bj) {
          const int gi = u.pn * 8 + bj * 4 + wc;
          f32x4 x1 = acc[ai][bj][m][0] * r, x2 = acc[ai][bj][m][1] * r;
          if (gi % 3 == 2) {
            const f32x4 cs = *(const GAS f32x4*)(tab + ridx * 32 + 4 * fq), sn = *(const GAS f32x4*)(tab + ridx * 32 + 16 + 4 * fq);
            const f32x4 o1 = x1 * cs - x2 * sn, o2 = x2 * cs + x1 * sn;
            x1 = o1; x2 = o2;
          }
          GAS u16* rp = dst + (size_t)row * 768 + gi * 32 + 4 * fq;
          *(GAS u32x2*)(rp) = (u32x2){pk2(x1.x, x1.y), pk2(x1.z, x1.w)};
          *(GAS u32x2*)(rp + 16) = (u32x2){pk2(x2.x, x2.y), pk2(x2.z, x2.w)};
        }
        __builtin_amdgcn_sched_barrier(0);
      }
  }
};

struct EpiG3 {
  static constexpr bool PERM = true;
  P p;
  DI void operator()(const acc_t& acc, const Unit& u, int, int, int, int) const {
    int t_ = threadIdx.x; asm volatile("" : "+v"(t_));
    const int wid_ = __builtin_amdgcn_readfirstlane(t_ >> 6), wr = wid_ >> 2, wc = wid_ & 3, fr = t_ & 15, fq = (t_ >> 4) & 3;
    GAS char* ws_ = (GAS char*)p.ws; GAS float* out_ = (GAS float*)p.out; asm volatile("" : "+s"(ws_), "+s"(out_));
    (void)out_;
    GAS u16* base = (GAS u16*)(ws_ + OFF_KV) + u.pn * 256 + wc * 32 + 8 * fq;
    const int row0 = u.pm * 256 + wr * 64 + fr;
#pragma unroll
    for (int ai = 0; ai < 2; ++ai)
#pragma unroll
      for (int m = 0; m < 4; ++m) { GAS u16* rp = base + (size_t)(row0 + ai * 128 + m * 16) * 1024;
#pragma unroll
        for (int bj = 0; bj < 2; ++bj) *(GAS u32x4*)(rp + bj * 128) = pack8(acc[ai][bj][m][0], acc[ai][bj][m][1]); }
  }
};

struct EpiG4 {
  static constexpr bool PERM = true;
  P p; LAS unsigned char* lds;
  DI void operator()(const acc_t& acc, const Unit& u, int, int, int, int) const {
    int t_ = threadIdx.x; asm volatile("" : "+v"(t_));
    const int wid_ = __builtin_amdgcn_readfirstlane(t_ >> 6), wr = wid_ >> 2, wc = wid_ & 3, fr = t_ & 15, fq = (t_ >> 4) & 3;
    GAS char* ws_ = (GAS char*)p.ws; GAS float* out_ = (GAS float*)p.out; asm volatile("" : "+s"(ws_), "+s"(out_));
    (void)out_;
    const int row0 = u.pm * 256 + wr * 64 + fr;
    float ss[2][4];
#pragma unroll
    for (int ai = 0; ai < 2; ++ai)
#pragma unroll
      for (int m = 0; m < 4; ++m) ss[ai][m] = (sq4(acc[ai][0][m][0]) + sq4(acc[ai][0][m][1])) + (sq4(acc[ai][1][m][0]) + sq4(acc[ai][1][m][1]));
    rowsum_xch(ss, (LAS float*)(lds + XCH_OFF), wr, wc, fr, fq);
    GAS float* rss = (GAS float*)(ws_ + OFF_ROWSS) + (size_t)u.pn * NTOK;
    if (wc == 0 && fq == 0) {
#pragma unroll
      for (int ai = 0; ai < 2; ++ai)
#pragma unroll
        for (int m = 0; m < 4; ++m) rss[row0 + ai * 128 + m * 16] = ss[ai][m];
    }
    GAS u16* base = (GAS u16*)(ws_ + OFF_GATES) + u.pn * 256 + wc * 32 + 8 * fq;
#pragma unroll
    for (int ai = 0; ai < 2; ++ai)
#pragma unroll
      for (int m = 0; m < 4; ++m) { GAS u16* rp = base + (size_t)(row0 + ai * 128 + m * 16) * 1024;
#pragma unroll
        for (int bj = 0; bj < 2; ++bj) *(GAS u32x4*)(rp + bj * 128) = pack8(acc[ai][bj][m][0], acc[ai][bj][m][1]); }
  }
};

DI void gemm_g1(const P& p, char* smem) {
  StaticOrder S; S.init(NTOK, NPAD, gridDim.x, blockIdx.x);
  EpiG1 E{p, (LAS unsigned char*)smem};
  gemm_phase((LAS unsigned char*)smem, (const u16*)(p.ws + OFF_H), (const u16*)(p.ws + OFF_WIN), 1024, S, E);
}
DI void gemm_g23(const P& p, char* smem) {
  { StaticOrder S; S.init(NTOK, 768, gridDim.x, blockIdx.x);
    EpiG2 E{p};
    gemm_phase((LAS unsigned char*)smem, (const u16*)(p.ws + OFF_CQ), (const u16*)(p.ws + OFF_WUQ), 384, S, E); }
  { StaticOrder S; S.init(NKV, 1024, gridDim.x, (blockIdx.x + 128) % gridDim.x);
    EpiG3 E{p};
    gemm_phase((LAS unsigned char*)smem, (const u16*)(p.ws + OFF_CKV), (const u16*)(p.ws + OFF_WUKV), 256, S, E); }
}
DI void gemm_g4(const P& p, char* smem) {
  StaticOrder S; S.init(NTOK, 1024, gridDim.x, blockIdx.x);
  EpiG4 E{p, (LAS unsigned char*)smem};
  gemm_phase((LAS unsigned char*)smem, (const u16*)(p.ws + OFF_H), (const u16*)(p.ws + OFF_WOUT), 1024, S, E);
}

constexpr int KS_SB = 144, KS_MLA = 208, VS = 192;
constexpr int MLA_STAGE = 64 * KS_MLA + 64 * VS;
constexpr int SB_STAGE = 64 * KS_SB + 64 * VS;
constexpr int FLAG_OFF = 65536;

DI void pv_step(const char* Vt, const bf16x8 (&pb)[4], f32x16 (&o)[2], int lane) {
  const int lh = lane >> 5, q4 = (lane & 15) >> 2, p4 = lane & 3, g1 = (lane >> 4) & 1;
  const char* vb = Vt + (4 * lh + q4) * VS + 32 * g1 + 8 * p4;
#pragma unroll
  for (int ks = 0; ks < 4; ++ks) {
#pragma unroll
    for (int dvt = 0; dvt < 2; ++dvt) {
      const s16x4 lo = tr_read(vb + (ks * 16) * VS + dvt * 64);
      const s16x4 hi = tr_read(vb + (ks * 16 + 8) * VS + dvt * 64);
      const bf16x8 vf = __builtin_shufflevector(lo, hi, 0, 1, 2, 3, 4, 5, 6, 7);
      o[dvt] = MFMA32(vf, pb[ks], o[dvt]);
    }
  }
}

DI void pack_p(const f32x16 (&s)[2], bf16x8 (&pb)[4]) {
#pragma unroll
  for (int mt = 0; mt < 2; ++mt)
#pragma unroll
    for (int h = 0; h < 2; ++h) {
      u32x4 t = {pk2(s[mt][8 * h + 0], s[mt][8 * h + 1]), pk2(s[mt][8 * h + 2], s[mt][8 * h + 3]),
                 pk2(s[mt][8 * h + 4], s[mt][8 * h + 5]), pk2(s[mt][8 * h + 6], s[mt][8 * h + 7])};
      pb[mt * 2 + h] = __builtin_bit_cast(bf16x8, t);
    }
}

DI void store_o(const P& p, const f32x16 (&o)[2], float inv, size_t tok, int colbase, int lh) {
  const u16* gates = (const u16*)(p.ws + OFF_GATES);
  u16* mixed = (u16*)(p.ws + OFF_H);
#pragma unroll
  for (int dvt = 0; dvt < 2; ++dvt)
#pragma unroll
    for (int g = 0; g < 4; ++g) {
      const size_t off = tok * 1024 + colbase + dvt * 32 + g * 8 + lh * 4;
      const u32x2 gt = *(const u32x2*)(gates + off);
      u32x2 ov = {pk2(o[dvt][4 * g + 0] * inv * bflo(gt.x), o[dvt][4 * g + 1] * inv * bfhi(gt.x)),
                  pk2(o[dvt][4 * g + 2] * inv * bflo(gt.y), o[dvt][4 * g + 3] * inv * bfhi(gt.y))};
      *(u32x2*)(mixed + off) = ov;
    }
}

DI void mla_item(const P& p, char* smem, int b, int hd, int q0, bool samp) {
  int tid = threadIdx.x; asm volatile("" : "+v"(tid));
  const int w = __builtin_amdgcn_readfirstlane(tid >> 6), lane = tid & 63, l32 = lane & 31, lh = lane >> 5;
  const int nq = samp ? 64 : 256;
  const bool active = (w * 32 < nq);
  const int qw0 = q0 + w * 32;
  const size_t tokrow0 = samp ? (size_t)(NTOK_P + b * 64) : (size_t)b * 2048;
  const int nkb_blk = samp ? 65 : (q0 / 64 + 4);
  const int nkb_w = samp ? 65 : (qw0 / 64 + 1);
  const u16* kv = (const u16*)(p.ws + OFF_KV);
  const u16* krope = (const u16*)(p.ws + OFF_KROPE);
  bf16x8 qf[6];
  if (active) {
    const u16* qp = (const u16*)(p.ws + OFF_QMLA) + (tokrow0 + qw0 + l32) * 768 + hd * 96 + lh * 8;
#pragma unroll
    for (int ks = 0; ks < 6; ++ks) qf[ks] = *(const bf16x8*)(qp + ks * 16);
  } else {
#pragma unroll
    for (int ks = 0; ks < 6; ++ks) qf[ks] = (bf16x8){0, 0, 0, 0, 0, 0, 0, 0};
  }
  u32x4 rkn, rvv, rkr;
  rkr = (u32x4){0, 0, 0, 0};
  auto gload = [&](int kb) {
    const size_t trow0 = samp ? (kb < 64 ? (size_t)(NTOK + b * PAST + kb * 64) : (size_t)(NTOK_P + b * 64)) : (size_t)(b * 2048 + kb * 64);
    const size_t row = trow0 + (tid >> 3);
    const u16* base = kv + row * 1024 + hd * 128 + (tid & 7) * 8;
    rkn = *(const u32x4*)base;
    rvv = *(const u32x4*)(base + 64);
    if (tid < 256) rkr = *(const u32x4*)(krope + (trow0 + (tid >> 2)) * 32 + (tid & 3) * 8);
  };
  auto lstore = [&](int buf) {
    char* Kt = smem + buf * MLA_STAGE; char* Vt = Kt + 64 * KS_MLA;
    *(u32x4*)(Kt + (tid >> 3) * KS_MLA + (tid & 7) * 16) = rkn;
    *(u32x4*)(Vt + (tid >> 3) * VS + (tid & 7) * 16) = rvv;
    if (tid < 256) *(u32x4*)(Kt + (tid >> 2) * KS_MLA + 128 + (tid & 3) * 16) = rkr;
  };
  f32x16 o[2];
#pragma unroll
  for (int i = 0; i < 16; ++i) { o[0][i] = 0.f; o[1][i] = 0.f; }
  float mrun = -1e30f, lsum = 0.f;
  gload(0); lstore(0);
  __syncthreads();
  for (int kb = 0; kb < nkb_blk; ++kb) {
    const bool has_next = kb + 1 < nkb_blk;
    if (has_next) gload(kb + 1);
    if (active && kb < nkb_w) {
      const char* Kt = smem + (kb & 1) * MLA_STAGE; const char* Vt = Kt + 64 * KS_MLA;
      f32x16 s[2];
#pragma unroll
      for (int i = 0; i < 16; ++i) { s[0][i] = 0.f; s[1][i] = 0.f; }
      const char* kp = Kt + l32 * KS_MLA + lh * 16;
#pragma unroll
      for (int ks = 0; ks < 6; ++ks) {
        const bf16x8 a0 = *(const bf16x8*)(kp + ks * 32);
        const bf16x8 a1 = *(const bf16x8*)(kp + 32 * KS_MLA + ks * 32);
        s[0] = MFMA32(a0, qf[ks], s[0]);
        s[1] = MFMA32(a1, qf[ks], s[1]);
      }
      f32x16 e[2];
      float ps0 = 0.f, ps1 = 0.f;
      bool redo = (kb == 0);
      if (!redo) {
#pragma unroll
        for (int i = 0; i < 16; ++i) { e[0][i] = ex2(s[0][i] - mrun); e[1][i] = ex2(s[1][i] - mrun); ps0 += e[0][i]; ps1 += e[1][i]; }
        redo = (__builtin_amdgcn_ballot_w64(!(ps0 + ps1 < 1e18f)) != 0ull);
      }
      if (redo) {
        float mx = fmaxf(s[0][0], s[1][0]);
#pragma unroll
        for (int i = 1; i < 16; ++i) mx = fmaxf(mx, fmaxf(s[0][i], s[1][i]));
        mx = fmaxf(mx, __shfl_xor(mx, 32));
        const float mn = fmaxf(mrun, mx);
        const float alpha = ex2(mrun - mn);
        lsum *= alpha;
#pragma unroll
        for (int i = 0; i < 16; ++i) { o[0][i] *= alpha; o[1][i] *= alpha; }
        mrun = mn;
        ps0 = 0.f; ps1 = 0.f;
#pragma unroll
        for (int i = 0; i < 16; ++i) { e[0][i] = ex2(s[0][i] - mn); e[1][i] = ex2(s[1][i] - mn); ps0 += e[0][i]; ps1 += e[1][i]; }
      }
      lsum += ps0 + ps1;
      bf16x8 pb[4];
      pack_p(e, pb);
      pv_step(Vt, pb, o, lane);
    }
    if (has_next) lstore((kb + 1) & 1);
    __syncthreads();
  }
  if (active) {
    const float lt = lsum + __shfl_xor(lsum, 32);
    store_o(p, o, 1.f / lt, tokrow0 + qw0 + l32, 512 + hd * 64, lh);
  }
}

constexpr int SB_NS = 6;
DI void sb_item(const P& p, char* smem, int b, int hd, int q0, bool samp) {
  int tid = threadIdx.x; asm volatile("" : "+v"(tid));
  const int w = __builtin_amdgcn_readfirstlane(tid >> 6), lane = tid & 63, l32 = lane & 31, lh = lane >> 5;
  const int nq = samp ? 64 : 256;
  const bool active = (w * 32 < nq);
  const int qw0 = q0 + w * 32;
  const int qpos_w0 = samp ? PAST + qw0 : qw0;
  const size_t tokrow0 = samp ? (size_t)(NTOK_P + b * 64) : (size_t)b * 2048;
  const int dw = samp ? 64 : (q0 >> 6) + (w >> 1);
  const int d_min = samp ? 64 : (q0 >> 6), d_cnt = samp ? 1 : 4;
  int* flags = (int*)(smem + SB_NS * SB_STAGE);
  bf16x8 qf[4];
  if (active) {
    const u16* qp = (const u16*)(p.ws + OFF_SBQ) + (tokrow0 + qw0 + l32) * 512 + hd * 64 + lh * 8;
#pragma unroll
    for (int ks = 0; ks < 4; ++ks) qf[ks] = *(const bf16x8*)(qp + ks * 16);
  } else {
#pragma unroll
    for (int ks = 0; ks < 4; ++ks) qf[ks] = (bf16x8){0, 0, 0, 0, 0, 0, 0, 0};
  }
  const int r = tid >> 3, c = tid & 7;
  const float* nk = p.out + (samp ? O_SKS : O_SKP);
  const float* nv = p.out + (samp ? O_SVS : O_SVP);
  auto src_off = [&](int kb) -> size_t {
    return samp ? (kb < 64 ? ((size_t)(b * PAST + kb * 64 + r) * 8 + hd) * 64 + c * 8 : (size_t)(b * 64 + r) * 512 + hd * 64 + c * 8)
                : ((size_t)b * 2048 + (size_t)kb * 64 + r) * 512 + hd * 64 + c * 8;
  };
  {
    f32x4 pk[4][2], pv[4][2];
#pragma unroll
    for (int i = 0; i < 4; ++i) {
      if (i < d_cnt) {
        const size_t off = src_off(d_min + i);
        const f32x4* ks = (const f32x4*)(nk + off); const f32x4* vs = (const f32x4*)(nv + off);
        pk[i][0] = ks[0]; pk[i][1] = ks[1]; pv[i][0] = vs[0]; pv[i][1] = vs[1];
      }
    }
#pragma unroll
    for (int i = 0; i < 4; ++i) {
      if (i < d_cnt) {
        char* Kt = smem + ((d_min + i) % SB_NS) * SB_STAGE; char* Vt = Kt + 64 * KS_SB;
        *(u32x4*)(Kt + r * KS_SB + c * 16) = pack8(pk[i][0], pk[i][1]);
        *(u32x4*)(Vt + r * VS + c * 16) = pack8(pv[i][0], pv[i][1]);
      }
    }
  }
  f32x4 fk0, fk1, fv0, fv1;
  fk0 = fk1 = fv0 = fv1 = (f32x4){0.f, 0.f, 0.f, 0.f};
  auto gload = [&](int kb) {
    const size_t off = src_off(kb);
    const f32x4* ks = (const f32x4*)((samp ? p.cache_sb_k : nk) + off);
    const f32x4* vs = (const f32x4*)((samp ? p.cache_sb_v : nv) + off);
    fk0 = ks[0]; fk1 = ks[1]; fv0 = vs[0]; fv1 = vs[1];
  };
  auto lstore = [&](int kb) {
    char* Kt = smem + (kb % SB_NS) * SB_STAGE; char* Vt = Kt + 64 * KS_SB;
    *(u32x4*)(Kt + r * KS_SB + c * 16) = pack8(fk0, fk1);
    *(u32x4*)(Vt + r * VS + c * 16) = pack8(fv0, fv1);
  };
  f32x16 o[2];
#pragma unroll
  for (int i = 0; i < 16; ++i) { o[0][i] = 0.f; o[1][i] = 0.f; }
  float Pg = 1.f;
  bool done = false;
  __syncthreads();
  for (int t = 0;; ++t) {
    const int kbn = d_min - (t + 1);
    const bool has_next = kbn >= 0;
    if (has_next) gload(kbn);
    const int kbw = dw - t;
    if (active && !done && kbw >= 0) {
      const char* Kt = smem + (kbw % SB_NS) * SB_STAGE; const char* Vt = Kt + 64 * KS_SB;
      f32x16 s[2];
#pragma unroll
      for (int i = 0; i < 16; ++i) { s[0][i] = 0.f; s[1][i] = 0.f; }
      const char* kp = Kt + l32 * KS_SB + lh * 16;
#pragma unroll
      for (int ks = 0; ks < 4; ++ks) {
        const bf16x8 a0 = *(const bf16x8*)(kp + ks * 32);
        const bf16x8 a1 = *(const bf16x8*)(kp + 32 * KS_SB + ks * 32);
        s[0] = MFMA32(a0, qf[ks], s[0]);
        s[1] = MFMA32(a1, qf[ks], s[1]);
      }
      const int qpos = qpos_w0 + l32;
      const int kt0 = kbw * 64 + lh * 4;
      const bool diag = (kbw * 64 + 63 >= qpos_w0);
      f32x16 om[2];
#pragma unroll
      for (int mt = 0; mt < 2; ++mt)
#pragma unroll
        for (int i = 0; i < 16; ++i) {
          const float z = __builtin_amdgcn_fmed3f(s[mt][i], -126.f, 126.f);
          const float e = ex2(-z);
          const float bt = __builtin_amdgcn_rcpf(1.f + e);
          s[mt][i] = bt; om[mt][i] = e * bt;
        }
      if (__builtin_amdgcn_readfirstlane((int)diag)) {
#pragma unroll
        for (int mt = 0; mt < 2; ++mt)
#pragma unroll
          for (int i = 0; i < 16; ++i) {
            const bool cz = (kt0 + mt * 32 + (i >> 2) * 8 + (i & 3)) < qpos;
            s[mt][i] = cz ? s[mt][i] : 0.f;
            om[mt][i] = cz ? om[mt][i] : 1.f;
          }
      }
      float R[8], Ro[8];
#pragma unroll
      for (int k8 = 0; k8 < 8; ++k8) {
        const int mt = k8 >> 2, g = k8 & 3;
        R[k8] = (om[mt][4 * g] * om[mt][4 * g + 1]) * (om[mt][4 * g + 2] * om[mt][4 * g + 3]);
      }
#pragma unroll
      for (int k8 = 0; k8 < 8; ++k8) Ro[k8] = __shfl_xor(R[k8], 32);
#pragma unroll
      for (int k8 = 7; k8 >= 0; --k8) {
        const int mt = k8 >> 2, g = k8 & 3;
        const float t3 = lh == 0 ? Pg * Ro[k8] : Pg;
        const float t2 = t3 * om[mt][4 * g + 3];
        const float t1 = t2 * om[mt][4 * g + 2];
        const float t0 = t1 * om[mt][4 * g + 1];
        s[mt][4 * g + 3] *= t3;
        s[mt][4 * g + 2] *= t2;
        s[mt][4 * g + 1] *= t1;
        s[mt][4 * g + 0] *= t0;
        Pg *= R[k8] * Ro[k8];
      }
      bf16x8 pb[4];
      pack_p(s, pb);
      pv_step(Vt, pb, o, lane);
      done = (__builtin_amdgcn_ballot_w64(Pg < SB_DONE) == ~0ull);
    }
    if (lane == 0) flags[(t & 1) * 8 + w] = (!active || done || kbw < 1) ? 1 : 0;
    if (has_next) lstore(kbn);
    __syncthreads();
    int alld = 1;
#pragma unroll
    for (int i = 0; i < 8; ++i) alld &= flags[(t & 1) * 8 + i];
    if (alld) break;
  }
  if (active) store_o(p, o, 1.f, tokrow0 + qw0 + l32, hd * 64, lh);
}

DI void attn_phase(const P& p, char* smem) {
  __shared__ int s_item;
  int* ctr = (int*)(p.ws + OFF_CTR);
  constexpr int N_MS = 128, N_SS = 128, N_MP = 2048, N_SP = 2048, N_ALL = N_MS + N_SS + N_MP + N_SP;
  if (threadIdx.x == 0) s_item = atomicAdd(ctr, 1);
  __syncthreads();
  int item = s_item;
  while (item < N_ALL) {
    __syncthreads();
    int nxt = 0;
    if (threadIdx.x == 0) nxt = atomicAdd(ctr, 1);
    int it = item;
    if (it < N_MS) { mla_item(p, smem, it >> 3, it & 7, 0, true); }
    else if ((it -= N_MS) < N_SS) { sb_item(p, smem, it >> 3, it & 7, 0, true); }
    else if ((it -= N_SS) < N_MP) { const int qt = 7 - (it >> 8), bh = it & 255; mla_item(p, smem, bh >> 3, bh & 7, qt * 256, false); }
    else { it -= N_MP; const int qt = 7 - (it >> 8), bh = it & 255; sb_item(p, smem, bh >> 3, bh & 7, qt * 256, false); }
    if (threadIdx.x == 0) s_item = nxt;
    __syncthreads();
    item = s_item;
  }
}

DI void phase_fin(const P& p) {
  const int lane = threadIdx.x & 63, gw = blockIdx.x * 8 + (threadIdx.x >> 6), ngw = gridDim.x * 8;
  const float* mod = (const float*)(p.ws + OFF_MOD);
  const float* rss = (const float*)(p.ws + OFF_ROWSS);
  const u16* outp = (const u16*)(p.ws + OFF_GATES);
  const f32x4* pg4 = (const f32x4*)p.post_g;
  for (int row = gw * 2; row < NTOK; row += ngw * 2) {
    const float* xr; int bm;
    if (row < NTOK_P) { xr = p.x_prompt + (size_t)row * 1024; bm = row >> 11; }
    else { xr = p.x_sample + (size_t)(row - NTOK_P) * 1024; bm = 32 + ((row - NTOK_P) >> 6); }
    const f32x4* x4 = (const f32x4*)xr;
    const u32x2* o2 = (const u32x2*)(outp + (size_t)row * 1024);
    f32x4 xv[2][4]; u32x2 ov[2][4];
#pragma unroll
    for (int j = 0; j < 4; ++j) { xv[0][j] = x4[lane + 64 * j]; xv[1][j] = x4[256 + lane + 64 * j]; ov[0][j] = o2[lane + 64 * j]; ov[1][j] = o2[256 + lane + 64 * j]; }
    const float s0 = (rss[row] + rss[NTOK + row]) + (rss[2 * NTOK + row] + rss[3 * NTOK + row]);
    const float s1 = (rss[row + 1] + rss[NTOK + row + 1]) + (rss[2 * NTOK + row + 1] + rss[3 * NTOK + row + 1]);
    const float r0 = rsqrtf(s0 * (1.f / 1024.f) + EPS), r1 = rsqrtf(s1 * (1.f / 1024.f) + EPS);
    const f32x4* gt4 = (const f32x4*)(mod + bm * 3072 + 2048);
    f32x4* y4 = (f32x4*)(p.out + (size_t)row * 1024);
#pragma unroll
    for (int j = 0; j < 4; ++j) {
      const int c4 = lane + 64 * j;
      const f32x4 m = gt4[c4] * pg4[c4];
      const f32x4 m0 = m * r0, m1 = m * r1;
      f32x4 y;
      y.x = xv[0][j].x + m0.x * bflo(ov[0][j].x); y.y = xv[0][j].y + m0.y * bfhi(ov[0][j].x);
      y.z = xv[0][j].z + m0.z * bflo(ov[0][j].y); y.w = xv[0][j].w + m0.w * bfhi(ov[0][j].y);
      y4[c4] = y;
      y.x = xv[1][j].x + m1.x * bflo(ov[1][j].x); y.y = xv[1][j].y + m1.y * bfhi(ov[1][j].x);
      y.z = xv[1][j].z + m1.z * bflo(ov[1][j].y); y.w = xv[1][j].w + m1.w * bfhi(ov[1][j].y);
      y4[256 + c4] = y;
    }
  }
}

__global__ void __launch_bounds__(512) sbmla_fwd(P p, int ph_lo, int ph_hi) {
  extern __shared__ __attribute__((aligned(16))) char smem[];
  cg::grid_group grid = cg::this_grid();
#ifndef REP_PHASE
#define REP_PHASE -1
#endif
#define PHASE(i, call) if (ph_lo <= (i) && (i) < ph_hi) { call; \
    if (REP_PHASE == (i)) { grid.sync(); if ((i) == 4) { if (blockIdx.x == 0 && threadIdx.x == 0) *(int*)(p.ws + OFF_CTR) = 0; grid.sync(); } call; } \
    if ((i) + 1 < ph_hi) grid.sync(); }
  PHASE(0, phase0(p, smem))
  PHASE(1, phase1(p))
  PHASE(2, gemm_g1(p, smem))
  PHASE(3, gemm_g23(p, smem))
  PHASE(4, attn_phase(p, smem))
  PHASE(5, gemm_g4(p, smem))
  PHASE(6, phase_fin(p))
#undef PHASE
}

#ifndef N_LAUNCH_SPLIT
#define N_LAUNCH_SPLIT 0
#endif

extern "C" void kernel_launch(void* const* d_in, const int* in_sizes, int n_in, void* d_out, int out_size, void* d_ws, size_t ws_size,
                              hipStream_t stream) {
  static int grid_blocks = 0;
  if (grid_blocks == 0) {
    if (n_in != 18 || ws_size < WS_END) { fprintf(stderr, "kernel_launch: unexpected n_in %d or ws_size %zu (need %zu)\n", n_in, ws_size, (size_t)WS_END); grid_blocks = -1; return; }
    int dev = 0, cus = 0, per_cu = 0;
    hipGetDevice(&dev);
    hipDeviceGetAttribute(&cus, hipDeviceAttributeMultiprocessorCount, dev);
    if (hipFuncSetAttribute((const void*)sbmla_fwd, hipFuncAttributeMaxDynamicSharedMemorySize, LDS_BYTES) != hipSuccess)
      fprintf(stderr, "kernel_launch: hipFuncSetAttribute failed\n");
    if (hipOccupancyMaxActiveBlocksPerMultiprocessor(&per_cu, (const void*)sbmla_fwd, 512, LDS_BYTES) != hipSuccess || per_cu < 1) {
      fprintf(stderr, "kernel_launch: occupancy query gave %d\n", per_cu); per_cu = 1;
    }
    (void)hipGetLastError();
    grid_blocks = cus * per_cu;
    if (grid_blocks > 256) grid_blocks = 256;
    fprintf(stderr, "kernel_launch: grid %d (cus %d per_cu %d)\n", grid_blocks, cus, per_cu);
  }
  if (grid_blocks < 0) return;
  P p{};
  const float** pp = (const float**)&p;
  for (int i = 0; i < 18; ++i) pp[i] = (const float*)d_in[i];
  p.out = (float*)d_out;
  p.ws = (char*)d_ws;
#if N_LAUNCH_SPLIT
  for (int ph = 0; ph < 7; ++ph) {
    int lo = ph, hi = ph + 1;
    hipLaunchKernelGGL(sbmla_fwd, dim3(grid_blocks), dim3(512), LDS_BYTES, stream, p, lo, hi);
  }
#else
  int lo = 0, hi = 7;
  void* args[] = {&p, &lo, &hi};
  hipError_t e = hipLaunchCooperativeKernel((const void*)sbmla_fwd, dim3(grid_blocks), dim3(512), args, LDS_BYTES, stream);
  if (e != hipSuccess) fprintf(stderr, "cooperative launch failed: %s (grid %d)\n", hipGetErrorString(e), grid_blocks);
#endif
}
```

```cpp
#include <hip/hip_runtime.h>
#include <hip/hip_cooperative_groups.h>
#include <cstdio>
namespace cg = cooperative_groups;

#define DI __device__ __forceinline__
typedef unsigned short u16;
typedef short bf16x8 __attribute__((ext_vector_type(8)));
typedef short s16x4 __attribute__((ext_vector_type(4)));
typedef float f32x4 __attribute__((ext_vector_type(4)));
typedef float f32x16 __attribute__((ext_vector_type(16)));
typedef unsigned u32x4 __attribute__((ext_vector_type(4)));
typedef unsigned u32x2 __attribute__((ext_vector_type(2)));

constexpr int T_P = 2048, T_S = 64, PAST = 4096;
constexpr int NTOK_P = 65536, NTOK = 66560;
constexpr int TKS = PAST + T_S;
constexpr int NKV = NTOK_P + 16 * TKS;
constexpr int IN_COLS = 3232, NPAD = 3328;
constexpr float EPS = 1e-6f;
constexpr float LOG2E = 1.4426950408889634f;
constexpr float QS_SB = 0.125f * LOG2E;
constexpr float QS_MLA = 0.10206207261596575f * LOG2E;
constexpr float SB_DONE = 1e-13f;

constexpr size_t O_YP = 0, O_YS = 67108864, O_SKP = 68157440, O_SVP = 101711872, O_CKVP = 135266304, O_KRP = 152043520,
                 O_SKS = 154140672, O_SVS = 154664960, O_CKVS = 155189248, O_KRS = 155451392;

constexpr size_t OFF_CTR = 0;
constexpr size_t OFF_MOD = 256;
constexpr size_t OFF_ROPE = OFF_MOD + 589824;
constexpr size_t OFF_WIN = OFF_ROPE + 270336;
constexpr size_t OFF_WUQ = OFF_WIN + 6815744;
constexpr size_t OFF_WUKV = OFF_WUQ + 589824;
constexpr size_t OFF_WOUT = OFF_WUKV + 524288;
constexpr size_t OFF_CQSS = OFF_WOUT + 2097152;
constexpr size_t OFF_ROWSS = OFF_CQSS + 532480;
constexpr size_t OFF_H = OFF_ROWSS + 1064960;
constexpr size_t OFF_GATES = OFF_H + 136314880;
constexpr size_t OFF_SBQ = OFF_GATES + 136314880;
constexpr size_t OFF_SBK = OFF_SBQ + 68157440;
constexpr size_t OFF_SBV = OFF_SBK + 68157440;
constexpr size_t OFF_CQ = OFF_SBV + 68157440;
constexpr size_t OFF_CKV = OFF_CQ + 51118080;
constexpr size_t OFF_KROPE = OFF_CKV + 67633152;
constexpr size_t OFF_QMLA = OFF_KROPE + 8454144;
constexpr size_t OFF_KV = OFF_QMLA + 102236160;
constexpr size_t WS_END = OFF_KV + 270532608;

constexpr int LDS_BYTES = 131072 + 4096;

struct P {
  const float *x_prompt, *x_sample, *cache_sb_k, *cache_sb_v, *cache_ckv, *cache_krope, *c_prompt, *c_sample,
      *ada_w, *ada_b, *pre_g, *w_in, *q_norm_g, *w_uq, *kv_norm_g, *w_ukv, *w_out, *post_g;
  float* out;
  char* ws;
};

DI unsigned pk2(float a, float b) {
  typedef __bf16 bf2 __attribute__((ext_vector_type(2)));
  typedef float f2 __attribute__((ext_vector_type(2)));
  f2 v = {a, b};
  bf2 r = __builtin_convertvector(v, bf2);
  return __builtin_bit_cast(unsigned, r);
}
DI u16 bf1(float a) { return (u16)(pk2(a, 0.f) & 0xffffu); }
DI float bflo(unsigned v) { return __uint_as_float(v << 16); }
DI float bfhi(unsigned v) { return __uint_as_float(v & 0xffff0000u); }
DI float silu_f(float x) { return x * __builtin_amdgcn_rcpf(1.f + __builtin_amdgcn_exp2f(-1.4426950408889634f * x)); }
DI float ex2(float x) { return __builtin_amdgcn_exp2f(x); }
DI float lg2(float x) { return __builtin_amdgcn_logf(x); }
DI float wave_sum(float v) {
#pragma unroll
  for (int o = 1; o < 64; o <<= 1) v += __shfl_xor(v, o);
  return v;
}
#define MFMA32(a, b, c) __builtin_amdgcn_mfma_f32_32x32x16_bf16((a), (b), (c), 0, 0, 0)
#define MFMA16(a, b, c) __builtin_amdgcn_mfma_f32_16x16x32_bf16((a), (b), (c), 0, 0, 0)

typedef __attribute__((address_space(3))) s16x4* lds_s16x4_ptr;
DI s16x4 tr_read(const char* ptr) {
  return __builtin_amdgcn_ds_read_tr16_b64_v4i16((lds_s16x4_ptr)(unsigned)(size_t)ptr);
}

DI int win_src_col(int p) {
  if (p < 2432) return p;
  if (p < 2464) return 2688 + (p - 2432);
  if (p < 2560) return -1;
  if (p < 2816) return 2432 + (p - 2560);
  return 2720 + (p - 2816);
}

DI void transpose_w(const float* __restrict__ W, int K, int N, int NP, u16* __restrict__ Wt, const float* __restrict__ kscale,
                    bool perm, int gtid, int gstride) {
  const int nk8 = K / 8;
  for (int e = gtid; e < NP * nk8; e += gstride) {
    const int pcol = e % NP, k8 = e / NP;
    const int c = perm ? win_src_col(pcol) : pcol;
    float v[8];
#pragma unroll
    for (int i = 0; i < 8; ++i) {
      float x = (c >= 0) ? W[(size_t)(k8 * 8 + i) * N + c] : 0.f;
      if (kscale) x *= kscale[k8 * 8 + i];
      v[i] = x;
    }
    u32x4 o = {pk2(v[0], v[1]), pk2(v[2], v[3]), pk2(v[4], v[5]), pk2(v[6], v[7])};
    *(u32x4*)(Wt + (size_t)pcol * K + k8 * 8) = o;
  }
}

DI void mod_job(const P& p, int job, float* lds) {
  const int cc = job % 48, bh = job / 48;
  const int tid = threadIdx.x, lane = tid & 63, w = tid >> 6;
  float* mod = (float*)(p.ws + OFF_MOD);
  __syncthreads();
  for (int e = tid; e < 24 * 1024; e += 512) {
    const int bl = e >> 10, k = e & 1023;
    const int b = bh * 24 + bl;
    const float cv = b < 32 ? p.c_prompt[b * 1024 + k] : p.c_sample[(b - 32) * 1024 + k];
    lds[k * 24 + bl] = silu_f(cv);
  }
  __syncthreads();
  float acc[24];
#pragma unroll
  for (int i = 0; i < 24; ++i) acc[i] = 0.f;
  const int col = cc * 64 + lane;
  for (int k = w * 128; k < w * 128 + 128; k += 16) {
    float wv[16];
#pragma unroll
    for (int u = 0; u < 16; ++u) wv[u] = p.ada_w[(size_t)(k + u) * 3072 + col];
#pragma unroll
    for (int u = 0; u < 16; ++u) {
      const f32x4* s4 = (const f32x4*)(lds + (k + u) * 24);
#pragma unroll
      for (int q = 0; q < 6; ++q) {
        const f32x4 s = s4[q];
        acc[q * 4 + 0] += s.x * wv[u]; acc[q * 4 + 1] += s.y * wv[u]; acc[q * 4 + 2] += s.z * wv[u]; acc[q * 4 + 3] += s.w * wv[u];
      }
    }
  }
  __syncthreads();
#pragma unroll
  for (int i = 0; i < 24; ++i) lds[(w * 24 + i) * 64 + lane] = acc[i];
  __syncthreads();
  for (int e = tid; e < 24 * 64; e += 512) {
    const int bl = e >> 6, l = e & 63;
    float s = 0.f;
#pragma unroll
    for (int ww = 0; ww < 8; ++ww) s += lds[(ww * 24 + bl) * 64 + l];
    const int b = bh * 24 + bl, c = cc * 64 + l;
    mod[b * 3072 + c] = s + p.ada_b[c];
  }
  __syncthreads();
}

DI void phase0(const P& p, char* smem) {
  const int tid = threadIdx.x;
  if (blockIdx.x == 0 && tid < 32) { ((int*)(p.ws + OFF_CTR))[tid] = 0; }
  for (int job = blockIdx.x; job < 96; job += gridDim.x) mod_job(p, job, (float*)smem);
  const bool split = gridDim.x >= 192;
  if (split && blockIdx.x < 96) return;
  const int gtid = (split ? blockIdx.x - 96 : blockIdx.x) * 512 + tid, gstride = (split ? gridDim.x - 96 : gridDim.x) * 512;
  transpose_w(p.w_in, 1024, IN_COLS, NPAD, (u16*)(p.ws + OFF_WIN), nullptr, true, gtid, gstride);
  transpose_w(p.w_uq, 384, 768, 768, (u16*)(p.ws + OFF_WUQ), p.q_norm_g, false, gtid, gstride);
  transpose_w(p.w_ukv, 256, 1024, 1024, (u16*)(p.ws + OFF_WUKV), nullptr, false, gtid, gstride);
  transpose_w(p.w_out, 1024, 1024, 1024, (u16*)(p.ws + OFF_WOUT), nullptr, false, gtid, gstride);
  {
    u16* ckv = (u16*)(p.ws + OFF_CKV);
    for (int e = gtid; e < 16 * PAST * 32; e += gstride) {
      const int c8 = e & 31, s = (e >> 5) & 4095, b = e >> 17;
      const f32x4* src = (const f32x4*)(p.cache_ckv + ((size_t)(b * PAST + s) * 256 + c8 * 8));
      const f32x4 a = src[0], c = src[1];
      u32x4 o = {pk2(a.x, a.y), pk2(a.z, a.w), pk2(c.x, c.y), pk2(c.z, c.w)};
      *(u32x4*)(ckv + ((size_t)(NTOK + b * PAST + s) * 256 + c8 * 8)) = o;
    }
    u16* kr = (u16*)(p.ws + OFF_KROPE);
    for (int e = gtid; e < 16 * PAST * 4; e += gstride) {
      const int c8 = e & 3, s = (e >> 2) & 4095, b = e >> 14;
      const f32x4* src = (const f32x4*)(p.cache_krope + ((size_t)(b * PAST + s) * 32 + c8 * 8));
      const f32x4 a = src[0], c = src[1];
      u32x4 o = {pk2(a.x, a.y), pk2(a.z, a.w), pk2(c.x, c.y), pk2(c.z, c.w)};
      *(u32x4*)(kr + ((size_t)(NTOK + b * PAST + s) * 32 + c8 * 8)) = o;
    }
  }
  {
    float* tab = (float*)(p.ws + OFF_ROPE);
    for (int e = gtid; e < 2112 * 16; e += gstride) {
      const int idx = e >> 4, i = e & 15;
      const int pos = idx < 2048 ? idx : PAST + (idx - 2048);
      const float inv = exp2f(-(float)i * (13.287712379549449f / 16.f));
      const float ang = (float)pos * inv;
      tab[idx * 32 + i] = cosf(ang);
      tab[idx * 32 + 16 + i] = sinf(ang);
    }
  }
}

DI void phase1(const P& p) {
  const int lane = threadIdx.x & 63, gw = blockIdx.x * 8 + (threadIdx.x >> 6), ngw = gridDim.x * 8;
  const float* mod = (const float*)(p.ws + OFF_MOD);
  u16* hb = (u16*)(p.ws + OFF_H);
  const f32x4* g4 = (const f32x4*)p.pre_g;
  for (int row = gw * 2; row < NTOK; row += ngw * 2) {
    const float* xr; int bm;
    if (row < NTOK_P) { xr = p.x_prompt + (size_t)row * 1024; bm = row >> 11; }
    else { xr = p.x_sample + (size_t)(row - NTOK_P) * 1024; bm = 32 + ((row - NTOK_P) >> 6); }
    const f32x4* x4 = (const f32x4*)xr;
    const f32x4* sh4 = (const f32x4*)(mod + bm * 3072);
    const f32x4* sc4 = (const f32x4*)(mod + bm * 3072 + 1024);
    f32x4 v[2][4]; float ss0 = 0.f, ss1 = 0.f;
#pragma unroll
    for (int j = 0; j < 4; ++j) { v[0][j] = x4[lane + 64 * j]; v[1][j] = x4[256 + lane + 64 * j]; }
#pragma unroll
    for (int j = 0; j < 4; ++j) {
      ss0 += v[0][j].x * v[0][j].x + v[0][j].y * v[0][j].y + v[0][j].z * v[0][j].z + v[0][j].w * v[0][j].w;
      ss1 += v[1][j].x * v[1][j].x + v[1][j].y * v[1][j].y + v[1][j].z * v[1][j].z + v[1][j].w * v[1][j].w;
    }
#pragma unroll
    for (int o = 1; o < 64; o <<= 1) { ss0 += __shfl_xor(ss0, o); ss1 += __shfl_xor(ss1, o); }
    const float r0 = rsqrtf(ss0 * (1.f / 1024.f) + EPS), r1 = rsqrtf(ss1 * (1.f / 1024.f) + EPS);
#pragma unroll
    for (int j = 0; j < 4; ++j) {
      const int c4 = lane + 64 * j;
      const f32x4 g = g4[c4], sc = sc4[c4], sh = sh4[c4];
      const f32x4 m = g * (sc + 1.f);
      const f32x4 a = v[0][j] * r0 * m + sh, bq = v[1][j] * r1 * m + sh;
      *(u32x2*)(hb + (size_t)row * 1024 + c4 * 4) = (u32x2){pk2(a.x, a.y), pk2(a.z, a.w)};
      *(u32x2*)(hb + (size_t)(row + 1) * 1024 + c4 * 4) = (u32x2){pk2(bq.x, bq.y), pk2(bq.z, bq.w)};
    }
  }
}

#define LAS __attribute__((address_space(3)))
#define GAS __attribute__((address_space(1)))
constexpr int BM = 256, BK = 64, HALF = 128, HTB = HALF * BK * 2, NXCD = 8, WGM = 8;
constexpr int XCH_OFF = 131072;
DI int lds_byte(int r, int c) { const int st = (r >> 4) * 2 + (c >> 5), rr = r & 15, cc = c & 31, ob = rr * 64 + cc * 2; return st * 1024 + (ob ^ (((ob >> 9) & 1) << 5)); }
DI void stage_rc(int b, int& R, int& C) { const int st = b / 1024, sb = b % 1024, swz = sb ^ (((sb >> 9) & 1) << 5); R = (st >> 1) * 16 + swz / 64; C = (st & 1) * 32 + (swz % 64) / 2; }
DI int perm32(int rho) { const int n = rho >> 4, i = rho & 15; return 8 * (i >> 2) + 4 * n + (i & 3); }

struct Unit { int pm, pn; };
struct StaticOrder {
  int nM, nN, nwg, G, c;
  DI void init(int M, int N, int G_, int c_) { nM = M / BM; nN = N / BM; nwg = nM * nN; G = G_; c = c_; }
  DI bool next(int i, Unit& u) const {
    const long L = (long)i * G + c; if (L >= nwg) return false;
    int wgid = (int)L; { const int q = nwg / NXCD, r = nwg % NXCD, xcd = wgid % NXCD, off = wgid / NXCD; wgid = (xcd < r ? xcd * (q + 1) : r * (q + 1) + (xcd - r) * q) + off; }
    const int nig = WGM * nN, gid = wgid / nig, fm = gid * WGM, gsz = (nM - fm) < WGM ? (nM - fm) : WGM;
    u.pm = fm + ((wgid % nig) % gsz); u.pn = (wgid % nig) / gsz; return true;
  }
};

typedef f32x4 acc_t[2][2][4][2];
template <class Epi>
DI void gemm_phase(LAS unsigned char* lds, const u16* Ag, const u16* Btg, const int K, const StaticOrder& S, const Epi& E) {
  int tid = threadIdx.x; asm volatile("" : "+v"(tid));
  const int wid = __builtin_amdgcn_readfirstlane(tid >> 6), lane = tid & 63, wr = wid >> 2, wc = wid & 3, fr = lane & 15, fq = lane >> 4;
  const int nt = K / BK;
  unsigned voffA[2], voffB[2];
#pragma unroll
  for (int i = 0; i < 2; ++i) { int R, C; stage_rc(tid * 16 + i * 8192, R, C); const int Rb = Epi::PERM ? ((R & ~31) + perm32(R & 31)) : R;
    voffA[i] = (unsigned)(R * K + C) * 2u; voffB[i] = (unsigned)(Rb * K + C) * 2u; }
  const size_t kstep = (size_t)(BK * 2);
  const size_t hstep = (size_t)HALF * K * 2;
  const size_t tstep = 2 * hstep;
  const unsigned ldsw = (unsigned)wid * 1024u;
  const int aoff = lds_byte(wr * 64 + fr, fq * 8), boff = lds_byte(wc * 32 + fr, fq * 8);
#define PG8_SA(b, h) (((b) * 2 + (h)) * HTB)
#define PG8_SB(b, h) ((4 + (b) * 2 + (h)) * HTB)
#define PG8_STAGE(bufoff, gbase, voff) do { _Pragma("unroll") for (int _i = 0; _i < 2; ++_i) \
    __builtin_amdgcn_global_load_lds((const unsigned*)((const char*)(gbase) + (voff)[_i]), (LAS unsigned*)(lds + (bufoff) + ldsw + _i * 8192), 16, 0, 0); } while (0)
#define PG8_LDA(dst, b, h) do { _Pragma("unroll") for (int m = 0; m < 4; ++m) _Pragma("unroll") for (int k = 0; k < 2; ++k) dst[m][k] = *(const LAS bf16x8*)(lds + PG8_SA(b, h) + aoff + m * 2048 + k * 1024); } while (0)
#define PG8_LDB(dst, b, h) do { _Pragma("unroll") for (int n = 0; n < 2; ++n) _Pragma("unroll") for (int k = 0; k < 2; ++k) dst[n][k] = *(const LAS bf16x8*)(lds + PG8_SB(b, h) + boff + n * 2048 + k * 1024); } while (0)
#define PG8_MMA(ai, bj, At, Bt) do { __builtin_amdgcn_s_setprio(1); _Pragma("unroll") for (int m = 0; m < 4; ++m) _Pragma("unroll") for (int n = 0; n < 2; ++n) _Pragma("unroll") for (int k = 0; k < 2; ++k) \
    acc[ai][bj][m][n] = __builtin_amdgcn_mfma_f32_16x16x32_bf16(Bt[n][k], At[m][k], acc[ai][bj][m][n], 0, 0, 0); __builtin_amdgcn_s_setprio(0); } while (0)
#define PG8_WAIT_V(n) asm volatile("s_waitcnt vmcnt(" #n ")" ::: "memory")
#define PG8_WAIT_L(n) asm volatile("s_waitcnt lgkmcnt(" #n ")" ::: "memory")
#define PG8_BAR __builtin_amdgcn_s_barrier()
#define PG8_SCHED __builtin_amdgcn_sched_barrier(0)
  Unit cur, nxt; int ui = 0;
  if (!S.next(0, cur)) return;
  f32x4 acc[2][2][4][2];
#pragma unroll
  for (int a = 0; a < 2; ++a)
#pragma unroll
    for (int b = 0; b < 2; ++b)
#pragma unroll
      for (int m = 0; m < 4; ++m)
#pragma unroll
        for (int n = 0; n < 2; ++n) acc[a][b][m][n] = (f32x4){0.f, 0.f, 0.f, 0.f};
  bf16x8 At[4][2], B0[2][2], B1[2][2];
  const char* cA = (const char*)Ag + (size_t)cur.pm * tstep; const char* cB = (const char*)Btg + (size_t)cur.pn * tstep;
  PG8_STAGE(PG8_SB(0, 0), cB, voffB); PG8_STAGE(PG8_SA(0, 0), cA, voffA); PG8_STAGE(PG8_SB(0, 1), cB + hstep, voffB); PG8_STAGE(PG8_SA(0, 1), cA + hstep, voffA);
  if (wr == 1) PG8_BAR;
  PG8_WAIT_V(4); PG8_BAR;
  PG8_STAGE(PG8_SB(1, 0), cB + kstep, voffB); PG8_STAGE(PG8_SA(1, 0), cA + kstep, voffA); PG8_STAGE(PG8_SB(1, 1), cB + hstep + kstep, voffB);
  PG8_WAIT_V(6); PG8_BAR;
  for (;;) {
    const bool has_next = S.next(ui + 1, nxt);
    const char* nA = has_next ? (const char*)Ag + (size_t)nxt.pm * tstep : cA; const char* nB = has_next ? (const char*)Btg + (size_t)nxt.pn * tstep : cB;
#pragma unroll 1
    for (int t = 0; t < nt; t += 2) {
      const bool last = (t == nt - 2);
      const char* a1 = cA + (size_t)(t + 1) * kstep;
      const char* a2 = last ? nA : cA + (size_t)(t + 2) * kstep; const char* b2 = last ? nB : cB + (size_t)(t + 2) * kstep;
      const char* a3 = a2 + kstep; const char* b3 = b2 + kstep;
      PG8_LDB(B0, 0, 0); PG8_SCHED; PG8_LDA(At, 0, 0); PG8_STAGE(PG8_SA(1, 1), a1 + hstep, voffA);
      PG8_WAIT_L(8); PG8_BAR; PG8_WAIT_L(0); PG8_MMA(0, 0, At, B0); PG8_BAR; PG8_SCHED;
      PG8_LDB(B1, 0, 1); PG8_STAGE(PG8_SB(0, 0), b2, voffB);
      PG8_BAR; PG8_WAIT_L(0); PG8_MMA(0, 1, At, B1); PG8_BAR;
      PG8_LDA(At, 0, 1); PG8_STAGE(PG8_SA(0, 0), a2, voffA);
      PG8_BAR; PG8_WAIT_L(0); PG8_MMA(1, 0, At, B0); PG8_BAR; PG8_SCHED;
      PG8_STAGE(PG8_SB(0, 1), b2 + hstep, voffB);
      PG8_WAIT_V(6); PG8_BAR; PG8_MMA(1, 1, At, B1); PG8_BAR;
      PG8_LDB(B0, 1, 0); PG8_SCHED; PG8_LDA(At, 1, 0); PG8_STAGE(PG8_SA(0, 1), a2 + hstep, voffA);
      PG8_WAIT_L(8); PG8_BAR; PG8_WAIT_L(0); PG8_MMA(0, 0, At, B0); PG8_BAR; PG8_SCHED;
      PG8_LDB(B1, 1, 1); PG8_STAGE(PG8_SB(1, 0), b3, voffB);
      PG8_BAR; PG8_WAIT_L(0); PG8_MMA(0, 1, At, B1); PG8_BAR;
      PG8_LDA(At, 1, 1); PG8_STAGE(PG8_SA(1, 0), a3, voffA);
      PG8_BAR; PG8_WAIT_L(0); PG8_MMA(1, 0, At, B0); PG8_BAR; PG8_SCHED;
      PG8_STAGE(PG8_SB(1, 1), b3 + hstep, voffB);
      PG8_WAIT_V(6); PG8_BAR; PG8_MMA(1, 1, At, B1); PG8_BAR;
    }
    E(acc, cur, wr, wc, fr, fq);
    if (!has_next) break;
#pragma unroll
    for (int a = 0; a < 2; ++a)
#pragma unroll
      for (int b = 0; b < 2; ++b)
#pragma unroll
        for (int m = 0; m < 4; ++m)
#pragma unroll
          for (int n = 0; n < 2; ++n) acc[a][b][m][n] = (f32x4){0.f, 0.f, 0.f, 0.f};
    cur = nxt; cA = nA; cB = nB; ++ui;
  }
  PG8_WAIT_V(0);
  if (wr == 0) PG8_BAR;
  PG8_BAR;
#undef PG8_SA
#undef PG8_SB
#undef PG8_STAGE
#undef PG8_LDA
#undef PG8_LDB
#undef PG8_MMA
#undef PG8_WAIT_V
#undef PG8_WAIT_L
#undef PG8_BAR
#undef PG8_SCHED
}

DI u32x4 pack8(const f32x4 a, const f32x4 b) { return (u32x4){pk2(a.x, a.y), pk2(a.z, a.w), pk2(b.x, b.y), pk2(b.z, b.w)}; }
DI float sq4(const f32x4 a) { return (a.x * a.x + a.y * a.y) + (a.z * a.z + a.w * a.w); }

DI void rowsum_xch(float (&ss)[2][4], LAS float* xch, int wr, int wc, int fr, int fq) {
#pragma unroll
  for (int ai = 0; ai < 2; ++ai)
#pragma unroll
    for (int m = 0; m < 4; ++m) { float s = ss[ai][m]; s += __shfl_xor(s, 16); s += __shfl_xor(s, 32); ss[ai][m] = s; }
  if (fq == 0) {
#pragma unroll
    for (int ai = 0; ai < 2; ++ai)
#pragma unroll
      for (int m = 0; m < 4; ++m) xch[(128 * ai + 64 * wr + 16 * m + fr) * 4 + wc] = ss[ai][m];
  }
  __syncthreads();
#pragma unroll
  for (int ai = 0; ai < 2; ++ai)
#pragma unroll
    for (int m = 0; m < 4; ++m) { const f32x4 t = *(const LAS f32x4*)(xch + (128 * ai + 64 * wr + 16 * m + fr) * 4); ss[ai][m] = (t.x + t.y) + (t.z + t.w); }
}

struct EpiG1 {
  static constexpr bool PERM = true;
  P p; LAS unsigned char* lds;
  DI void operator()(const acc_t& acc, const Unit& u, int, int, int, int) const {
    int t_ = threadIdx.x; asm volatile("" : "+v"(t_));
    const int wid_ = __builtin_amdgcn_readfirstlane(t_ >> 6), wr = wid_ >> 2, wc = wid_ & 3, fr = t_ & 15, fq = (t_ >> 4) & 3;
    GAS char* ws_ = (GAS char*)p.ws; GAS float* out_ = (GAS float*)p.out; asm volatile("" : "+s"(ws_), "+s"(out_));
    (void)out_;
    const int nt = u.pn;
    const bool samp = u.pm >= 256;
    const int row0 = u.pm * 256 + wr * 64 + fr;
    const int rl0 = samp ? row0 - NTOK_P : row0;
    const int c8 = wc * 32 + 8 * fq;
    if (nt < 2) {
      GAS u16* base = (GAS u16*)(ws_ + OFF_SBQ) + nt * 256 + c8;
#pragma unroll
      for (int ai = 0; ai < 2; ++ai)
#pragma unroll
        for (int m = 0; m < 4; ++m) { GAS u16* rp = base + (size_t)(row0 + ai * 128 + m * 16) * 512;
#pragma unroll
          for (int bj = 0; bj < 2; ++bj) *(GAS u32x4*)(rp + bj * 128) = pack8(acc[ai][bj][m][0] * QS_SB, acc[ai][bj][m][1] * QS_SB); }
    } else if (nt < 6) {
      const bool isv = nt >= 4;
      const int cb = (nt & 1) * 256 + c8;
      GAS float* ofb = out_ + (samp ? (isv ? O_SVS : O_SKS) : (isv ? O_SVP : O_SKP)) + cb;
#pragma unroll
      for (int ai = 0; ai < 2; ++ai)
#pragma unroll
        for (int m = 0; m < 4; ++m) { GAS float* of = ofb + (size_t)(rl0 + ai * 128 + m * 16) * 512;
#pragma unroll
          for (int bj = 0; bj < 2; ++bj) { *(GAS f32x4*)(of + bj * 128) = acc[ai][bj][m][0]; *(GAS f32x4*)(of + bj * 128 + 4) = acc[ai][bj][m][1];
          } }
    } else if (nt < 8 || nt >= 11) {
      const int cb = (nt < 8 ? (nt - 6) * 256 : 512 + (nt - 11) * 256) + c8;
      GAS u16* base = (GAS u16*)(ws_ + OFF_GATES) + cb;
#pragma unroll
      for (int ai = 0; ai < 2; ++ai)
#pragma unroll
        for (int m = 0; m < 4; ++m) { GAS u16* rp = base + (size_t)(row0 + ai * 128 + m * 16) * 1024;
#pragma unroll
          for (int bj = 0; bj < 2; ++bj) { f32x4 a = acc[ai][bj][m][0], b = acc[ai][bj][m][1];
            a.x = silu_f(a.x); a.y = silu_f(a.y); a.z = silu_f(a.z); a.w = silu_f(a.w); b.x = silu_f(b.x); b.y = silu_f(b.y); b.z = silu_f(b.z); b.w = silu_f(b.w);
            *(GAS u32x4*)(rp + bj * 128) = pack8(a, b); } }
    } else if (nt == 8 || nt == 9) {
      const int part = nt - 8;
      float ss[2][4];
#pragma unroll
      for (int ai = 0; ai < 2; ++ai)
#pragma unroll
        for (int m = 0; m < 4; ++m) { float s = sq4(acc[ai][0][m][0]) + sq4(acc[ai][0][m][1]); if (part == 0) s += sq4(acc[ai][1][m][0]) + sq4(acc[ai][1][m][1]); ss[ai][m] = s; }
      rowsum_xch(ss, (LAS float*)(lds + XCH_OFF), wr, wc, fr, fq);
      GAS float* cqss = (GAS float*)(ws_ + OFF_CQSS) + (size_t)part * NTOK;
      if (wc == 0 && fq == 0) {
#pragma unroll
        for (int ai = 0; ai < 2; ++ai)
#pragma unroll
          for (int m = 0; m < 4; ++m) cqss[row0 + ai * 128 + m * 16] = ss[ai][m];
      }
      GAS u16* base = (GAS u16*)(ws_ + OFF_CQ) + part * 256 + c8;
#pragma unroll
      for (int ai = 0; ai < 2; ++ai)
#pragma unroll
        for (int m = 0; m < 4; ++m) { GAS u16* rp = base + (size_t)(row0 + ai * 128 + m * 16) * 384;
          *(GAS u32x4*)(rp) = pack8(acc[ai][0][m][0], acc[ai][0][m][1]);
          if (part == 0) *(GAS u32x4*)(rp + 128) = pack8(acc[ai][1][m][0], acc[ai][1][m][1]); }
      if (part == 1 && wc == 0) {
        const GAS float* tab = (const GAS float*)(ws_ + OFF_ROPE);
        GAS float* okr = out_ + (samp ? O_KRS : O_KRP);
        GAS u16* kr = (GAS u16*)(ws_ + OFF_KROPE);
        const int i0 = (8 * fq) & 15;
#pragma unroll
        for (int ai = 0; ai < 2; ++ai)
#pragma unroll
          for (int m = 0; m < 4; ++m) {
            const int row = row0 + ai * 128 + m * 16, rl = rl0 + ai * 128 + m * 16;
            const int ridx = samp ? 2048 + (rl & 63) : (rl & 2047);
            f32x4 o[2];
#pragma unroll
            for (int n = 0; n < 2; ++n) {
              const f32x4 cs = *(const GAS f32x4*)(tab + ridx * 32 + i0 + 4 * n), sn = *(const GAS f32x4*)(tab + ridx * 32 + 16 + i0 + 4 * n);
              const f32x4 mine = acc[ai][1][m][n];
              f32x4 oth; oth.x = __shfl_xor(mine.x, 32); oth.y = __shfl_xor(mine.y, 32); oth.z = __shfl_xor(mine.z, 32); oth.w = __shfl_xor(mine.w, 32);
              o[n] = (fq < 2) ? (mine * cs - oth * sn) : (mine * cs + oth * sn);
            }
            *(GAS f32x4*)(okr + (size_t)rl * 32 + 8 * fq) = o[0]; *(GAS f32x4*)(okr + (size_t)rl * 32 + 8 * fq + 4) = o[1];
            *(GAS u32x4*)(kr + (size_t)row * 32 + 8 * fq) = pack8(o[0], o[1]);
          }
      }
    } else {
      float ss[2][4];
#pragma unroll
      for (int ai = 0; ai < 2; ++ai)
#pragma unroll
        for (int m = 0; m < 4; ++m) ss[ai][m] = (sq4(acc[ai][0][m][0]) + sq4(acc[ai][0][m][1])) + (sq4(acc[ai][1][m][0]) + sq4(acc[ai][1][m][1]));
      rowsum_xch(ss, (LAS float*)(lds + XCH_OFF), wr, wc, fr, fq);
      GAS float* ofb = out_ + (samp ? O_CKVS : O_CKVP) + c8;
      GAS u16* base = (GAS u16*)(ws_ + OFF_CKV) + c8;
      f32x4 gv[2][2];
#pragma unroll
      for (int bj = 0; bj < 2; ++bj)
#pragma unroll
        for (int n = 0; n < 2; ++n) gv[bj][n] = *(const f32x4*)(p.kv_norm_g + bj * 128 + c8 + 4 * n);
#pragma unroll
      for (int ai = 0; ai < 2; ++ai)
#pragma unroll
        for (int m = 0; m < 4; ++m) {
          const float r = rsqrtf(ss[ai][m] * (1.f / 256.f) + EPS);
          GAS float* of = ofb + (size_t)(rl0 + ai * 128 + m * 16) * 256; GAS u16* rp = base + (size_t)(row0 + ai * 128 + m * 16) * 256;
#pragma unroll
          for (int bj = 0; bj < 2; ++bj) {
            const f32x4 a = acc[ai][bj][m][0] * r * gv[bj][0], b = acc[ai][bj][m][1] * r * gv[bj][1];
            *(GAS f32x4*)(of + bj * 128) = a; *(GAS f32x4*)(of + bj * 128 + 4) = b;
            *(GAS u32x4*)(rp + bj * 128) = pack8(a, b);
          }
        }
    }
  }
};

struct EpiG2 {
  static constexpr bool PERM = false;
  P p;
  DI void operator()(const acc_t& acc, const Unit& u, int, int, int, int) const {
    int t_ = threadIdx.x; asm volatile("" : "+v"(t_));
    const int wid_ = __builtin_amdgcn_readfirstlane(t_ >> 6), wr = wid_ >> 2, wc = wid_ & 3, fr = t_ & 15, fq = (t_ >> 4) & 3;
    GAS char* ws_ = (GAS char*)p.ws; GAS float* out_ = (GAS float*)p.out; asm volatile("" : "+s"(ws_), "+s"(out_));
    (void)out_;
    const bool samp = u.pm >= 256;
    const int row0 = u.pm * 256 + wr * 64 + fr;
    const GAS float* cqss = (const GAS float*)(ws_ + OFF_CQSS);
    const GAS float* tab = (const GAS float*)(ws_ + OFF_ROPE);
    GAS u16* dst = (GAS u16*)(ws_ + OFF_QMLA);
#pragma unroll
    for (int ai = 0; ai < 2; ++ai)
#pragma unroll
      for (int m = 0; m < 4; ++m) {
        const int row = row0 + ai * 128 + m * 16;
        const float r = rsqrtf((cqss[row] + cqss[NTOK + row]) * (1.f / 384.f) + EPS) * QS_MLA;
        const int ridx = samp ? 2048 + ((row - NTOK_P) & 63) : (row & 2047);
#pragma unroll
        for (int bj = 0; bj < 2; ++bj) {
          const int gi = u.pn * 8 + bj * 4 + wc;
          f32x4 x1 = acc[ai][bj][m][0] * r, x2 = acc[ai][bj][m][1] * r;
          if (gi % 3 == 2) {
            const f32x4 cs = *(const GAS f32x4*)(tab + ridx * 32 + 4 * fq), sn = *(const GAS f32x4*)(tab + ridx * 32 + 16 + 4 * fq);
            const f32x4 o1 = x1 * cs - x2 * sn, o2 = x2 * cs + x1 * sn;
            x1 = o1; x2 = o2;
          }
          GAS u16* rp = dst + (size_t)row * 768 + gi * 32 + 4 * fq;
          *(GAS u32x2*)(rp) = (u32x2){pk2(x1.x, x1.y), pk2(x1.z, x1.w)};
          *(GAS u32x2*)(rp + 16) = (u32x2){pk2(x2.x, x2.y), pk2(x2.z, x2.w)};
        }
        __builtin_amdgcn_sched_barrier(0);
      }
  }
};

struct EpiG3 {
  static constexpr bool PERM = true;
  P p;
  DI void operator()(const acc_t& acc, const Unit& u, int, int, int, int) const {
    int t_ = threadIdx.x; asm volatile("" : "+v"(t_));
    const int wid_ = __builtin_amdgcn_readfirstlane(t_ >> 6), wr = wid_ >> 2, wc = wid_ & 3, fr = t_ & 15, fq = (t_ >> 4) & 3;
    GAS char* ws_ = (GAS char*)p.ws; GAS float* out_ = (GAS float*)p.out; asm volatile("" : "+s"(ws_), "+s"(out_));
    (void)out_;
    GAS u16* base = (GAS u16*)(ws_ + OFF_KV) + u.pn * 256 + wc * 32 + 8 * fq;
    const int row0 = u.pm * 256 + wr * 64 + fr;
#pragma unroll
    for (int ai = 0; ai < 2; ++ai)
#pragma unroll
      for (int m = 0; m < 4; ++m) { GAS u16* rp = base + (size_t)(row0 + ai * 128 + m * 16) * 1024;
#pragma unroll
        for (int bj = 0; bj < 2; ++bj) *(GAS u32x4*)(rp + bj * 128) = pack8(acc[ai][bj][m][0], acc[ai][bj][m][1]); }
  }
};

struct EpiG4 {
  static constexpr bool PERM = true;
  P p; LAS unsigned char* lds;
  DI void operator()(const acc_t& acc, const Unit& u, int, int, int, int) const {
    int t_ = threadIdx.x; asm volatile("" : "+v"(t_));
    const int wid_ = __builtin_amdgcn_readfirstlane(t_ >> 6), wr = wid_ >> 2, wc = wid_ & 3, fr = t_ & 15, fq = (t_ >> 4) & 3;
    GAS char* ws_ = (GAS char*)p.ws; GAS float* out_ = (GAS float*)p.out; asm volatile("" : "+s"(ws_), "+s"(out_));
    (void)out_;
    const int row0 = u.pm * 256 + wr * 64 + fr;
    float ss[2][4];
#pragma unroll
    for (int ai = 0; ai < 2; ++ai)
#pragma unroll
      for (int m = 0; m < 4; ++m) ss[ai][m] = (sq4(acc[ai][0][m][0]) + sq4(acc[ai][0][m][1])) + (sq4(acc[ai][1][m][0]) + sq4(acc[ai][1][m][1]));
    rowsum_xch(ss, (LAS float*)(lds + XCH_OFF), wr, wc, fr, fq);
    GAS float* rss = (GAS float*)(ws_ + OFF_ROWSS) + (size_t)u.pn * NTOK;
    if (wc == 0 && fq == 0) {
#pragma unroll
      for (int ai = 0; ai < 2; ++ai)
#pragma unroll
        for (int m = 0; m < 4; ++m) rss[row0 + ai * 128 + m * 16] = ss[ai][m];
    }
    GAS u16* base = (GAS u16*)(ws_ + OFF_GATES) + u.pn * 256 + wc * 32 + 8 * fq;
#pragma unroll
    for (int ai = 0; ai < 2; ++ai)
#pragma unroll
      for (int m = 0; m < 4; ++m) { GAS u16* rp = base + (size_t)(row0 + ai * 128 + m * 16) * 1024;
#pragma unroll
        for (int bj = 0; bj < 2; ++bj) *(GAS u32x4*)(rp + bj * 128) = pack8(acc[ai][bj][m][0], acc[ai][bj][m][1]); }
  }
};

DI void gemm_g1(const P& p, char* smem) {
  StaticOrder S; S.init(NTOK, NPAD, gridDim.x, blockIdx.x);
  EpiG1 E{p, (LAS unsigned char*)smem};
  gemm_phase((LAS unsigned char*)smem, (const u16*)(p.ws + OFF_H), (const u16*)(p.ws + OFF_WIN), 1024, S, E);
}
DI void gemm_g23(const P& p, char* smem) {
  { StaticOrder S; S.init(NTOK, 768, gridDim.x, blockIdx.x);
    EpiG2 E{p};
    gemm_phase((LAS unsigned char*)smem, (const u16*)(p.ws + OFF_CQ), (const u16*)(p.ws + OFF_WUQ), 384, S, E); }
  { StaticOrder S; S.init(NKV, 1024, gridDim.x, (blockIdx.x + 128) % gridDim.x);
    EpiG3 E{p};
    gemm_phase((LAS unsigned char*)smem, (const u16*)(p.ws + OFF_CKV), (const u16*)(p.ws + OFF_WUKV), 256, S, E); }
}
DI void gemm_g4(const P& p, char* smem) {
  StaticOrder S; S.init(NTOK, 1024, gridDim.x, blockIdx.x);
  EpiG4 E{p, (LAS unsigned char*)smem};
  gemm_phase((LAS unsigned char*)smem, (const u16*)(p.ws + OFF_H), (const u16*)(p.ws + OFF_WOUT), 1024, S, E);
}

constexpr int KS_SB = 144, KS_MLA = 208, VS = 192;
constexpr int MLA_STAGE = 64 * KS_MLA + 64 * VS;
constexpr int SB_STAGE = 64 * KS_SB + 64 * VS;
constexpr int FLAG_OFF = 65536;

DI void pv_step(const char* Vt, const bf16x8 (&pb)[4], f32x16 (&o)[2], int lane) {
  const int lh = lane >> 5, q4 = (lane & 15) >> 2, p4 = lane & 3, g1 = (lane >> 4) & 1;
  const char* vb = Vt + (4 * lh + q4) * VS + 32 * g1 + 8 * p4;
#pragma unroll
  for (int ks = 0; ks < 4; ++ks) {
#pragma unroll
    for (int dvt = 0; dvt < 2; ++dvt) {
      const s16x4 lo = tr_read(vb + (ks * 16) * VS + dvt * 64);
      const s16x4 hi = tr_read(vb + (ks * 16 + 8) * VS + dvt * 64);
      const bf16x8 vf = __builtin_shufflevector(lo, hi, 0, 1, 2, 3, 4, 5, 6, 7);
      o[dvt] = MFMA32(vf, pb[ks], o[dvt]);
    }
  }
}

DI void pack_p(const f32x16 (&s)[2], bf16x8 (&pb)[4]) {
#pragma unroll
  for (int mt = 0; mt < 2; ++mt)
#pragma unroll
    for (int h = 0; h < 2; ++h) {
      u32x4 t = {pk2(s[mt][8 * h + 0], s[mt][8 * h + 1]), pk2(s[mt][8 * h + 2], s[mt][8 * h + 3]),
                 pk2(s[mt][8 * h + 4], s[mt][8 * h + 5]), pk2(s[mt][8 * h + 6], s[mt][8 * h + 7])};
      pb[mt * 2 + h] = __builtin_bit_cast(bf16x8, t);
    }
}

DI void store_o(const P& p, const f32x16 (&o)[2], float inv, size_t tok, int colbase, int lh) {
  const u16* gates = (const u16*)(p.ws + OFF_GATES);
  u16* mixed = (u16*)(p.ws + OFF_H);
#pragma unroll
  for (int dvt = 0; dvt < 2; ++dvt)
#pragma unroll
    for (int g = 0; g < 4; ++g) {
      const size_t off = tok * 1024 + colbase + dvt * 32 + g * 8 + lh * 4;
      const u32x2 gt = *(const u32x2*)(gates + off);
      u32x2 ov = {pk2(o[dvt][4 * g + 0] * inv * bflo(gt.x), o[dvt][4 * g + 1] * inv * bfhi(gt.x)),
                  pk2(o[dvt][4 * g + 2] * inv * bflo(gt.y), o[dvt][4 * g + 3] * inv * bfhi(gt.y))};
      *(u32x2*)(mixed + off) = ov;
    }
}

DI void mla_item(const P& p, char* smem, int b, int hd, int q0, bool samp) {
  int tid = threadIdx.x; asm volatile("" : "+v"(tid));
  const int w = __builtin_amdgcn_readfirstlane(tid >> 6), lane = tid & 63, l32 = lane & 31, lh = lane >> 5;
  const bool active = samp ? (w < 4) : true;
  const int hw = samp ? hd + (w >> 1) : hd;
  const int qw0 = samp ? (w & 1) * 32 : q0 + w * 32;
  constexpr int STG = 2 * MLA_STAGE;
  const int hoff = samp ? (w >> 1) * MLA_STAGE : 0;
  const size_t tokrow0 = samp ? (size_t)(NTOK_P + b * 64) : (size_t)b * 2048;
  const int nkb_blk = samp ? 65 : (q0 / 64 + 4);
  const int nkb_w = samp ? 65 : (qw0 / 64 + 1);
  const u16* kv = (const u16*)(p.ws + OFF_KV);
  const u16* krope = (const u16*)(p.ws + OFF_KROPE);
  bf16x8 qf[6];
  if (active) {
    const u16* qp = (const u16*)(p.ws + OFF_QMLA) + (tokrow0 + qw0 + l32) * 768 + hw * 96 + lh * 8;
#pragma unroll
    for (int ks = 0; ks < 6; ++ks) qf[ks] = *(const bf16x8*)(qp + ks * 16);
  } else {
#pragma unroll
    for (int ks = 0; ks < 6; ++ks) qf[ks] = (bf16x8){0, 0, 0, 0, 0, 0, 0, 0};
  }
  u32x4 rkn, rvv, rkr, rkn2, rvv2;
  rkr = rkn2 = rvv2 = (u32x4){0, 0, 0, 0};
  auto gload = [&](int kb) {
    const size_t trow0 = samp ? (kb < 64 ? (size_t)(NTOK + b * PAST + kb * 64) : (size_t)(NTOK_P + b * 64)) : (size_t)(b * 2048 + kb * 64);
    if (samp) {
      const int h2 = tid >> 8, u = tid & 255;
      const u16* base = kv + (trow0 + (u >> 3)) * 1024 + (hd + h2) * 128 + (u & 7) * 8;
      rkn = *(const u32x4*)base; rvv = *(const u32x4*)(base + 64);
      rkn2 = *(const u32x4*)(base + 32 * 1024); rvv2 = *(const u32x4*)(base + 32 * 1024 + 64);
      rkr = *(const u32x4*)(krope + (trow0 + (u >> 2)) * 32 + (u & 3) * 8);
    } else {
      const size_t row = trow0 + (tid >> 3);
      const u16* base = kv + row * 1024 + hd * 128 + (tid & 7) * 8;
      rkn = *(const u32x4*)base;
      rvv = *(const u32x4*)(base + 64);
      if (tid < 256) rkr = *(const u32x4*)(krope + (trow0 + (tid >> 2)) * 32 + (tid & 3) * 8);
    }
  };
  auto lstore = [&](int buf) {
    if (samp) {
      const int h2 = tid >> 8, u = tid & 255;
      char* Kt = smem + buf * STG + h2 * MLA_STAGE; char* Vt = Kt + 64 * KS_MLA;
      *(u32x4*)(Kt + (u >> 3) * KS_MLA + (u & 7) * 16) = rkn;
      *(u32x4*)(Kt + (32 + (u >> 3)) * KS_MLA + (u & 7) * 16) = rkn2;
      *(u32x4*)(Vt + (u >> 3) * VS + (u & 7) * 16) = rvv;
      *(u32x4*)(Vt + (32 + (u >> 3)) * VS + (u & 7) * 16) = rvv2;
      *(u32x4*)(Kt + (u >> 2) * KS_MLA + 128 + (u & 3) * 16) = rkr;
    } else {
      char* Kt = smem + buf * STG; char* Vt = Kt + 64 * KS_MLA;
      *(u32x4*)(Kt + (tid >> 3) * KS_MLA + (tid & 7) * 16) = rkn;
      *(u32x4*)(Vt + (tid >> 3) * VS + (tid & 7) * 16) = rvv;
      if (tid < 256) *(u32x4*)(Kt + (tid >> 2) * KS_MLA + 128 + (tid & 3) * 16) = rkr;
    }
  };
  f32x16 o[2];
#pragma unroll
  for (int i = 0; i < 16; ++i) { o[0][i] = 0.f; o[1][i] = 0.f; }
  float mrun = -1e30f, lsum = 0.f;
  gload(0); lstore(0);
  __syncthreads();
  for (int kb = 0; kb < nkb_blk; ++kb) {
    const bool has_next = kb + 1 < nkb_blk;
    if (has_next) gload(kb + 1);
    if (active && kb < nkb_w) {
      const char* Kt = smem + (kb & 1) * STG + hoff; const char* Vt = Kt + 64 * KS_MLA;
      f32x16 s[2];
      const float cinit = (kb == 0) ? 0.f : -mrun;
#pragma unroll
      for (int i = 0; i < 16; ++i) { s[0][i] = cinit; s[1][i] = cinit; }
      const char* kp = Kt + l32 * KS_MLA + lh * 16;
#pragma unroll
      for (int ks = 0; ks < 6; ++ks) {
        const bf16x8 a0 = *(const bf16x8*)(kp + ks * 32);
        const bf16x8 a1 = *(const bf16x8*)(kp + 32 * KS_MLA + ks * 32);
        s[0] = MFMA32(a0, qf[ks], s[0]);
        s[1] = MFMA32(a1, qf[ks], s[1]);
      }
      f32x16 e[2];
      float ps0 = 0.f, ps1 = 0.f;
      bool redo = (kb == 0);
      if (!redo) {
#pragma unroll
        for (int i = 0; i < 16; ++i) { e[0][i] = ex2(s[0][i]); e[1][i] = ex2(s[1][i]); ps0 += e[0][i]; ps1 += e[1][i]; }
        redo = (__builtin_amdgcn_ballot_w64(!(ps0 + ps1 < 1e18f)) != 0ull);
      }
      if (redo) {
        float mx = fmaxf(s[0][0], s[1][0]);
#pragma unroll
        for (int i = 1; i < 16; ++i) mx = fmaxf(mx, fmaxf(s[0][i], s[1][i]));
        mx = fmaxf(mx, __shfl_xor(mx, 32));
        const float up = (kb == 0) ? mx : fmaxf(mx, 0.f);
        const float alpha = (kb == 0) ? 0.f : ex2(-up);
        lsum *= alpha;
#pragma unroll
        for (int i = 0; i < 16; ++i) { o[0][i] *= alpha; o[1][i] *= alpha; }
        mrun = (kb == 0) ? mx : mrun + up;
        ps0 = 0.f; ps1 = 0.f;
#pragma unroll
        for (int i = 0; i < 16; ++i) { e[0][i] = ex2(s[0][i] - up); e[1][i] = ex2(s[1][i] - up); ps0 += e[0][i]; ps1 += e[1][i]; }
      }
      lsum += ps0 + ps1;
      bf16x8 pb[4];
      pack_p(e, pb);
      pv_step(Vt, pb, o, lane);
    }
    if (has_next) lstore((kb + 1) & 1);
    __syncthreads();
  }
  if (active) {
    const float lt = lsum + __shfl_xor(lsum, 32);
    store_o(p, o, 1.f / lt, tokrow0 + qw0 + l32, 512 + hw * 64, lh);
  }
}

constexpr int SB_NS = 6;
DI void sb_item(const P& p, char* smem, int b, int hd, int q0, bool samp) {
  int tid = threadIdx.x; asm volatile("" : "+v"(tid));
  const int w = __builtin_amdgcn_readfirstlane(tid >> 6), lane = tid & 63, l32 = lane & 31, lh = lane >> 5;
  const int nq = samp ? 64 : 256;
  const bool active = (w * 32 < nq);
  const int qw0 = q0 + w * 32;
  const int qpos_w0 = samp ? PAST + qw0 : qw0;
  const size_t tokrow0 = samp ? (size_t)(NTOK_P + b * 64) : (size_t)b * 2048;
  const int dw = samp ? 64 : (q0 >> 6) + (w >> 1);
  const int d_min = samp ? 64 : (q0 >> 6), d_cnt = samp ? 1 : 4;
  int* flags = (int*)(smem + SB_NS * SB_STAGE);
  bf16x8 qf[4];
  if (active) {
    const u16* qp = (const u16*)(p.ws + OFF_SBQ) + (tokrow0 + qw0 + l32) * 512 + hd * 64 + lh * 8;
#pragma unroll
    for (int ks = 0; ks < 4; ++ks) qf[ks] = *(const bf16x8*)(qp + ks * 16);
  } else {
#pragma unroll
    for (int ks = 0; ks < 4; ++ks) qf[ks] = (bf16x8){0, 0, 0, 0, 0, 0, 0, 0};
  }
  const int r = tid >> 3, c = tid & 7;
  const float* nk = p.out + (samp ? O_SKS : O_SKP);
  const float* nv = p.out + (samp ? O_SVS : O_SVP);
  auto src_off = [&](int kb) -> size_t {
    return samp ? (kb < 64 ? ((size_t)(b * PAST + kb * 64 + r) * 8 + hd) * 64 + c * 8 : (size_t)(b * 64 + r) * 512 + hd * 64 + c * 8)
                : ((size_t)b * 2048 + (size_t)kb * 64 + r) * 512 + hd * 64 + c * 8;
  };
  {
    f32x4 pk[4][2], pv[4][2];
#pragma unroll
    for (int i = 0; i < 4; ++i) {
      if (i < d_cnt) {
        const size_t off = src_off(d_min + i);
        const f32x4* ks = (const f32x4*)(nk + off); const f32x4* vs = (const f32x4*)(nv + off);
        pk[i][0] = ks[0]; pk[i][1] = ks[1]; pv[i][0] = vs[0]; pv[i][1] = vs[1];
      }
    }
#pragma unroll
    for (int i = 0; i < 4; ++i) {
      if (i < d_cnt) {
        char* Kt = smem + ((d_min + i) % SB_NS) * SB_STAGE; char* Vt = Kt + 64 * KS_SB;
        *(u32x4*)(Kt + r * KS_SB + c * 16) = pack8(pk[i][0], pk[i][1]);
        *(u32x4*)(Vt + r * VS + c * 16) = pack8(pv[i][0], pv[i][1]);
      }
    }
  }
  f32x4 fk0, fk1, fv0, fv1;
  fk0 = fk1 = fv0 = fv1 = (f32x4){0.f, 0.f, 0.f, 0.f};
  auto gload = [&](int kb) {
    const size_t off = src_off(kb);
    const f32x4* ks = (const f32x4*)((samp ? p.cache_sb_k : nk) + off);
    const f32x4* vs = (const f32x4*)((samp ? p.cache_sb_v : nv) + off);
    fk0 = ks[0]; fk1 = ks[1]; fv0 = vs[0]; fv1 = vs[1];
  };
  auto lstore = [&](int kb) {
    char* Kt = smem + (kb % SB_NS) * SB_STAGE; char* Vt = Kt + 64 * KS_SB;
    *(u32x4*)(Kt + r * KS_SB + c * 16) = pack8(fk0, fk1);
    *(u32x4*)(Vt + r * VS + c * 16) = pack8(fv0, fv1);
  };
  f32x16 o[2];
#pragma unroll
  for (int i = 0; i < 16; ++i) { o[0][i] = 0.f; o[1][i] = 0.f; }
  float Pg = 1.f;
  bool done = false;
  __syncthreads();
  for (int t = 0;; ++t) {
    const int kbn = d_min - (t + 1);
    const bool has_next = kbn >= 0;
    if (has_next) gload(kbn);
    const int kbw = dw - t;
    if (active && !done && kbw >= 0) {
      const char* Kt = smem + (kbw % SB_NS) * SB_STAGE; const char* Vt = Kt + 64 * KS_SB;
      f32x16 s[2];
#pragma unroll
      for (int i = 0; i < 16; ++i) { s[0][i] = 0.f; s[1][i] = 0.f; }
      const char* kp = Kt + l32 * KS_SB + lh * 16;
#pragma unroll
      for (int ks = 0; ks < 4; ++ks) {
        const bf16x8 a0 = *(const bf16x8*)(kp + ks * 32);
        const bf16x8 a1 = *(const bf16x8*)(kp + 32 * KS_SB + ks * 32);
        s[0] = MFMA32(a0, qf[ks], s[0]);
        s[1] = MFMA32(a1, qf[ks], s[1]);
      }
      const int qpos = qpos_w0 + l32;
      const int kt0 = kbw * 64 + lh * 4;
      const bool diag = (kbw * 64 + 63 >= qpos_w0);
      f32x16 om[2];
#pragma unroll
      for (int mt = 0; mt < 2; ++mt)
#pragma unroll
        for (int i = 0; i < 16; ++i) {
          const float z = __builtin_amdgcn_fmed3f(s[mt][i], -126.f, 126.f);
          const float e = ex2(-z);
          const float bt = __builtin_amdgcn_rcpf(1.f + e);
          s[mt][i] = bt; om[mt][i] = e * bt;
        }
      if (__builtin_amdgcn_readfirstlane((int)diag)) {
#pragma unroll
        for (int mt = 0; mt < 2; ++mt)
#pragma unroll
          for (int i = 0; i < 16; ++i) {
            const bool cz = (kt0 + mt * 32 + (i >> 2) * 8 + (i & 3)) < qpos;
            s[mt][i] = cz ? s[mt][i] : 0.f;
            om[mt][i] = cz ? om[mt][i] : 1.f;
          }
      }
      float R[8], Ro[8];
#pragma unroll
      for (int k8 = 0; k8 < 8; ++k8) {
        const int mt = k8 >> 2, g = k8 & 3;
        R[k8] = (om[mt][4 * g] * om[mt][4 * g + 1]) * (om[mt][4 * g + 2] * om[mt][4 * g + 3]);
      }
#pragma unroll
      for (int k8 = 0; k8 < 8; ++k8) Ro[k8] = __shfl_xor(R[k8], 32);
#pragma unroll
      for (int k8 = 7; k8 >= 0; --k8) {
        const int mt = k8 >> 2, g = k8 & 3;
        const float t3 = lh == 0 ? Pg * Ro[k8] : Pg;
        const float t2 = t3 * om[mt][4 * g + 3];
        const float t1 = t2 * om[mt][4 * g + 2];
        const float t0 = t1 * om[mt][4 * g + 1];
        s[mt][4 * g + 3] *= t3;
        s[mt][4 * g + 2] *= t2;
        s[mt][4 * g + 1] *= t1;
        s[mt][4 * g + 0] *= t0;
        Pg *= R[k8] * Ro[k8];
      }
      bf16x8 pb[4];
      pack_p(s, pb);
      pv_step(Vt, pb, o, lane);
      done = (__builtin_amdgcn_ballot_w64(Pg < SB_DONE) == ~0ull);
    }
    if (lane == 0) flags[(t & 1) * 8 + w] = (!active || done || kbw < 1) ? 1 : 0;
    if (has_next) lstore(kbn);
    __syncthreads();
    int alld = 1;
#pragma unroll
    for (int i = 0; i < 8; ++i) alld &= flags[(t & 1) * 8 + i];
    if (alld) break;
  }
  if (active) store_o(p, o, 1.f, tokrow0 + qw0 + l32, hd * 64, lh);
}

DI void attn_phase(const P& p, char* smem) {
  __shared__ int s_item;
  int* ctr = (int*)(p.ws + OFF_CTR);
  constexpr int N_MS = 64, N_SS = 128, N_MP = 2048, N_SP = 2048, N_ALL = N_MS + N_SS + N_MP + N_SP;
  if (threadIdx.x == 0) s_item = atomicAdd(ctr, 1);
  __syncthreads();
  int item = s_item;
  while (item < N_ALL) {
    __syncthreads();
    int nxt = 0;
    if (threadIdx.x == 0) nxt = atomicAdd(ctr, 1);
    int it = item;
    if (it < N_MS) { mla_item(p, smem, it >> 2, (it & 3) * 2, 0, true); }
    else if ((it -= N_MS) < N_SS) { sb_item(p, smem, it >> 3, it & 7, 0, true); }
    else if ((it -= N_SS) < N_MP) { const int qt = 7 - (it >> 8), bh = it & 255; mla_item(p, smem, bh >> 3, bh & 7, qt * 256, false); }
    else { it -= N_MP; const int qt = 7 - (it >> 8), bh = it & 255; sb_item(p, smem, bh >> 3, bh & 7, qt * 256, false); }
    if (threadIdx.x == 0) s_item = nxt;
    __syncthreads();
    item = s_item;
  }
}

DI void phase_fin(const P& p) {
  const int lane = threadIdx.x & 63, gw = blockIdx.x * 8 + (threadIdx.x >> 6), ngw = gridDim.x * 8;
  const float* mod = (const float*)(p.ws + OFF_MOD);
  const float* rss = (const float*)(p.ws + OFF_ROWSS);
  const u16* outp = (const u16*)(p.ws + OFF_GATES);
  const f32x4* pg4 = (const f32x4*)p.post_g;
  for (int row = gw * 2; row < NTOK; row += ngw * 2) {
    const float* xr; int bm;
    if (row < NTOK_P) { xr = p.x_prompt + (size_t)row * 1024; bm = row >> 11; }
    else { xr = p.x_sample + (size_t)(row - NTOK_P) * 1024; bm = 32 + ((row - NTOK_P) >> 6); }
    const f32x4* x4 = (const f32x4*)xr;
    const u32x2* o2 = (const u32x2*)(outp + (size_t)row * 1024);
    f32x4 xv[2][4]; u32x2 ov[2][4];
#pragma unroll
    for (int j = 0; j < 4; ++j) { xv[0][j] = x4[lane + 64 * j]; xv[1][j] = x4[256 + lane + 64 * j]; ov[0][j] = o2[lane + 64 * j]; ov[1][j] = o2[256 + lane + 64 * j]; }
    const float s0 = (rss[row] + rss[NTOK + row]) + (rss[2 * NTOK + row] + rss[3 * NTOK + row]);
    const float s1 = (rss[row + 1] + rss[NTOK + row + 1]) + (rss[2 * NTOK + row + 1] + rss[3 * NTOK + row + 1]);
    const float r0 = rsqrtf(s0 * (1.f / 1024.f) + EPS), r1 = rsqrtf(s1 * (1.f / 1024.f) + EPS);
    const f32x4* gt4 = (const f32x4*)(mod + bm * 3072 + 2048);
    f32x4* y4 = (f32x4*)(p.out + (size_t)row * 1024);
#pragma unroll
    for (int j = 0; j < 4; ++j) {
      const int c4 = lane + 64 * j;
      const f32x4 m = gt4[c4] * pg4[c4];
      const f32x4 m0 = m * r0, m1 = m * r1;
      f32x4 y;
      y.x = xv[0][j].x + m0.x * bflo(ov[0][j].x); y.y = xv[0][j].y + m0.y * bfhi(ov[0][j].x);
      y.z = xv[0][j].z + m0.z * bflo(ov[0][j].y); y.w = xv[0][j].w + m0.w * bfhi(ov[0][j].y);
      y4[c4] = y;
      y.x = xv[1][j].x + m1.x * bflo(ov[1][j].x); y.y = xv[1][j].y + m1.y * bfhi(ov[1][j].x);
      y.z = xv[1][j].z + m1.z * bflo(ov[1][j].y); y.w = xv[1][j].w + m1.w * bfhi(ov[1][j].y);
      y4[256 + c4] = y;
    }
  }
}

__global__ void __launch_bounds__(512) sbmla_fwd(P p, int ph_lo, int ph_hi) {
  extern __shared__ __attribute__((aligned(16))) char smem[];
  cg::grid_group grid = cg::this_grid();
#ifndef REP_PHASE
#define REP_PHASE -1
#endif
#define PHASE(i, call) if (ph_lo <= (i) && (i) < ph_hi) { call; \
    if (REP_PHASE == (i)) { grid.sync(); if ((i) == 4) { if (blockIdx.x == 0 && threadIdx.x == 0) *(int*)(p.ws + OFF_CTR) = 0; grid.sync(); } call; } \
    if ((i) + 1 < ph_hi) grid.sync(); }
  PHASE(0, phase0(p, smem))
  PHASE(1, phase1(p))
  PHASE(2, gemm_g1(p, smem))
  PHASE(3, gemm_g23(p, smem))
  PHASE(4, attn_phase(p, smem))
  PHASE(5, gemm_g4(p, smem))
  PHASE(6, phase_fin(p))
#undef PHASE
}

#ifndef N_LAUNCH_SPLIT
#define N_LAUNCH_SPLIT 0
#endif

extern "C" void kernel_launch(void* const* d_in, const int* in_sizes, int n_in, void* d_out, int out_size, void* d_ws, size_t ws_size,
                              hipStream_t stream) {
  static int grid_blocks = 0;
  if (grid_blocks == 0) {
    if (n_in != 18 || ws_size < WS_END) { fprintf(stderr, "kernel_launch: unexpected n_in %d or ws_size %zu (need %zu)\n", n_in, ws_size, (size_t)WS_END); grid_blocks = -1; return; }
    int dev = 0, cus = 0, per_cu = 0;
    hipGetDevice(&dev);
    hipDeviceGetAttribute(&cus, hipDeviceAttributeMultiprocessorCount, dev);
    if (hipFuncSetAttribute((const void*)sbmla_fwd, hipFuncAttributeMaxDynamicSharedMemorySize, LDS_BYTES) != hipSuccess)
      fprintf(stderr, "kernel_launch: hipFuncSetAttribute failed\n");
    if (hipOccupancyMaxActiveBlocksPerMultiprocessor(&per_cu, (const void*)sbmla_fwd, 512, LDS_BYTES) != hipSuccess || per_cu < 1) {
      fprintf(stderr, "kernel_launch: occupancy query gave %d\n", per_cu); per_cu = 1;
    }
    (void)hipGetLastError();
    grid_blocks = cus * per_cu;
    if (grid_blocks > 256) grid_blocks = 256;
    fprintf(stderr, "kernel_launch: grid %d (cus %d per_cu %d)\n", grid_blocks, cus, per_cu);
  }
  if (grid_blocks < 0) return;
  P p{};
  const float** pp = (const float**)&p;
  for (int i = 0; i < 18; ++i) pp[i] = (const float*)d_in[i];
  p.out = (float*)d_out;
  p.ws = (char*)d_ws;
#if N_LAUNCH_SPLIT
  for (int ph = 0; ph < 7; ++ph) {
    int lo = ph, hi = ph + 1;
    hipLaunchKernelGGL(sbmla_fwd, dim3(grid_blocks), dim3(512), LDS_BYTES, stream, p, lo, hi);
  }
#else
  int lo = 0, hi = 7;
  void* args[] = {&p, &lo, &hi};
  hipError_t e = hipLaunchCooperativeKernel((const void*)sbmla_fwd, dim3(grid_blocks), dim3(512), args, LDS_BYTES, stream);
  if (e != hipSuccess) fprintf(stderr, "cooperative launch failed: %s (grid %d)\n", hipGetErrorString(e), grid_blocks);
#endif
}
```

```cpp
#include <hip/hip_runtime.h>
#include <hip/hip_cooperative_groups.h>
#include <cstdio>
namespace cg = cooperative_groups;

#define DI __device__ __forceinline__
typedef unsigned short u16;
typedef short bf16x8 __attribute__((ext_vector_type(8)));
typedef short s16x4 __attribute__((ext_vector_type(4)));
typedef float f32x4 __attribute__((ext_vector_type(4)));
typedef float f32x16 __attribute__((ext_vector_type(16)));
typedef unsigned u32x4 __attribute__((ext_vector_type(4)));
typedef unsigned u32x2 __attribute__((ext_vector_type(2)));

constexpr int T_P = 2048, T_S = 64, PAST = 4096;
constexpr int NTOK_P = 65536, NTOK = 66560;
constexpr int TKS = PAST + T_S;
constexpr int NKV = NTOK_P + 16 * TKS;
constexpr int IN_COLS = 3232, NPAD = 3328;
constexpr float EPS = 1e-6f;
constexpr float LOG2E = 1.4426950408889634f;
constexpr float QS_SB = 0.125f * LOG2E;
constexpr float QS_MLA = 0.10206207261596575f * LOG2E;
constexpr float SB_DONE = 1e-13f;

constexpr size_t O_YP = 0, O_YS = 67108864, O_SKP = 68157440, O_SVP = 101711872, O_CKVP = 135266304, O_KRP = 152043520,
                 O_SKS = 154140672, O_SVS = 154664960, O_CKVS = 155189248, O_KRS = 155451392;

constexpr size_t OFF_CTR = 0;
constexpr size_t OFF_MOD = 256;
constexpr size_t OFF_ROPE = OFF_MOD + 589824;
constexpr size_t OFF_WIN = OFF_ROPE + 270336;
constexpr size_t OFF_WUQ = OFF_WIN + 6815744;
constexpr size_t OFF_WUKV = OFF_WUQ + 589824;
constexpr size_t OFF_WOUT = OFF_WUKV + 524288;
constexpr size_t OFF_CQSS = OFF_WOUT + 2097152;
constexpr size_t OFF_ROWSS = OFF_CQSS + 532480;
constexpr size_t OFF_H = OFF_ROWSS + 1064960;
constexpr size_t OFF_GATES = OFF_H + 136314880;
constexpr size_t OFF_SBQ = OFF_GATES + 136314880;
constexpr size_t OFF_SBK = OFF_SBQ + 68157440;
constexpr size_t OFF_SBV = OFF_SBK + 68157440;
constexpr size_t OFF_CQ = OFF_SBV + 68157440;
constexpr size_t OFF_CKV = OFF_CQ + 51118080;
constexpr size_t OFF_KROPE = OFF_CKV + 67633152;
constexpr size_t OFF_QMLA = OFF_KROPE + 8454144;
constexpr size_t OFF_KV = OFF_QMLA + 102236160;
constexpr size_t WS_END = OFF_KV + 270532608;

constexpr int LDS_BYTES = 131072 + 4096;

struct P {
  const float *x_prompt, *x_sample, *cache_sb_k, *cache_sb_v, *cache_ckv, *cache_krope, *c_prompt, *c_sample,
      *ada_w, *ada_b, *pre_g, *w_in, *q_norm_g, *w_uq, *kv_norm_g, *w_ukv, *w_out, *post_g;
  float* out;
  char* ws;
};

DI unsigned pk2(float a, float b) {
  typedef __bf16 bf2 __attribute__((ext_vector_type(2)));
  typedef float f2 __attribute__((ext_vector_type(2)));
  f2 v = {a, b};
  bf2 r = __builtin_convertvector(v, bf2);
  return __builtin_bit_cast(unsigned, r);
}
DI u16 bf1(float a) { return (u16)(pk2(a, 0.f) & 0xffffu); }
DI float bflo(unsigned v) { return __uint_as_float(v << 16); }
DI float bfhi(unsigned v) { return __uint_as_float(v & 0xffff0000u); }
DI float silu_f(float x) { return x * __builtin_amdgcn_rcpf(1.f + __builtin_amdgcn_exp2f(-1.4426950408889634f * x)); }
DI float ex2(float x) { return __builtin_amdgcn_exp2f(x); }
DI float lg2(float x) { return __builtin_amdgcn_logf(x); }
DI float wave_sum(float v) {
#pragma unroll
  for (int o = 1; o < 64; o <<= 1) v += __shfl_xor(v, o);
  return v;
}
#define MFMA32(a, b, c) __builtin_amdgcn_mfma_f32_32x32x16_bf16((a), (b), (c), 0, 0, 0)
#define MFMA16(a, b, c) __builtin_amdgcn_mfma_f32_16x16x32_bf16((a), (b), (c), 0, 0, 0)

typedef __attribute__((address_space(3))) s16x4* lds_s16x4_ptr;
DI s16x4 tr_read(const char* ptr) {
  return __builtin_amdgcn_ds_read_tr16_b64_v4i16((lds_s16x4_ptr)(unsigned)(size_t)ptr);
}

DI int win_src_col(int p) {
  if (p < 2432) return p;
  if (p < 2464) return 2688 + (p - 2432);
  if (p < 2560) return -1;
  if (p < 2816) return 2432 + (p - 2560);
  return 2720 + (p - 2816);
}

DI void transpose_w(const float* __restrict__ W, int K, int N, int NP, u16* __restrict__ Wt, const float* __restrict__ kscale,
                    bool perm, int gtid, int gstride) {
  const int nk8 = K / 8;
  for (int e = gtid; e < NP * nk8; e += gstride) {
    const int pcol = e % NP, k8 = e / NP;
    const int c = perm ? win_src_col(pcol) : pcol;
    float v[8];
#pragma unroll
    for (int i = 0; i < 8; ++i) {
      float x = (c >= 0) ? W[(size_t)(k8 * 8 + i) * N + c] : 0.f;
      if (kscale) x *= kscale[k8 * 8 + i];
      v[i] = x;
    }
    u32x4 o = {pk2(v[0], v[1]), pk2(v[2], v[3]), pk2(v[4], v[5]), pk2(v[6], v[7])};
    *(u32x4*)(Wt + (size_t)pcol * K + k8 * 8) = o;
  }
}

DI void mod_job(const P& p, int job, float* lds) {
  const int cc = job % 48, bh = job / 48;
  const int tid = threadIdx.x, lane = tid & 63, w = tid >> 6;
  float* mod = (float*)(p.ws + OFF_MOD);
  __syncthreads();
  for (int e = tid; e < 24 * 1024; e += 512) {
    const int bl = e >> 10, k = e & 1023;
    const int b = bh * 24 + bl;
    const float cv = b < 32 ? p.c_prompt[b * 1024 + k] : p.c_sample[(b - 32) * 1024 + k];
    lds[k * 24 + bl] = silu_f(cv);
  }
  __syncthreads();
  float acc[24];
#pragma unroll
  for (int i = 0; i < 24; ++i) acc[i] = 0.f;
  const int col = cc * 64 + lane;
  for (int k = w * 128; k < w * 128 + 128; k += 16) {
    float wv[16];
#pragma unroll
    for (int u = 0; u < 16; ++u) wv[u] = p.ada_w[(size_t)(k + u) * 3072 + col];
#pragma unroll
    for (int u = 0; u < 16; ++u) {
      const f32x4* s4 = (const f32x4*)(lds + (k + u) * 24);
#pragma unroll
      for (int q = 0; q < 6; ++q) {
        const f32x4 s = s4[q];
        acc[q * 4 + 0] += s.x * wv[u]; acc[q * 4 + 1] += s.y * wv[u]; acc[q * 4 + 2] += s.z * wv[u]; acc[q * 4 + 3] += s.w * wv[u];
      }
    }
  }
  __syncthreads();
#pragma unroll
  for (int i = 0; i < 24; ++i) lds[(w * 24 + i) * 64 + lane] = acc[i];
  __syncthreads();
  for (int e = tid; e < 24 * 64; e += 512) {
    const int bl = e >> 6, l = e & 63;
    float s = 0.f;
#pragma unroll
    for (int ww = 0; ww < 8; ++ww) s += lds[(ww * 24 + bl) * 64 + l];
    const int b = bh * 24 + bl, c = cc * 64 + l;
    mod[b * 3072 + c] = s + p.ada_b[c];
  }
  __syncthreads();
}

DI void phase0(const P& p, char* smem) {
  const int tid = threadIdx.x;
  if (blockIdx.x == 0 && tid < 32) { ((int*)(p.ws + OFF_CTR))[tid] = 0; }
  for (int job = blockIdx.x; job < 96; job += gridDim.x) mod_job(p, job, (float*)smem);
  const bool split = gridDim.x >= 192;
  if (split && blockIdx.x < 96) return;
  const int gtid = (split ? blockIdx.x - 96 : blockIdx.x) * 512 + tid, gstride = (split ? gridDim.x - 96 : gridDim.x) * 512;
  transpose_w(p.w_in, 1024, IN_COLS, NPAD, (u16*)(p.ws + OFF_WIN), nullptr, true, gtid, gstride);
  transpose_w(p.w_uq, 384, 768, 768, (u16*)(p.ws + OFF_WUQ), p.q_norm_g, false, gtid, gstride);
  transpose_w(p.w_ukv, 256, 1024, 1024, (u16*)(p.ws + OFF_WUKV), nullptr, false, gtid, gstride);
  transpose_w(p.w_out, 1024, 1024, 1024, (u16*)(p.ws + OFF_WOUT), nullptr, false, gtid, gstride);
  {
    u16* ckv = (u16*)(p.ws + OFF_CKV);
    for (int e = gtid; e < 16 * PAST * 32; e += gstride) {
      const int c8 = e & 31, s = (e >> 5) & 4095, b = e >> 17;
      const f32x4* src = (const f32x4*)(p.cache_ckv + ((size_t)(b * PAST + s) * 256 + c8 * 8));
      const f32x4 a = src[0], c = src[1];
      u32x4 o = {pk2(a.x, a.y), pk2(a.z, a.w), pk2(c.x, c.y), pk2(c.z, c.w)};
      *(u32x4*)(ckv + ((size_t)(NTOK + b * PAST + s) * 256 + c8 * 8)) = o;
    }
    u16* kr = (u16*)(p.ws + OFF_KROPE);
    for (int e = gtid; e < 16 * PAST * 4; e += gstride) {
      const int c8 = e & 3, s = (e >> 2) & 4095, b = e >> 14;
      const f32x4* src = (const f32x4*)(p.cache_krope + ((size_t)(b * PAST + s) * 32 + c8 * 8));
      const f32x4 a = src[0], c = src[1];
      u32x4 o = {pk2(a.x, a.y), pk2(a.z, a.w), pk2(c.x, c.y), pk2(c.z, c.w)};
      *(u32x4*)(kr + ((size_t)(NTOK + b * PAST + s) * 32 + c8 * 8)) = o;
    }
  }
  {
    float* tab = (float*)(p.ws + OFF_ROPE);
    for (int e = gtid; e < 2112 * 16; e += gstride) {
      const int idx = e >> 4, i = e & 15;
      const int pos = idx < 2048 ? idx : PAST + (idx - 2048);
      const float inv = exp2f(-(float)i * (13.287712379549449f / 16.f));
      const float ang = (float)pos * inv;
      tab[idx * 32 + i] = cosf(ang);
      tab[idx * 32 + 16 + i] = sinf(ang);
    }
  }
}

DI void phase1(const P& p) {
  const int lane = threadIdx.x & 63, gw = blockIdx.x * 8 + (threadIdx.x >> 6), ngw = gridDim.x * 8;
  const float* mod = (const float*)(p.ws + OFF_MOD);
  u16* hb = (u16*)(p.ws + OFF_H);
  const f32x4* g4 = (const f32x4*)p.pre_g;
  for (int row = gw * 2; row < NTOK; row += ngw * 2) {
    const float* xr; int bm;
    if (row < NTOK_P) { xr = p.x_prompt + (size_t)row * 1024; bm = row >> 11; }
    else { xr = p.x_sample + (size_t)(row - NTOK_P) * 1024; bm = 32 + ((row - NTOK_P) >> 6); }
    const f32x4* x4 = (const f32x4*)xr;
    const f32x4* sh4 = (const f32x4*)(mod + bm * 3072);
    const f32x4* sc4 = (const f32x4*)(mod + bm * 3072 + 1024);
    f32x4 v[2][4]; float ss0 = 0.f, ss1 = 0.f;
#pragma unroll
    for (int j = 0; j < 4; ++j) { v[0][j] = __builtin_nontemporal_load(x4 + lane + 64 * j); v[1][j] = __builtin_nontemporal_load(x4 + 256 + lane + 64 * j); }
#pragma unroll
    for (int j = 0; j < 4; ++j) {
      ss0 += v[0][j].x * v[0][j].x + v[0][j].y * v[0][j].y + v[0][j].z * v[0][j].z + v[0][j].w * v[0][j].w;
      ss1 += v[1][j].x * v[1][j].x + v[1][j].y * v[1][j].y + v[1][j].z * v[1][j].z + v[1][j].w * v[1][j].w;
    }
#pragma unroll
    for (int o = 1; o < 64; o <<= 1) { ss0 += __shfl_xor(ss0, o); ss1 += __shfl_xor(ss1, o); }
    const float r0 = rsqrtf(ss0 * (1.f / 1024.f) + EPS), r1 = rsqrtf(ss1 * (1.f / 1024.f) + EPS);
#pragma unroll
    for (int j = 0; j < 4; ++j) {
      const int c4 = lane + 64 * j;
      const f32x4 g = g4[c4], sc = sc4[c4], sh = sh4[c4];
      const f32x4 m = g * (sc + 1.f);
      const f32x4 a = v[0][j] * r0 * m + sh, bq = v[1][j] * r1 * m + sh;
      *(u32x2*)(hb + (size_t)row * 1024 + c4 * 4) = (u32x2){pk2(a.x, a.y), pk2(a.z, a.w)};
      *(u32x2*)(hb + (size_t)(row + 1) * 1024 + c4 * 4) = (u32x2){pk2(bq.x, bq.y), pk2(bq.z, bq.w)};
    }
  }
}

#define LAS __attribute__((address_space(3)))
#define GAS __attribute__((address_space(1)))
constexpr int BM = 256, BK = 64, HALF = 128, HTB = HALF * BK * 2, NXCD = 8, WGM = 8;
constexpr int XCH_OFF = 131072;
DI int lds_byte(int r, int c) { const int st = (r >> 4) * 2 + (c >> 5), rr = r & 15, cc = c & 31, ob = rr * 64 + cc * 2; return st * 1024 + (ob ^ (((ob >> 9) & 1) << 5)); }
DI void stage_rc(int b, int& R, int& C) { const int st = b / 1024, sb = b % 1024, swz = sb ^ (((sb >> 9) & 1) << 5); R = (st >> 1) * 16 + swz / 64; C = (st & 1) * 32 + (swz % 64) / 2; }
DI int perm32(int rho) { const int n = rho >> 4, i = rho & 15; return 8 * (i >> 2) + 4 * n + (i & 3); }

struct Unit { int pm, pn; };
struct StaticOrder {
  int nM, nN, nwg, G, c;
  DI void init(int M, int N, int G_, int c_) { nM = M / BM; nN = N / BM; nwg = nM * nN; G = G_; c = c_; }
  DI bool next(int i, Unit& u) const {
    const long L = (long)i * G + c; if (L >= nwg) return false;
    int wgid = (int)L; { const int q = nwg / NXCD, r = nwg % NXCD, xcd = wgid % NXCD, off = wgid / NXCD; wgid = (xcd < r ? xcd * (q + 1) : r * (q + 1) + (xcd - r) * q) + off; }
    const int nig = WGM * nN, gid = wgid / nig, fm = gid * WGM, gsz = (nM - fm) < WGM ? (nM - fm) : WGM;
    u.pm = fm + ((wgid % nig) % gsz); u.pn = (wgid % nig) / gsz; return true;
  }
};

typedef f32x4 acc_t[2][2][4][2];
template <class Epi>
DI void gemm_phase(LAS unsigned char* lds, const u16* Ag, const u16* Btg, const int K, const StaticOrder& S, const Epi& E) {
  int tid = threadIdx.x; asm volatile("" : "+v"(tid));
  const int wid = __builtin_amdgcn_readfirstlane(tid >> 6), lane = tid & 63, wr = wid >> 2, wc = wid & 3, fr = lane & 15, fq = lane >> 4;
  const int nt = K / BK;
  unsigned voffA[2], voffB[2];
#pragma unroll
  for (int i = 0; i < 2; ++i) { int R, C; stage_rc(tid * 16 + i * 8192, R, C); const int Rb = Epi::PERM ? ((R & ~31) + perm32(R & 31)) : R;
    voffA[i] = (unsigned)(R * K + C) * 2u; voffB[i] = (unsigned)(Rb * K + C) * 2u; }
  const size_t kstep = (size_t)(BK * 2);
  const size_t hstep = (size_t)HALF * K * 2;
  const size_t tstep = 2 * hstep;
  const unsigned ldsw = (unsigned)wid * 1024u;
  const int aoff = lds_byte(wr * 64 + fr, fq * 8), boff = lds_byte(wc * 32 + fr, fq * 8);
#define PG8_SA(b, h) (((b) * 2 + (h)) * HTB)
#define PG8_SB(b, h) ((4 + (b) * 2 + (h)) * HTB)
#define PG8_STAGE(bufoff, gbase, voff) do { _Pragma("unroll") for (int _i = 0; _i < 2; ++_i) \
    __builtin_amdgcn_global_load_lds((const unsigned*)((const char*)(gbase) + (voff)[_i]), (LAS unsigned*)(lds + (bufoff) + ldsw + _i * 8192), 16, 0, 0); } while (0)
#define PG8_LDA(dst, b, h) do { _Pragma("unroll") for (int m = 0; m < 4; ++m) _Pragma("unroll") for (int k = 0; k < 2; ++k) dst[m][k] = *(const LAS bf16x8*)(lds + PG8_SA(b, h) + aoff + m * 2048 + k * 1024); } while (0)
#define PG8_LDB(dst, b, h) do { _Pragma("unroll") for (int n = 0; n < 2; ++n) _Pragma("unroll") for (int k = 0; k < 2; ++k) dst[n][k] = *(const LAS bf16x8*)(lds + PG8_SB(b, h) + boff + n * 2048 + k * 1024); } while (0)
#define PG8_MMA(ai, bj, At, Bt) do { __builtin_amdgcn_s_setprio(1); _Pragma("unroll") for (int m = 0; m < 4; ++m) _Pragma("unroll") for (int n = 0; n < 2; ++n) _Pragma("unroll") for (int k = 0; k < 2; ++k) \
    acc[ai][bj][m][n] = __builtin_amdgcn_mfma_f32_16x16x32_bf16(Bt[n][k], At[m][k], acc[ai][bj][m][n], 0, 0, 0); __builtin_amdgcn_s_setprio(0); } while (0)
#define PG8_WAIT_V(n) asm volatile("s_waitcnt vmcnt(" #n ")" ::: "memory")
#define PG8_WAIT_L(n) asm volatile("s_waitcnt lgkmcnt(" #n ")" ::: "memory")
#define PG8_BAR __builtin_amdgcn_s_barrier()
#define PG8_SCHED __builtin_amdgcn_sched_barrier(0)
  Unit cur, nxt; int ui = 0;
  if (!S.next(0, cur)) return;
  f32x4 acc[2][2][4][2];
#pragma unroll
  for (int a = 0; a < 2; ++a)
#pragma unroll
    for (int b = 0; b < 2; ++b)
#pragma unroll
      for (int m = 0; m < 4; ++m)
#pragma unroll
        for (int n = 0; n < 2; ++n) acc[a][b][m][n] = (f32x4){0.f, 0.f, 0.f, 0.f};
  bf16x8 At[4][2], B0[2][2], B1[2][2];
  const char* cA = (const char*)Ag + (size_t)cur.pm * tstep; const char* cB = (const char*)Btg + (size_t)cur.pn * tstep;
  PG8_STAGE(PG8_SB(0, 0), cB, voffB); PG8_STAGE(PG8_SA(0, 0), cA, voffA); PG8_STAGE(PG8_SB(0, 1), cB + hstep, voffB); PG8_STAGE(PG8_SA(0, 1), cA + hstep, voffA);
  if (wr == 1) PG8_BAR;
  PG8_WAIT_V(4); PG8_BAR;
  PG8_STAGE(PG8_SB(1, 0), cB + kstep, voffB); PG8_STAGE(PG8_SA(1, 0), cA + kstep, voffA); PG8_STAGE(PG8_SB(1, 1), cB + hstep + kstep, voffB);
  PG8_WAIT_V(6); PG8_BAR;
  for (;;) {
    const bool has_next = S.next(ui + 1, nxt);
    const char* nA = has_next ? (const char*)Ag + (size_t)nxt.pm * tstep : cA; const char* nB = has_next ? (const char*)Btg + (size_t)nxt.pn * tstep : cB;
#pragma unroll 1
    for (int t = 0; t < nt; t += 2) {
      const bool last = (t == nt - 2);
      const char* a1 = cA + (size_t)(t + 1) * kstep;
      const char* a2 = last ? nA : cA + (size_t)(t + 2) * kstep; const char* b2 = last ? nB : cB + (size_t)(t + 2) * kstep;
      const char* a3 = a2 + kstep; const char* b3 = b2 + kstep;
      PG8_LDB(B0, 0, 0); PG8_SCHED; PG8_LDA(At, 0, 0); PG8_STAGE(PG8_SA(1, 1), a1 + hstep, voffA);
      PG8_WAIT_L(8); PG8_BAR; PG8_WAIT_L(0); PG8_MMA(0, 0, At, B0); PG8_BAR; PG8_SCHED;
      PG8_LDB(B1, 0, 1); PG8_STAGE(PG8_SB(0, 0), b2, voffB);
      PG8_BAR; PG8_WAIT_L(0); PG8_MMA(0, 1, At, B1); PG8_BAR;
      PG8_LDA(At, 0, 1); PG8_STAGE(PG8_SA(0, 0), a2, voffA);
      PG8_BAR; PG8_WAIT_L(0); PG8_MMA(1, 0, At, B0); PG8_BAR; PG8_SCHED;
      PG8_STAGE(PG8_SB(0, 1), b2 + hstep, voffB);
      PG8_WAIT_V(6); PG8_BAR; PG8_MMA(1, 1, At, B1); PG8_BAR;
      PG8_LDB(B0, 1, 0); PG8_SCHED; PG8_LDA(At, 1, 0); PG8_STAGE(PG8_SA(0, 1), a2 + hstep, voffA);
      PG8_WAIT_L(8); PG8_BAR; PG8_WAIT_L(0); PG8_MMA(0, 0, At, B0); PG8_BAR; PG8_SCHED;
      PG8_LDB(B1, 1, 1); PG8_STAGE(PG8_SB(1, 0), b3, voffB);
      PG8_BAR; PG8_WAIT_L(0); PG8_MMA(0, 1, At, B1); PG8_BAR;
      PG8_LDA(At, 1, 1); PG8_STAGE(PG8_SA(1, 0), a3, voffA);
      PG8_BAR; PG8_WAIT_L(0); PG8_MMA(1, 0, At, B0); PG8_BAR; PG8_SCHED;
      PG8_STAGE(PG8_SB(1, 1), b3 + hstep, voffB);
      PG8_WAIT_V(6); PG8_BAR; PG8_MMA(1, 1, At, B1); PG8_BAR;
    }
    E(acc, cur, wr, wc, fr, fq);
    if (!has_next) break;
#pragma unroll
    for (int a = 0; a < 2; ++a)
#pragma unroll
      for (int b = 0; b < 2; ++b)
#pragma unroll
        for (int m = 0; m < 4; ++m)
#pragma unroll
          for (int n = 0; n < 2; ++n) acc[a][b][m][n] = (f32x4){0.f, 0.f, 0.f, 0.f};
    cur = nxt; cA = nA; cB = nB; ++ui;
  }
  PG8_WAIT_V(0);
  if (wr == 0) PG8_BAR;
  PG8_BAR;
#undef PG8_SA
#undef PG8_SB
#undef PG8_STAGE
#undef PG8_LDA
#undef PG8_LDB
#undef PG8_MMA
#undef PG8_WAIT_V
#undef PG8_WAIT_L
#undef PG8_BAR
#undef PG8_SCHED
}

DI u32x4 pack8(const f32x4 a, const f32x4 b) { return (u32x4){pk2(a.x, a.y), pk2(a.z, a.w), pk2(b.x, b.y), pk2(b.z, b.w)}; }
DI float sq4(const f32x4 a) { return (a.x * a.x + a.y * a.y) + (a.z * a.z + a.w * a.w); }

DI void rowsum_xch(float (&ss)[2][4], LAS float* xch, int wr, int wc, int fr, int fq) {
#pragma unroll
  for (int ai = 0; ai < 2; ++ai)
#pragma unroll
    for (int m = 0; m < 4; ++m) { float s = ss[ai][m]; s += __shfl_xor(s, 16); s += __shfl_xor(s, 32); ss[ai][m] = s; }
  if (fq == 0) {
#pragma unroll
    for (int ai = 0; ai < 2; ++ai)
#pragma unroll
      for (int m = 0; m < 4; ++m) xch[(128 * ai + 64 * wr + 16 * m + fr) * 4 + wc] = ss[ai][m];
  }
  __syncthreads();
#pragma unroll
  for (int ai = 0; ai < 2; ++ai)
#pragma unroll
    for (int m = 0; m < 4; ++m) { const f32x4 t = *(const LAS f32x4*)(xch + (128 * ai + 64 * wr + 16 * m + fr) * 4); ss[ai][m] = (t.x + t.y) + (t.z + t.w); }
}

struct EpiG1 {
  static constexpr bool PERM = true;
  P p; LAS unsigned char* lds;
  DI void operator()(const acc_t& acc, const Unit& u, int, int, int, int) const {
    int t_ = threadIdx.x; asm volatile("" : "+v"(t_));
    const int wid_ = __builtin_amdgcn_readfirstlane(t_ >> 6), wr = wid_ >> 2, wc = wid_ & 3, fr = t_ & 15, fq = (t_ >> 4) & 3;
    GAS char* ws_ = (GAS char*)p.ws; GAS float* out_ = (GAS float*)p.out; asm volatile("" : "+s"(ws_), "+s"(out_));
    (void)out_;
    const int nt = u.pn;
    const bool samp = u.pm >= 256;
    const int row0 = u.pm * 256 + wr * 64 + fr;
    const int rl0 = samp ? row0 - NTOK_P : row0;
    const int c8 = wc * 32 + 8 * fq;
    if (nt < 2) {
      GAS u16* base = (GAS u16*)(ws_ + OFF_SBQ) + nt * 256 + c8;
#pragma unroll
      for (int ai = 0; ai < 2; ++ai)
#pragma unroll
        for (int m = 0; m < 4; ++m) { GAS u16* rp = base + (size_t)(row0 + ai * 128 + m * 16) * 512;
#pragma unroll
          for (int bj = 0; bj < 2; ++bj) *(GAS u32x4*)(rp + bj * 128) = pack8(acc[ai][bj][m][0] * QS_SB, acc[ai][bj][m][1] * QS_SB); }
    } else if (nt < 6) {
      const bool isv = nt >= 4;
      const int cb = (nt & 1) * 256 + c8;
      GAS float* ofb = out_ + (samp ? (isv ? O_SVS : O_SKS) : (isv ? O_SVP : O_SKP)) + cb;
#pragma unroll
      for (int ai = 0; ai < 2; ++ai)
#pragma unroll
        for (int m = 0; m < 4; ++m) { GAS float* of = ofb + (size_t)(rl0 + ai * 128 + m * 16) * 512;
#pragma unroll
          for (int bj = 0; bj < 2; ++bj) { *(GAS f32x4*)(of + bj * 128) = acc[ai][bj][m][0]; *(GAS f32x4*)(of + bj * 128 + 4) = acc[ai][bj][m][1];
          } }
    } else if (nt < 8 || nt >= 11) {
      const int cb = (nt < 8 ? (nt - 6) * 256 : 512 + (nt - 11) * 256) + c8;
      GAS u16* base = (GAS u16*)(ws_ + OFF_GATES) + cb;
#pragma unroll
      for (int ai = 0; ai < 2; ++ai)
#pragma unroll
        for (int m = 0; m < 4; ++m) { GAS u16* rp = base + (size_t)(row0 + ai * 128 + m * 16) * 1024;
#pragma unroll
          for (int bj = 0; bj < 2; ++bj) { f32x4 a = acc[ai][bj][m][0], b = acc[ai][bj][m][1];
            a.x = silu_f(a.x); a.y = silu_f(a.y); a.z = silu_f(a.z); a.w = silu_f(a.w); b.x = silu_f(b.x); b.y = silu_f(b.y); b.z = silu_f(b.z); b.w = silu_f(b.w);
            *(GAS u32x4*)(rp + bj * 128) = pack8(a, b); } }
    } else if (nt == 8 || nt == 9) {
      const int part = nt - 8;
      float ss[2][4];
#pragma unroll
      for (int ai = 0; ai < 2; ++ai)
#pragma unroll
        for (int m = 0; m < 4; ++m) { float s = sq4(acc[ai][0][m][0]) + sq4(acc[ai][0][m][1]); if (part == 0) s += sq4(acc[ai][1][m][0]) + sq4(acc[ai][1][m][1]); ss[ai][m] = s; }
      rowsum_xch(ss, (LAS float*)(lds + XCH_OFF), wr, wc, fr, fq);
      GAS float* cqss = (GAS float*)(ws_ + OFF_CQSS) + (size_t)part * NTOK;
      if (wc == 0 && fq == 0) {
#pragma unroll
        for (int ai = 0; ai < 2; ++ai)
#pragma unroll
          for (int m = 0; m < 4; ++m) cqss[row0 + ai * 128 + m * 16] = ss[ai][m];
      }
      GAS u16* base = (GAS u16*)(ws_ + OFF_CQ) + part * 256 + c8;
#pragma unroll
      for (int ai = 0; ai < 2; ++ai)
#pragma unroll
        for (int m = 0; m < 4; ++m) { GAS u16* rp = base + (size_t)(row0 + ai * 128 + m * 16) * 384;
          *(GAS u32x4*)(rp) = pack8(acc[ai][0][m][0], acc[ai][0][m][1]);
          if (part == 0) *(GAS u32x4*)(rp + 128) = pack8(acc[ai][1][m][0], acc[ai][1][m][1]); }
      if (part == 1 && wc == 0) {
        const GAS float* tab = (const GAS float*)(ws_ + OFF_ROPE);
        GAS float* okr = out_ + (samp ? O_KRS : O_KRP);
        GAS u16* kr = (GAS u16*)(ws_ + OFF_KROPE);
        const int i0 = (8 * fq) & 15;
#pragma unroll
        for (int ai = 0; ai < 2; ++ai)
#pragma unroll
          for (int m = 0; m < 4; ++m) {
            const int row = row0 + ai * 128 + m * 16, rl = rl0 + ai * 128 + m * 16;
            const int ridx = samp ? 2048 + (rl & 63) : (rl & 2047);
            f32x4 o[2];
#pragma unroll
            for (int n = 0; n < 2; ++n) {
              const f32x4 cs = *(const GAS f32x4*)(tab + ridx * 32 + i0 + 4 * n), sn = *(const GAS f32x4*)(tab + ridx * 32 + 16 + i0 + 4 * n);
              const f32x4 mine = acc[ai][1][m][n];
              f32x4 oth; oth.x = __shfl_xor(mine.x, 32); oth.y = __shfl_xor(mine.y, 32); oth.z = __shfl_xor(mine.z, 32); oth.w = __shfl_xor(mine.w, 32);
              o[n] = (fq < 2) ? (mine * cs - oth * sn) : (mine * cs + oth * sn);
            }
            *(GAS f32x4*)(okr + (size_t)rl * 32 + 8 * fq) = o[0]; *(GAS f32x4*)(okr + (size_t)rl * 32 + 8 * fq + 4) = o[1];
            *(GAS u32x4*)(kr + (size_t)row * 32 + 8 * fq) = pack8(o[0], o[1]);
          }
      }
    } else {
      float ss[2][4];
#pragma unroll
      for (int ai = 0; ai < 2; ++ai)
#pragma unroll
        for (int m = 0; m < 4; ++m) ss[ai][m] = (sq4(acc[ai][0][m][0]) + sq4(acc[ai][0][m][1])) + (sq4(acc[ai][1][m][0]) + sq4(acc[ai][1][m][1]));
      rowsum_xch(ss, (LAS float*)(lds + XCH_OFF), wr, wc, fr, fq);
      GAS float* ofb = out_ + (samp ? O_CKVS : O_CKVP) + c8;
      GAS u16* base = (GAS u16*)(ws_ + OFF_CKV) + c8;
      f32x4 gv[2][2];
#pragma unroll
      for (int bj = 0; bj < 2; ++bj)
#pragma unroll
        for (int n = 0; n < 2; ++n) gv[bj][n] = *(const f32x4*)(p.kv_norm_g + bj * 128 + c8 + 4 * n);
#pragma unroll
      for (int ai = 0; ai < 2; ++ai)
#pragma unroll
        for (int m = 0; m < 4; ++m) {
          const float r = rsqrtf(ss[ai][m] * (1.f / 256.f) + EPS);
          GAS float* of = ofb + (size_t)(rl0 + ai * 128 + m * 16) * 256; GAS u16* rp = base + (size_t)(row0 + ai * 128 + m * 16) * 256;
#pragma unroll
          for (int bj = 0; bj < 2; ++bj) {
            const f32x4 a = acc[ai][bj][m][0] * r * gv[bj][0], b = acc[ai][bj][m][1] * r * gv[bj][1];
            *(GAS f32x4*)(of + bj * 128) = a; *(GAS f32x4*)(of + bj * 128 + 4) = b;
            *(GAS u32x4*)(rp + bj * 128) = pack8(a, b);
          }
        }
    }
  }
};

struct EpiG2 {
  static constexpr bool PERM = false;
  P p;
  DI void operator()(const acc_t& acc, const Unit& u, int, int, int, int) const {
    int t_ = threadIdx.x; asm volatile("" : "+v"(t_));
    const int wid_ = __builtin_amdgcn_readfirstlane(t_ >> 6), wr = wid_ >> 2, wc = wid_ & 3, fr = t_ & 15, fq = (t_ >> 4) & 3;
    GAS char* ws_ = (GAS char*)p.ws; GAS float* out_ = (GAS float*)p.out; asm volatile("" : "+s"(ws_), "+s"(out_));
    (void)out_;
    const bool samp = u.pm >= 256;
    const int row0 = u.pm * 256 + wr * 64 + fr;
    const GAS float* cqss = (const GAS float*)(ws_ + OFF_CQSS);
    const GAS float* tab = (const GAS float*)(ws_ + OFF_ROPE);
    GAS u16* dst = (GAS u16*)(ws_ + OFF_QMLA);
#pragma unroll
    for (int ai = 0; ai < 2; ++ai)
#pragma unroll
      for (int m = 0; m < 4; ++m) {
        const int row = row0 + ai * 128 + m * 16;
        const float r = rsqrtf((cqss[row] + cqss[NTOK + row]) * (1.f / 384.f) + EPS) * QS_MLA;
        const int ridx = samp ? 2048 + ((row - NTOK_P) & 63) : (row & 2047);
#pragma unroll
        for (int bj = 0; bj < 2; ++bj) {
          const int gi = u.pn * 8 + bj * 4 + wc;
          f32x4 x1 = acc[ai][bj][m][0] * r, x2 = acc[ai][bj][m][1] * r;
          if (gi % 3 == 2) {
            const f32x4 cs = *(const GAS f32x4*)(tab + ridx * 32 + 4 * fq), sn = *(const GAS f32x4*)(tab + ridx * 32 + 16 + 4 * fq);
            const f32x4 o1 = x1 * cs - x2 * sn, o2 = x2 * cs + x1 * sn;
            x1 = o1; x2 = o2;
          }
          GAS u16* rp = dst + (size_t)row * 768 + gi * 32 + 4 * fq;
          *(GAS u32x2*)(rp) = (u32x2){pk2(x1.x, x1.y), pk2(x1.z, x1.w)};
          *(GAS u32x2*)(rp + 16) = (u32x2){pk2(x2.x, x2.y), pk2(x2.z, x2.w)};
        }
        __builtin_amdgcn_sched_barrier(0);
      }
  }
};

struct EpiG3 {
  static constexpr bool PERM = true;
  P p;
  DI void operator()(const acc_t& acc, const Unit& u, int, int, int, int) const {
    int t_ = threadIdx.x; asm volatile("" : "+v"(t_));
    const int wid_ = __builtin_amdgcn_readfirstlane(t_ >> 6), wr = wid_ >> 2, wc = wid_ & 3, fr = t_ & 15, fq = (t_ >> 4) & 3;
    GAS char* ws_ = (GAS char*)p.ws; GAS float* out_ = (GAS float*)p.out; asm volatile("" : "+s"(ws_), "+s"(out_));
    (void)out_;
    GAS u16* base = (GAS u16*)(ws_ + OFF_KV) + u.pn * 256 + wc * 32 + 8 * fq;
    const int row0 = u.pm * 256 + wr * 64 + fr;
#pragma unroll
    for (int ai = 0; ai < 2; ++ai)
#pragma unroll
      for (int m = 0; m < 4; ++m) { GAS u16* rp = base + (size_t)(row0 + ai * 128 + m * 16) * 1024;
#pragma unroll
        for (int bj = 0; bj < 2; ++bj) *(GAS u32x4*)(rp + bj * 128) = pack8(acc[ai][bj][m][0], acc[ai][bj][m][1]); }
  }
};

struct EpiG4 {
  static constexpr bool PERM = true;
  P p; LAS unsigned char* lds;
  DI void operator()(const acc_t& acc, const Unit& u, int, int, int, int) const {
    int t_ = threadIdx.x; asm volatile("" : "+v"(t_));
    const int wid_ = __builtin_amdgcn_readfirstlane(t_ >> 6), wr = wid_ >> 2, wc = wid_ & 3, fr = t_ & 15, fq = (t_ >> 4) & 3;
    GAS char* ws_ = (GAS char*)p.ws; GAS float* out_ = (GAS float*)p.out; asm volatile("" : "+s"(ws_), "+s"(out_));
    (void)out_;
    const int row0 = u.pm * 256 + wr * 64 + fr;
    float ss[2][4];
#pragma unroll
    for (int ai = 0; ai < 2; ++ai)
#pragma unroll
      for (int m = 0; m < 4; ++m) ss[ai][m] = (sq4(acc[ai][0][m][0]) + sq4(acc[ai][0][m][1])) + (sq4(acc[ai][1][m][0]) + sq4(acc[ai][1][m][1]));
    rowsum_xch(ss, (LAS float*)(lds + XCH_OFF), wr, wc, fr, fq);
    GAS float* rss = (GAS float*)(ws_ + OFF_ROWSS) + (size_t)u.pn * NTOK;
    if (wc == 0 && fq == 0) {
#pragma unroll
      for (int ai = 0; ai < 2; ++ai)
#pragma unroll
        for (int m = 0; m < 4; ++m) rss[row0 + ai * 128 + m * 16] = ss[ai][m];
    }
    GAS u16* base = (GAS u16*)(ws_ + OFF_GATES) + u.pn * 256 + wc * 32 + 8 * fq;
#pragma unroll
    for (int ai = 0; ai < 2; ++ai)
#pragma unroll
      for (int m = 0; m < 4; ++m) { GAS u16* rp = base + (size_t)(row0 + ai * 128 + m * 16) * 1024;
#pragma unroll
        for (int bj = 0; bj < 2; ++bj) *(GAS u32x4*)(rp + bj * 128) = pack8(acc[ai][bj][m][0], acc[ai][bj][m][1]); }
  }
};

DI void gemm_g1(const P& p, char* smem) {
  StaticOrder S; S.init(NTOK, NPAD, gridDim.x, blockIdx.x);
  EpiG1 E{p, (LAS unsigned char*)smem};
  gemm_phase((LAS unsigned char*)smem, (const u16*)(p.ws + OFF_H), (const u16*)(p.ws + OFF_WIN), 1024, S, E);
}
DI void gemm_g23(const P& p, char* smem) {
  { StaticOrder S; S.init(NTOK, 768, gridDim.x, blockIdx.x);
    EpiG2 E{p};
    gemm_phase((LAS unsigned char*)smem, (const u16*)(p.ws + OFF_CQ), (const u16*)(p.ws + OFF_WUQ), 384, S, E); }
  { StaticOrder S; S.init(NKV, 1024, gridDim.x, (blockIdx.x + 128) % gridDim.x);
    EpiG3 E{p};
    gemm_phase((LAS unsigned char*)smem, (const u16*)(p.ws + OFF_CKV), (const u16*)(p.ws + OFF_WUKV), 256, S, E); }
}
DI void gemm_g4(const P& p, char* smem) {
  StaticOrder S; S.init(NTOK, 1024, gridDim.x, blockIdx.x);
  EpiG4 E{p, (LAS unsigned char*)smem};
  gemm_phase((LAS unsigned char*)smem, (const u16*)(p.ws + OFF_H), (const u16*)(p.ws + OFF_WOUT), 1024, S, E);
}

constexpr int KS_SB = 144, KS_MLA = 208, VS = 192;
constexpr int MLA_STAGE = 64 * KS_MLA + 64 * VS;
constexpr int SB_STAGE = 64 * KS_SB + 64 * VS;
constexpr int FLAG_OFF = 65536;

DI void pv_step(const char* Vt, const bf16x8 (&pb)[4], f32x16 (&o)[2], int lane) {
  const int lh = lane >> 5, q4 = (lane & 15) >> 2, p4 = lane & 3, g1 = (lane >> 4) & 1;
  const char* vb = Vt + (4 * lh + q4) * VS + 32 * g1 + 8 * p4;
#pragma unroll
  for (int ks = 0; ks < 4; ++ks) {
#pragma unroll
    for (int dvt = 0; dvt < 2; ++dvt) {
      const s16x4 lo = tr_read(vb + (ks * 16) * VS + dvt * 64);
      const s16x4 hi = tr_read(vb + (ks * 16 + 8) * VS + dvt * 64);
      const bf16x8 vf = __builtin_shufflevector(lo, hi, 0, 1, 2, 3, 4, 5, 6, 7);
      o[dvt] = MFMA32(vf, pb[ks], o[dvt]);
    }
  }
}

DI void pack_p(const f32x16 (&s)[2], bf16x8 (&pb)[4]) {
#pragma unroll
  for (int mt = 0; mt < 2; ++mt)
#pragma unroll
    for (int h = 0; h < 2; ++h) {
      u32x4 t = {pk2(s[mt][8 * h + 0], s[mt][8 * h + 1]), pk2(s[mt][8 * h + 2], s[mt][8 * h + 3]),
                 pk2(s[mt][8 * h + 4], s[mt][8 * h + 5]), pk2(s[mt][8 * h + 6], s[mt][8 * h + 7])};
      pb[mt * 2 + h] = __builtin_bit_cast(bf16x8, t);
    }
}

DI void store_o(const P& p, const f32x16 (&o)[2], float inv, size_t tok, int colbase, int lh) {
  const u16* gates = (const u16*)(p.ws + OFF_GATES);
  u16* mixed = (u16*)(p.ws + OFF_H);
#pragma unroll
  for (int dvt = 0; dvt < 2; ++dvt)
#pragma unroll
    for (int g = 0; g < 4; ++g) {
      const size_t off = tok * 1024 + colbase + dvt * 32 + g * 8 + lh * 4;
      const u32x2 gt = *(const u32x2*)(gates + off);
      u32x2 ov = {pk2(o[dvt][4 * g + 0] * inv * bflo(gt.x), o[dvt][4 * g + 1] * inv * bfhi(gt.x)),
                  pk2(o[dvt][4 * g + 2] * inv * bflo(gt.y), o[dvt][4 * g + 3] * inv * bfhi(gt.y))};
      *(u32x2*)(mixed + off) = ov;
    }
}

DI void mla_item(const P& p, char* smem, int b, int hd, int q0, bool samp) {
  int tid = threadIdx.x; asm volatile("" : "+v"(tid));
  const int w = __builtin_amdgcn_readfirstlane(tid >> 6), lane = tid & 63, l32 = lane & 31, lh = lane >> 5;
  const bool active = samp ? (w < 4) : true;
  const int hw = samp ? hd + (w >> 1) : hd;
  const int qw0 = samp ? (w & 1) * 32 : q0 + w * 32;
  constexpr int STG = 2 * MLA_STAGE;
  const int hoff = samp ? (w >> 1) * MLA_STAGE : 0;
  const size_t tokrow0 = samp ? (size_t)(NTOK_P + b * 64) : (size_t)b * 2048;
  const int nkb_blk = samp ? 65 : (q0 / 64 + 4);
  const int nkb_w = samp ? 65 : (qw0 / 64 + 1);
  const u16* kv = (const u16*)(p.ws + OFF_KV);
  const u16* krope = (const u16*)(p.ws + OFF_KROPE);
  bf16x8 qf[6];
  if (active) {
    const u16* qp = (const u16*)(p.ws + OFF_QMLA) + (tokrow0 + qw0 + l32) * 768 + hw * 96 + lh * 8;
#pragma unroll
    for (int ks = 0; ks < 6; ++ks) qf[ks] = *(const bf16x8*)(qp + ks * 16);
  } else {
#pragma unroll
    for (int ks = 0; ks < 6; ++ks) qf[ks] = (bf16x8){0, 0, 0, 0, 0, 0, 0, 0};
  }
  u32x4 rkn, rvv, rkr, rkn2, rvv2;
  rkr = rkn2 = rvv2 = (u32x4){0, 0, 0, 0};
  auto gload = [&](int kb) {
    const size_t trow0 = samp ? (kb < 64 ? (size_t)(NTOK + b * PAST + kb * 64) : (size_t)(NTOK_P + b * 64)) : (size_t)(b * 2048 + kb * 64);
    if (samp) {
      const int h2 = tid >> 8, u = tid & 255;
      const u16* base = kv + (trow0 + (u >> 3)) * 1024 + (hd + h2) * 128 + (u & 7) * 8;
      rkn = *(const u32x4*)base; rvv = *(const u32x4*)(base + 64);
      rkn2 = *(const u32x4*)(base + 32 * 1024); rvv2 = *(const u32x4*)(base + 32 * 1024 + 64);
      rkr = *(const u32x4*)(krope + (trow0 + (u >> 2)) * 32 + (u & 3) * 8);
    } else {
      const size_t row = trow0 + (tid >> 3);
      const u16* base = kv + row * 1024 + hd * 128 + (tid & 7) * 8;
      rkn = *(const u32x4*)base;
      rvv = *(const u32x4*)(base + 64);
      if (tid < 256) rkr = *(const u32x4*)(krope + (trow0 + (tid >> 2)) * 32 + (tid & 3) * 8);
    }
  };
  auto lstore = [&](int buf) {
    if (samp) {
      const int h2 = tid >> 8, u = tid & 255;
      char* Kt = smem + buf * STG + h2 * MLA_STAGE; char* Vt = Kt + 64 * KS_MLA;
      *(u32x4*)(Kt + (u >> 3) * KS_MLA + (u & 7) * 16) = rkn;
      *(u32x4*)(Kt + (32 + (u >> 3)) * KS_MLA + (u & 7) * 16) = rkn2;
      *(u32x4*)(Vt + (u >> 3) * VS + (u & 7) * 16) = rvv;
      *(u32x4*)(Vt + (32 + (u >> 3)) * VS + (u & 7) * 16) = rvv2;
      *(u32x4*)(Kt + (u >> 2) * KS_MLA + 128 + (u & 3) * 16) = rkr;
    } else {
      char* Kt = smem + buf * STG; char* Vt = Kt + 64 * KS_MLA;
      *(u32x4*)(Kt + (tid >> 3) * KS_MLA + (tid & 7) * 16) = rkn;
      *(u32x4*)(Vt + (tid >> 3) * VS + (tid & 7) * 16) = rvv;
      if (tid < 256) *(u32x4*)(Kt + (tid >> 2) * KS_MLA + 128 + (tid & 3) * 16) = rkr;
    }
  };
  f32x16 o[2];
#pragma unroll
  for (int i = 0; i < 16; ++i) { o[0][i] = 0.f; o[1][i] = 0.f; }
  float mrun = -1e30f, lsum = 0.f;
  gload(0); lstore(0);
  __syncthreads();
  for (int kb = 0; kb < nkb_blk; ++kb) {
    const bool has_next = kb + 1 < nkb_blk;
    if (has_next) gload(kb + 1);
    if (active && kb < nkb_w) {
      const char* Kt = smem + (kb & 1) * STG + hoff; const char* Vt = Kt + 64 * KS_MLA;
      f32x16 s[2];
      const float cinit = (kb == 0) ? 0.f : -mrun;
#pragma unroll
      for (int i = 0; i < 16; ++i) { s[0][i] = cinit; s[1][i] = cinit; }
      const char* kp = Kt + l32 * KS_MLA + lh * 16;
#pragma unroll
      for (int ks = 0; ks < 6; ++ks) {
        const bf16x8 a0 = *(const bf16x8*)(kp + ks * 32);
        const bf16x8 a1 = *(const bf16x8*)(kp + 32 * KS_MLA + ks * 32);
        s[0] = MFMA32(a0, qf[ks], s[0]);
        s[1] = MFMA32(a1, qf[ks], s[1]);
      }
      f32x16 e[2];
      float ps0 = 0.f, ps1 = 0.f;
      bool redo = (kb == 0);
      if (!redo) {
#pragma unroll
        for (int i = 0; i < 16; ++i) { e[0][i] = ex2(s[0][i]); e[1][i] = ex2(s[1][i]); ps0 += e[0][i]; ps1 += e[1][i]; }
        redo = (__builtin_amdgcn_ballot_w64(!(ps0 + ps1 < 1e18f)) != 0ull);
      }
      if (redo) {
        float mx = fmaxf(s[0][0], s[1][0]);
#pragma unroll
        for (int i = 1; i < 16; ++i) mx = fmaxf(mx, fmaxf(s[0][i], s[1][i]));
        mx = fmaxf(mx, __shfl_xor(mx, 32));
        const float up = (kb == 0) ? mx : fmaxf(mx, 0.f);
        const float alpha = (kb == 0) ? 0.f : ex2(-up);
        lsum *= alpha;
#pragma unroll
        for (int i = 0; i < 16; ++i) { o[0][i] *= alpha; o[1][i] *= alpha; }
        mrun = (kb == 0) ? mx : mrun + up;
        ps0 = 0.f; ps1 = 0.f;
#pragma unroll
        for (int i = 0; i < 16; ++i) { e[0][i] = ex2(s[0][i] - up); e[1][i] = ex2(s[1][i] - up); ps0 += e[0][i]; ps1 += e[1][i]; }
      }
      lsum += ps0 + ps1;
      bf16x8 pb[4];
      pack_p(e, pb);
      pv_step(Vt, pb, o, lane);
    }
    if (has_next) lstore((kb + 1) & 1);
    __syncthreads();
  }
  if (active) {
    const float lt = lsum + __shfl_xor(lsum, 32);
    store_o(p, o, 1.f / lt, tokrow0 + qw0 + l32, 512 + hw * 64, lh);
  }
}

constexpr int SB_NS = 6;
DI void sb_item(const P& p, char* smem, int b, int hd, int q0, bool samp) {
  int tid = threadIdx.x; asm volatile("" : "+v"(tid));
  const int w = __builtin_amdgcn_readfirstlane(tid >> 6), lane = tid & 63, l32 = lane & 31, lh = lane >> 5;
  const int nq = samp ? 64 : 256;
  const bool active = (w * 32 < nq);
  const int qw0 = q0 + w * 32;
  const int qpos_w0 = samp ? PAST + qw0 : qw0;
  const size_t tokrow0 = samp ? (size_t)(NTOK_P + b * 64) : (size_t)b * 2048;
  const int dw = samp ? 64 : (q0 >> 6) + (w >> 1);
  const int d_min = samp ? 64 : (q0 >> 6), d_cnt = samp ? 1 : 4;
  int* flags = (int*)(smem + SB_NS * SB_STAGE);
  bf16x8 qf[4];
  if (active) {
    const u16* qp = (const u16*)(p.ws + OFF_SBQ) + (tokrow0 + qw0 + l32) * 512 + hd * 64 + lh * 8;
#pragma unroll
    for (int ks = 0; ks < 4; ++ks) qf[ks] = *(const bf16x8*)(qp + ks * 16);
  } else {
#pragma unroll
    for (int ks = 0; ks < 4; ++ks) qf[ks] = (bf16x8){0, 0, 0, 0, 0, 0, 0, 0};
  }
  const int r = tid >> 3, c = tid & 7;
  const float* nk = p.out + (samp ? O_SKS : O_SKP);
  const float* nv = p.out + (samp ? O_SVS : O_SVP);
  auto src_off = [&](int kb) -> size_t {
    return samp ? (kb < 64 ? ((size_t)(b * PAST + kb * 64 + r) * 8 + hd) * 64 + c * 8 : (size_t)(b * 64 + r) * 512 + hd * 64 + c * 8)
                : ((size_t)b * 2048 + (size_t)kb * 64 + r) * 512 + hd * 64 + c * 8;
  };
  {
    f32x4 pk[4][2], pv[4][2];
#pragma unroll
    for (int i = 0; i < 4; ++i) {
      if (i < d_cnt) {
        const size_t off = src_off(d_min + i);
        const f32x4* ks = (const f32x4*)(nk + off); const f32x4* vs = (const f32x4*)(nv + off);
        pk[i][0] = ks[0]; pk[i][1] = ks[1]; pv[i][0] = vs[0]; pv[i][1] = vs[1];
      }
    }
#pragma unroll
    for (int i = 0; i < 4; ++i) {
      if (i < d_cnt) {
        char* Kt = smem + ((d_min + i) % SB_NS) * SB_STAGE; char* Vt = Kt + 64 * KS_SB;
        *(u32x4*)(Kt + r * KS_SB + c * 16) = pack8(pk[i][0], pk[i][1]);
        *(u32x4*)(Vt + r * VS + c * 16) = pack8(pv[i][0], pv[i][1]);
      }
    }
  }
  f32x4 fk0, fk1, fv0, fv1;
  fk0 = fk1 = fv0 = fv1 = (f32x4){0.f, 0.f, 0.f, 0.f};
  auto gload = [&](int kb) {
    const size_t off = src_off(kb);
    const f32x4* ks = (const f32x4*)((samp ? p.cache_sb_k : nk) + off);
    const f32x4* vs = (const f32x4*)((samp ? p.cache_sb_v : nv) + off);
    fk0 = ks[0]; fk1 = ks[1]; fv0 = vs[0]; fv1 = vs[1];
  };
  auto lstore = [&](int kb) {
    char* Kt = smem + (kb % SB_NS) * SB_STAGE; char* Vt = Kt + 64 * KS_SB;
    *(u32x4*)(Kt + r * KS_SB + c * 16) = pack8(fk0, fk1);
    *(u32x4*)(Vt + r * VS + c * 16) = pack8(fv0, fv1);
  };
  f32x16 o[2];
#pragma unroll
  for (int i = 0; i < 16; ++i) { o[0][i] = 0.f; o[1][i] = 0.f; }
  float Pg = 1.f;
  bool done = false;
  __syncthreads();
  for (int t = 0;; ++t) {
    const int kbn = d_min - (t + 1);
    const bool has_next = kbn >= 0;
    if (has_next) gload(kbn);
    const int kbw = dw - t;
    if (active && !done && kbw >= 0) {
      const char* Kt = smem + (kbw % SB_NS) * SB_STAGE; const char* Vt = Kt + 64 * KS_SB;
      f32x16 s[2];
#pragma unroll
      for (int i = 0; i < 16; ++i) { s[0][i] = 0.f; s[1][i] = 0.f; }
      const char* kp = Kt + l32 * KS_SB + lh * 16;
#pragma unroll
      for (int ks = 0; ks < 4; ++ks) {
        const bf16x8 a0 = *(const bf16x8*)(kp + ks * 32);
        const bf16x8 a1 = *(const bf16x8*)(kp + 32 * KS_SB + ks * 32);
        s[0] = MFMA32(a0, qf[ks], s[0]);
        s[1] = MFMA32(a1, qf[ks], s[1]);
      }
      const int qpos = qpos_w0 + l32;
      const int kt0 = kbw * 64 + lh * 4;
      const bool diag = (kbw * 64 + 63 >= qpos_w0);
      f32x16 om[2];
#pragma unroll
      for (int mt = 0; mt < 2; ++mt)
#pragma unroll
        for (int i = 0; i < 16; ++i) {
          const float z = __builtin_amdgcn_fmed3f(s[mt][i], -126.f, 126.f);
          const float e = ex2(-z);
          const float bt = __builtin_amdgcn_rcpf(1.f + e);
          s[mt][i] = bt; om[mt][i] = e * bt;
        }
      if (__builtin_amdgcn_readfirstlane((int)diag)) {
#pragma unroll
        for (int mt = 0; mt < 2; ++mt)
#pragma unroll
          for (int i = 0; i < 16; ++i) {
            const bool cz = (kt0 + mt * 32 + (i >> 2) * 8 + (i & 3)) < qpos;
            s[mt][i] = cz ? s[mt][i] : 0.f;
            om[mt][i] = cz ? om[mt][i] : 1.f;
          }
      }
      float R[8], Ro[8];
#pragma unroll
      for (int k8 = 0; k8 < 8; ++k8) {
        const int mt = k8 >> 2, g = k8 & 3;
        R[k8] = (om[mt][4 * g] * om[mt][4 * g + 1]) * (om[mt][4 * g + 2] * om[mt][4 * g + 3]);
      }
#pragma unroll
      for (int k8 = 0; k8 < 8; ++k8) Ro[k8] = __shfl_xor(R[k8], 32);
#pragma unroll
      for (int k8 = 7; k8 >= 0; --k8) {
        const int mt = k8 >> 2, g = k8 & 3;
        const float t3 = lh == 0 ? Pg * Ro[k8] : Pg;
        const float t2 = t3 * om[mt][4 * g + 3];
        const float t1 = t2 * om[mt][4 * g + 2];
        const float t0 = t1 * om[mt][4 * g + 1];
        s[mt][4 * g + 3] *= t3;
        s[mt][4 * g + 2] *= t2;
        s[mt][4 * g + 1] *= t1;
        s[mt][4 * g + 0] *= t0;
        Pg *= R[k8] * Ro[k8];
      }
      bf16x8 pb[4];
      pack_p(s, pb);
      pv_step(Vt, pb, o, lane);
      done = (__builtin_amdgcn_ballot_w64(Pg < SB_DONE) == ~0ull);
    }
    if (lane == 0) flags[(t & 1) * 8 + w] = (!active || done || kbw < 1) ? 1 : 0;
    if (has_next) lstore(kbn);
    __syncthreads();
    int alld = 1;
#pragma unroll
    for (int i = 0; i < 8; ++i) alld &= flags[(t & 1) * 8 + i];
    if (alld) break;
  }
  if (active) store_o(p, o, 1.f, tokrow0 + qw0 + l32, hd * 64, lh);
}

DI void attn_phase(const P& p, char* smem) {
  __shared__ int s_item;
  int* ctr = (int*)(p.ws + OFF_CTR);
  constexpr int N_MS = 64, N_SS = 128, N_MP = 2048, N_SP = 2048, N_ALL = N_MS + N_SS + N_MP + N_SP;
  if (threadIdx.x == 0) s_item = atomicAdd(ctr, 1);
  __syncthreads();
  int item = s_item;
  while (item < N_ALL) {
    __syncthreads();
    int nxt = 0;
    if (threadIdx.x == 0) nxt = atomicAdd(ctr, 1);
    int it = item;
    if (it < N_MS) { mla_item(p, smem, it >> 2, (it & 3) * 2, 0, true); }
    else if ((it -= N_MS) < N_SS) { sb_item(p, smem, it >> 3, it & 7, 0, true); }
    else if ((it -= N_SS) < N_MP) { const int qt = 7 - (it >> 8), bh = it & 255; mla_item(p, smem, bh >> 3, bh & 7, qt * 256, false); }
    else { it -= N_MP; const int qt = 7 - (it >> 8), bh = it & 255; sb_item(p, smem, bh >> 3, bh & 7, qt * 256, false); }
    if (threadIdx.x == 0) s_item = nxt;
    __syncthreads();
    item = s_item;
  }
}

DI void phase_fin(const P& p) {
  const int lane = threadIdx.x & 63, gw = blockIdx.x * 8 + (threadIdx.x >> 6), ngw = gridDim.x * 8;
  const float* mod = (const float*)(p.ws + OFF_MOD);
  const float* rss = (const float*)(p.ws + OFF_ROWSS);
  const u16* outp = (const u16*)(p.ws + OFF_GATES);
  const f32x4* pg4 = (const f32x4*)p.post_g;
  for (int row = gw * 2; row < NTOK; row += ngw * 2) {
    const float* xr; int bm;
    if (row < NTOK_P) { xr = p.x_prompt + (size_t)row * 1024; bm = row >> 11; }
    else { xr = p.x_sample + (size_t)(row - NTOK_P) * 1024; bm = 32 + ((row - NTOK_P) >> 6); }
    const f32x4* x4 = (const f32x4*)xr;
    const u32x2* o2 = (const u32x2*)(outp + (size_t)row * 1024);
    f32x4 xv[2][4]; u32x2 ov[2][4];
#pragma unroll
    for (int j = 0; j < 4; ++j) { xv[0][j] = __builtin_nontemporal_load(x4 + lane + 64 * j); xv[1][j] = __builtin_nontemporal_load(x4 + 256 + lane + 64 * j); ov[0][j] = o2[lane + 64 * j]; ov[1][j] = o2[256 + lane + 64 * j]; }
    const float s0 = (rss[row] + rss[NTOK + row]) + (rss[2 * NTOK + row] + rss[3 * NTOK + row]);
    const float s1 = (rss[row + 1] + rss[NTOK + row + 1]) + (rss[2 * NTOK + row + 1] + rss[3 * NTOK + row + 1]);
    const float r0 = rsqrtf(s0 * (1.f / 1024.f) + EPS), r1 = rsqrtf(s1 * (1.f / 1024.f) + EPS);
    const f32x4* gt4 = (const f32x4*)(mod + bm * 3072 + 2048);
    f32x4* y4 = (f32x4*)(p.out + (size_t)row * 1024);
#pragma unroll
    for (int j = 0; j < 4; ++j) {
      const int c4 = lane + 64 * j;
      const f32x4 m = gt4[c4] * pg4[c4];
      const f32x4 m0 = m * r0, m1 = m * r1;
      f32x4 y;
      y.x = xv[0][j].x + m0.x * bflo(ov[0][j].x); y.y = xv[0][j].y + m0.y * bfhi(ov[0][j].x);
      y.z = xv[0][j].z + m0.z * bflo(ov[0][j].y); y.w = xv[0][j].w + m0.w * bfhi(ov[0][j].y);
      y4[c4] = y;
      y.x = xv[1][j].x + m1.x * bflo(ov[1][j].x); y.y = xv[1][j].y + m1.y * bfhi(ov[1][j].x);
      y.z = xv[1][j].z + m1.z * bflo(ov[1][j].y); y.w = xv[1][j].w + m1.w * bfhi(ov[1][j].y);
      y4[256 + c4] = y;
    }
  }
}

__global__ void __launch_bounds__(512) sbmla_fwd(P p, int ph_lo, int ph_hi) {
  extern __shared__ __attribute__((aligned(16))) char smem[];
  cg::grid_group grid = cg::this_grid();
#ifndef REP_PHASE
#define REP_PHASE -1
#endif
#define PHASE(i, call) if (ph_lo <= (i) && (i) < ph_hi) { call; \
    if (REP_PHASE == (i)) { grid.sync(); if ((i) == 4) { if (blockIdx.x == 0 && threadIdx.x == 0) *(int*)(p.ws + OFF_CTR) = 0; grid.sync(); } call; } \
    if ((i) + 1 < ph_hi) grid.sync(); }
  PHASE(0, phase0(p, smem))
  PHASE(1, phase1(p))
  PHASE(2, gemm_g1(p, smem))
  PHASE(3, gemm_g23(p, smem))
  PHASE(4, attn_phase(p, smem))
  PHASE(5, gemm_g4(p, smem))
  PHASE(6, phase_fin(p))
#undef PHASE
}

#ifndef N_LAUNCH_SPLIT
#define N_LAUNCH_SPLIT 0
#endif

extern "C" void kernel_launch(void* const* d_in, const int* in_sizes, int n_in, void* d_out, int out_size, void* d_ws, size_t ws_size,
                              hipStream_t stream) {
  static int grid_blocks = 0;
  if (grid_blocks == 0) {
    if (n_in != 18 || ws_size < WS_END) { fprintf(stderr, "kernel_launch: unexpected n_in %d or ws_size %zu (need %zu)\n", n_in, ws_size, (size_t)WS_END); grid_blocks = -1; return; }
    int dev = 0, cus = 0, per_cu = 0;
    hipGetDevice(&dev);
    hipDeviceGetAttribute(&cus, hipDeviceAttributeMultiprocessorCount, dev);
    if (hipFuncSetAttribute((const void*)sbmla_fwd, hipFuncAttributeMaxDynamicSharedMemorySize, LDS_BYTES) != hipSuccess)
      fprintf(stderr, "kernel_launch: hipFuncSetAttribute failed\n");
    if (hipOccupancyMaxActiveBlocksPerMultiprocessor(&per_cu, (const void*)sbmla_fwd, 512, LDS_BYTES) != hipSuccess || per_cu < 1) {
      fprintf(stderr, "kernel_launch: occupancy query gave %d\n", per_cu); per_cu = 1;
    }
    (void)hipGetLastError();
    grid_blocks = cus * per_cu;
    if (grid_blocks > 256) grid_blocks = 256;
    fprintf(stderr, "kernel_launch: grid %d (cus %d per_cu %d)\n", grid_blocks, cus, per_cu);
  }
  if (grid_blocks < 0) return;
  P p{};
  const float** pp = (const float**)&p;
  for (int i = 0; i < 18; ++i) pp[i] = (const float*)d_in[i];
  p.out = (float*)d_out;
  p.ws = (char*)d_ws;
#if N_LAUNCH_SPLIT
  for (int ph = 0; ph < 7; ++ph) {
    int lo = ph, hi = ph + 1;
    hipLaunchKernelGGL(sbmla_fwd, dim3(grid_blocks), dim3(512), LDS_BYTES, stream, p, lo, hi);
  }
#else
  int lo = 0, hi = 7;
  void* args[] = {&p, &lo, &hi};
  hipError_t e = hipLaunchCooperativeKernel((const void*)sbmla_fwd, dim3(grid_blocks), dim3(512), args, LDS_BYTES, stream);
  if (e != hipSuccess) fprintf(stderr, "cooperative launch failed: %s (grid %d)\n", hipGetErrorString(e), grid_blocks);
#endif
}
```

```cpp
#include <hip/hip_runtime.h>
#include <hip/hip_cooperative_groups.h>
#include <cstdio>
namespace cg = cooperative_groups;

#define DI __device__ __forceinline__
typedef unsigned short u16;
typedef short bf16x8 __attribute__((ext_vector_type(8)));
typedef short s16x4 __attribute__((ext_vector_type(4)));
typedef float f32x4 __attribute__((ext_vector_type(4)));
typedef float f32x16 __attribute__((ext_vector_type(16)));
typedef unsigned u32x4 __attribute__((ext_vector_type(4)));
typedef unsigned u32x2 __attribute__((ext_vector_type(2)));

constexpr int T_P = 2048, T_S = 64, PAST = 4096;
constexpr int NTOK_P = 65536, NTOK = 66560;
constexpr int TKS = PAST + T_S;
constexpr int NKV = NTOK_P + 16 * TKS;
constexpr int IN_COLS = 3232, NPAD = 3328;
constexpr float EPS = 1e-6f;
constexpr float LOG2E = 1.4426950408889634f;
constexpr float QS_SB = 0.125f * LOG2E;
constexpr float QS_MLA = 0.10206207261596575f * LOG2E;
constexpr float SB_DONE = 1e-13f;

constexpr size_t O_YP = 0, O_YS = 67108864, O_SKP = 68157440, O_SVP = 101711872, O_CKVP = 135266304, O_KRP = 152043520,
                 O_SKS = 154140672, O_SVS = 154664960, O_CKVS = 155189248, O_KRS = 155451392;

constexpr size_t OFF_CTR = 0;
constexpr size_t OFF_MOD = 256;
constexpr size_t OFF_ROPE = OFF_MOD + 589824;
constexpr size_t OFF_WIN = OFF_ROPE + 270336;
constexpr size_t OFF_WUQ = OFF_WIN + 6815744;
constexpr size_t OFF_WUKV = OFF_WUQ + 589824;
constexpr size_t OFF_WOUT = OFF_WUKV + 524288;
constexpr size_t OFF_CQSS = OFF_WOUT + 2097152;
constexpr size_t OFF_ROWSS = OFF_CQSS + 532480;
constexpr size_t OFF_H = OFF_ROWSS + 1064960;
constexpr size_t OFF_GATES = OFF_H + 136314880;
constexpr size_t OFF_SBQ = OFF_GATES + 136314880;
constexpr size_t OFF_SBK = OFF_SBQ + 68157440;
constexpr size_t OFF_SBV = OFF_SBK + 68157440;
constexpr size_t OFF_CQ = OFF_SBV + 68157440;
constexpr size_t OFF_CKV = OFF_CQ + 51118080;
constexpr size_t OFF_KROPE = OFF_CKV + 67633152;
constexpr size_t OFF_QMLA = OFF_KROPE + 8454144;
constexpr size_t OFF_KV = OFF_QMLA + 102236160;
constexpr size_t WS_END = OFF_KV + 270532608;

constexpr int LDS_BYTES = 131072 + 4096;

struct P {
  const float *x_prompt, *x_sample, *cache_sb_k, *cache_sb_v, *cache_ckv, *cache_krope, *c_prompt, *c_sample,
      *ada_w, *ada_b, *pre_g, *w_in, *q_norm_g, *w_uq, *kv_norm_g, *w_ukv, *w_out, *post_g;
  float* out;
  char* ws;
};

DI unsigned pk2(float a, float b) {
  typedef __bf16 bf2 __attribute__((ext_vector_type(2)));
  typedef float f2 __attribute__((ext_vector_type(2)));
  f2 v = {a, b};
  bf2 r = __builtin_convertvector(v, bf2);
  return __builtin_bit_cast(unsigned, r);
}
DI u16 bf1(float a) { return (u16)(pk2(a, 0.f) & 0xffffu); }
DI float bflo(unsigned v) { return __uint_as_float(v << 16); }
DI float bfhi(unsigned v) { return __uint_as_float(v & 0xffff0000u); }
DI float silu_f(float x) { return x * __builtin_amdgcn_rcpf(1.f + __builtin_amdgcn_exp2f(-1.4426950408889634f * x)); }
DI float ex2(float x) { return __builtin_amdgcn_exp2f(x); }
DI float lg2(float x) { return __builtin_amdgcn_logf(x); }
DI float wave_sum(float v) {
#pragma unroll
  for (int o = 1; o < 64; o <<= 1) v += __shfl_xor(v, o);
  return v;
}
#define MFMA32(a, b, c) __builtin_amdgcn_mfma_f32_32x32x16_bf16((a), (b), (c), 0, 0, 0)
#define MFMA16(a, b, c) __builtin_amdgcn_mfma_f32_16x16x32_bf16((a), (b), (c), 0, 0, 0)

typedef __attribute__((address_space(3))) s16x4* lds_s16x4_ptr;
DI s16x4 tr_read(const char* ptr) {
  return __builtin_amdgcn_ds_read_tr16_b64_v4i16((lds_s16x4_ptr)(unsigned)(size_t)ptr);
}

DI int win_src_col(int p) {
  if (p < 2432) return p;
  if (p < 2464) return 2688 + (p - 2432);
  if (p < 2560) return -1;
  if (p < 2816) return 2432 + (p - 2560);
  return 2720 + (p - 2816);
}

DI void transpose_w(const float* __restrict__ W, int K, int N, int NP, u16* __restrict__ Wt, const float* __restrict__ kscale,
                    bool perm, int gtid, int gstride) {
  const int nk8 = K / 8;
  for (int e = gtid; e < NP * nk8; e += gstride) {
    const int pcol = e % NP, k8 = e / NP;
    const int c = perm ? win_src_col(pcol) : pcol;
    float v[8];
#pragma unroll
    for (int i = 0; i < 8; ++i) {
      float x = (c >= 0) ? W[(size_t)(k8 * 8 + i) * N + c] : 0.f;
      if (kscale) x *= kscale[k8 * 8 + i];
      v[i] = x;
    }
    u32x4 o = {pk2(v[0], v[1]), pk2(v[2], v[3]), pk2(v[4], v[5]), pk2(v[6], v[7])};
    *(u32x4*)(Wt + (size_t)pcol * K + k8 * 8) = o;
  }
}

DI void mod_job(const P& p, int job, float* lds) {
  const int cc = job % 48, bh = job / 48;
  const int tid = threadIdx.x, lane = tid & 63, w = tid >> 6;
  float* mod = (float*)(p.ws + OFF_MOD);
  __syncthreads();
  for (int e = tid; e < 24 * 1024; e += 512) {
    const int bl = e >> 10, k = e & 1023;
    const int b = bh * 24 + bl;
    const float cv = b < 32 ? p.c_prompt[b * 1024 + k] : p.c_sample[(b - 32) * 1024 + k];
    lds[k * 24 + bl] = silu_f(cv);
  }
  __syncthreads();
  float acc[24];
#pragma unroll
  for (int i = 0; i < 24; ++i) acc[i] = 0.f;
  const int col = cc * 64 + lane;
  for (int k = w * 128; k < w * 128 + 128; k += 16) {
    float wv[16];
#pragma unroll
    for (int u = 0; u < 16; ++u) wv[u] = p.ada_w[(size_t)(k + u) * 3072 + col];
#pragma unroll
    for (int u = 0; u < 16; ++u) {
      const f32x4* s4 = (const f32x4*)(lds + (k + u) * 24);
#pragma unroll
      for (int q = 0; q < 6; ++q) {
        const f32x4 s = s4[q];
        acc[q * 4 + 0] += s.x * wv[u]; acc[q * 4 + 1] += s.y * wv[u]; acc[q * 4 + 2] += s.z * wv[u]; acc[q * 4 + 3] += s.w * wv[u];
      }
    }
  }
  __syncthreads();
#pragma unroll
  for (int i = 0; i < 24; ++i) lds[(w * 24 + i) * 64 + lane] = acc[i];
  __syncthreads();
  for (int e = tid; e < 24 * 64; e += 512) {
    const int bl = e >> 6, l = e & 63;
    float s = 0.f;
#pragma unroll
    for (int ww = 0; ww < 8; ++ww) s += lds[(ww * 24 + bl) * 64 + l];
    const int b = bh * 24 + bl, c = cc * 64 + l;
    mod[b * 3072 + c] = s + p.ada_b[c];
  }
  __syncthreads();
}

DI void phase0(const P& p, char* smem) {
  const int tid = threadIdx.x;
  if (blockIdx.x == 0 && tid < 32) { ((int*)(p.ws + OFF_CTR))[tid] = 0; }
  for (int job = blockIdx.x; job < 96; job += gridDim.x) mod_job(p, job, (float*)smem);
  const bool split = gridDim.x >= 192;
  if (split && blockIdx.x < 96) return;
  const int gtid = (split ? blockIdx.x - 96 : blockIdx.x) * 512 + tid, gstride = (split ? gridDim.x - 96 : gridDim.x) * 512;
  transpose_w(p.w_in, 1024, IN_COLS, NPAD, (u16*)(p.ws + OFF_WIN), nullptr, true, gtid, gstride);
  transpose_w(p.w_uq, 384, 768, 768, (u16*)(p.ws + OFF_WUQ), p.q_norm_g, false, gtid, gstride);
  transpose_w(p.w_ukv, 256, 1024, 1024, (u16*)(p.ws + OFF_WUKV), nullptr, false, gtid, gstride);
  transpose_w(p.w_out, 1024, 1024, 1024, (u16*)(p.ws + OFF_WOUT), nullptr, false, gtid, gstride);
  {
    u16* ckv = (u16*)(p.ws + OFF_CKV);
    for (int e = gtid; e < 16 * PAST * 32; e += gstride) {
      const int c8 = e & 31, s = (e >> 5) & 4095, b = e >> 17;
      const f32x4* src = (const f32x4*)(p.cache_ckv + ((size_t)(b * PAST + s) * 256 + c8 * 8));
      const f32x4 a = src[0], c = src[1];
      u32x4 o = {pk2(a.x, a.y), pk2(a.z, a.w), pk2(c.x, c.y), pk2(c.z, c.w)};
      *(u32x4*)(ckv + ((size_t)(NTOK + b * PAST + s) * 256 + c8 * 8)) = o;
    }
    u16* kr = (u16*)(p.ws + OFF_KROPE);
    for (int e = gtid; e < 16 * PAST * 4; e += gstride) {
      const int c8 = e & 3, s = (e >> 2) & 4095, b = e >> 14;
      const f32x4* src = (const f32x4*)(p.cache_krope + ((size_t)(b * PAST + s) * 32 + c8 * 8));
      const f32x4 a = src[0], c = src[1];
      u32x4 o = {pk2(a.x, a.y), pk2(a.z, a.w), pk2(c.x, c.y), pk2(c.z, c.w)};
      *(u32x4*)(kr + ((size_t)(NTOK + b * PAST + s) * 32 + c8 * 8)) = o;
    }
  }
  {
    float* tab = (float*)(p.ws + OFF_ROPE);
    for (int e = gtid; e < 2112 * 16; e += gstride) {
      const int idx = e >> 4, i = e & 15;
      const int pos = idx < 2048 ? idx : PAST + (idx - 2048);
      const float inv = exp2f(-(float)i * (13.287712379549449f / 16.f));
      const float ang = (float)pos * inv;
      tab[idx * 32 + i] = cosf(ang);
      tab[idx * 32 + 16 + i] = sinf(ang);
    }
  }
}

DI void phase1(const P& p) {
  const int lane = threadIdx.x & 63, gw = blockIdx.x * 8 + (threadIdx.x >> 6), ngw = gridDim.x * 8;
  const float* mod = (const float*)(p.ws + OFF_MOD);
  u16* hb = (u16*)(p.ws + OFF_H);
  const f32x4* g4 = (const f32x4*)p.pre_g;
  for (int row = gw * 2; row < NTOK; row += ngw * 2) {
    const float* xr; int bm;
    if (row < NTOK_P) { xr = p.x_prompt + (size_t)row * 1024; bm = row >> 11; }
    else { xr = p.x_sample + (size_t)(row - NTOK_P) * 1024; bm = 32 + ((row - NTOK_P) >> 6); }
    const f32x4* x4 = (const f32x4*)xr;
    const f32x4* sh4 = (const f32x4*)(mod + bm * 3072);
    const f32x4* sc4 = (const f32x4*)(mod + bm * 3072 + 1024);
    f32x4 v[2][4]; float ss0 = 0.f, ss1 = 0.f;
#pragma unroll
    for (int j = 0; j < 4; ++j) { v[0][j] = __builtin_nontemporal_load(x4 + lane + 64 * j); v[1][j] = __builtin_nontemporal_load(x4 + 256 + lane + 64 * j); }
#pragma unroll
    for (int j = 0; j < 4; ++j) {
      ss0 += v[0][j].x * v[0][j].x + v[0][j].y * v[0][j].y + v[0][j].z * v[0][j].z + v[0][j].w * v[0][j].w;
      ss1 += v[1][j].x * v[1][j].x + v[1][j].y * v[1][j].y + v[1][j].z * v[1][j].z + v[1][j].w * v[1][j].w;
    }
#pragma unroll
    for (int o = 1; o < 64; o <<= 1) { ss0 += __shfl_xor(ss0, o); ss1 += __shfl_xor(ss1, o); }
    const float r0 = rsqrtf(ss0 * (1.f / 1024.f) + EPS), r1 = rsqrtf(ss1 * (1.f / 1024.f) + EPS);
#pragma unroll
    for (int j = 0; j < 4; ++j) {
      const int c4 = lane + 64 * j;
      const f32x4 g = g4[c4], sc = sc4[c4], sh = sh4[c4];
      const f32x4 m = g * (sc + 1.f);
      const f32x4 a = v[0][j] * r0 * m + sh, bq = v[1][j] * r1 * m + sh;
      *(u32x2*)(hb + (size_t)row * 1024 + c4 * 4) = (u32x2){pk2(a.x, a.y), pk2(a.z, a.w)};
      *(u32x2*)(hb + (size_t)(row + 1) * 1024 + c4 * 4) = (u32x2){pk2(bq.x, bq.y), pk2(bq.z, bq.w)};
    }
  }
}

#define LAS __attribute__((address_space(3)))
#define GAS __attribute__((address_space(1)))
constexpr int BM = 256, BK = 64, HALF = 128, HTB = HALF * BK * 2, NXCD = 8, WGM = 8;
constexpr int XCH_OFF = 131072;
DI int lds_byte(int r, int c) { const int st = (r >> 4) * 2 + (c >> 5), rr = r & 15, cc = c & 31, ob = rr * 64 + cc * 2; return st * 1024 + (ob ^ (((ob >> 9) & 1) << 5)); }
DI void stage_rc(int b, int& R, int& C) { const int st = b / 1024, sb = b % 1024, swz = sb ^ (((sb >> 9) & 1) << 5); R = (st >> 1) * 16 + swz / 64; C = (st & 1) * 32 + (swz % 64) / 2; }
DI int perm32(int rho) { const int n = rho >> 4, i = rho & 15; return 8 * (i >> 2) + 4 * n + (i & 3); }

struct Unit { int pm, pn; };
struct StaticOrder {
  int nM, nN, nwg, G, c;
  DI void init(int M, int N, int G_, int c_) { nM = M / BM; nN = N / BM; nwg = nM * nN; G = G_; c = c_; }
  DI bool next(int i, Unit& u) const {
    const long L = (long)i * G + c; if (L >= nwg) return false;
    int wgid = (int)L; { const int q = nwg / NXCD, r = nwg % NXCD, xcd = wgid % NXCD, off = wgid / NXCD; wgid = (xcd < r ? xcd * (q + 1) : r * (q + 1) + (xcd - r) * q) + off; }
    const int nig = WGM * nN, gid = wgid / nig, fm = gid * WGM, gsz = (nM - fm) < WGM ? (nM - fm) : WGM;
    u.pm = fm + ((wgid % nig) % gsz); u.pn = (wgid % nig) / gsz; return true;
  }
};

typedef f32x4 acc_t[2][2][4][2];
template <class Epi>
DI void gemm_phase(LAS unsigned char* lds, const u16* Ag, const u16* Btg, const int K, const StaticOrder& S, const Epi& E) {
  int tid = threadIdx.x; asm volatile("" : "+v"(tid));
  const int wid = __builtin_amdgcn_readfirstlane(tid >> 6), lane = tid & 63, wr = wid >> 2, wc = wid & 3, fr = lane & 15, fq = lane >> 4;
  const int nt = K / BK;
  unsigned voffA[2], voffB[2];
#pragma unroll
  for (int i = 0; i < 2; ++i) { int R, C; stage_rc(tid * 16 + i * 8192, R, C); const int Rb = Epi::PERM ? ((R & ~31) + perm32(R & 31)) : R;
    voffA[i] = (unsigned)(R * K + C) * 2u; voffB[i] = (unsigned)(Rb * K + C) * 2u; }
  const size_t kstep = (size_t)(BK * 2);
  const size_t hstep = (size_t)HALF * K * 2;
  const size_t tstep = 2 * hstep;
  const unsigned ldsw = (unsigned)wid * 1024u;
  const int aoff = lds_byte(wr * 64 + fr, fq * 8), boff = lds_byte(wc * 32 + fr, fq * 8);
#define PG8_SA(b, h) (((b) * 2 + (h)) * HTB)
#define PG8_SB(b, h) ((4 + (b) * 2 + (h)) * HTB)
#define PG8_STAGE(bufoff, gbase, voff) do { _Pragma("unroll") for (int _i = 0; _i < 2; ++_i) \
    __builtin_amdgcn_global_load_lds((const unsigned*)((const char*)(gbase) + (voff)[_i]), (LAS unsigned*)(lds + (bufoff) + ldsw + _i * 8192), 16, 0, 0); } while (0)
#define PG8_LDA(dst, b, h) do { _Pragma("unroll") for (int m = 0; m < 4; ++m) _Pragma("unroll") for (int k = 0; k < 2; ++k) dst[m][k] = *(const LAS bf16x8*)(lds + PG8_SA(b, h) + aoff + m * 2048 + k * 1024); } while (0)
#define PG8_LDB(dst, b, h) do { _Pragma("unroll") for (int n = 0; n < 2; ++n) _Pragma("unroll") for (int k = 0; k < 2; ++k) dst[n][k] = *(const LAS bf16x8*)(lds + PG8_SB(b, h) + boff + n * 2048 + k * 1024); } while (0)
#define PG8_MMA(ai, bj, At, Bt) do { __builtin_amdgcn_s_setprio(1); _Pragma("unroll") for (int m = 0; m < 4; ++m) _Pragma("unroll") for (int n = 0; n < 2; ++n) _Pragma("unroll") for (int k = 0; k < 2; ++k) \
    acc[ai][bj][m][n] = __builtin_amdgcn_mfma_f32_16x16x32_bf16(Bt[n][k], At[m][k], acc[ai][bj][m][n], 0, 0, 0); __builtin_amdgcn_s_setprio(0); } while (0)
#define PG8_WAIT_V(n) asm volatile("s_waitcnt vmcnt(" #n ")" ::: "memory")
#define PG8_WAIT_L(n) asm volatile("s_waitcnt lgkmcnt(" #n ")" ::: "memory")
#define PG8_BAR __builtin_amdgcn_s_barrier()
#define PG8_SCHED __builtin_amdgcn_sched_barrier(0)
  Unit cur, nxt; int ui = 0;
  if (!S.next(0, cur)) return;
  f32x4 acc[2][2][4][2];
#pragma unroll
  for (int a = 0; a < 2; ++a)
#pragma unroll
    for (int b = 0; b < 2; ++b)
#pragma unroll
      for (int m = 0; m < 4; ++m)
#pragma unroll
        for (int n = 0; n < 2; ++n) acc[a][b][m][n] = (f32x4){0.f, 0.f, 0.f, 0.f};
  bf16x8 At[4][2], B0[2][2], B1[2][2];
  const char* cA = (const char*)Ag + (size_t)cur.pm * tstep; const char* cB = (const char*)Btg + (size_t)cur.pn * tstep;
  PG8_STAGE(PG8_SB(0, 0), cB, voffB); PG8_STAGE(PG8_SA(0, 0), cA, voffA); PG8_STAGE(PG8_SB(0, 1), cB + hstep, voffB); PG8_STAGE(PG8_SA(0, 1), cA + hstep, voffA);
  if (wr == 1) PG8_BAR;
  PG8_WAIT_V(4); PG8_BAR;
  PG8_STAGE(PG8_SB(1, 0), cB + kstep, voffB); PG8_STAGE(PG8_SA(1, 0), cA + kstep, voffA); PG8_STAGE(PG8_SB(1, 1), cB + hstep + kstep, voffB);
  PG8_WAIT_V(6); PG8_BAR;
  for (;;) {
    const bool has_next = S.next(ui + 1, nxt);
    const char* nA = has_next ? (const char*)Ag + (size_t)nxt.pm * tstep : cA; const char* nB = has_next ? (const char*)Btg + (size_t)nxt.pn * tstep : cB;
#pragma unroll 1
    for (int t = 0; t < nt; t += 2) {
      const bool last = (t == nt - 2);
      const char* a1 = cA + (size_t)(t + 1) * kstep;
      const char* a2 = last ? nA : cA + (size_t)(t + 2) * kstep; const char* b2 = last ? nB : cB + (size_t)(t + 2) * kstep;
      const char* a3 = a2 + kstep; const char* b3 = b2 + kstep;
      PG8_LDB(B0, 0, 0); PG8_SCHED; PG8_LDA(At, 0, 0); PG8_STAGE(PG8_SA(1, 1), a1 + hstep, voffA);
      PG8_WAIT_L(8); PG8_BAR; PG8_WAIT_L(0); PG8_MMA(0, 0, At, B0); PG8_BAR; PG8_SCHED;
      PG8_LDB(B1, 0, 1); PG8_STAGE(PG8_SB(0, 0), b2, voffB);
      PG8_BAR; PG8_WAIT_L(0); PG8_MMA(0, 1, At, B1); PG8_BAR;
      PG8_LDA(At, 0, 1); PG8_STAGE(PG8_SA(0, 0), a2, voffA);
      PG8_BAR; PG8_WAIT_L(0); PG8_MMA(1, 0, At, B0); PG8_BAR; PG8_SCHED;
      PG8_STAGE(PG8_SB(0, 1), b2 + hstep, voffB);
      PG8_WAIT_V(6); PG8_BAR; PG8_MMA(1, 1, At, B1); PG8_BAR;
      PG8_LDB(B0, 1, 0); PG8_SCHED; PG8_LDA(At, 1, 0); PG8_STAGE(PG8_SA(0, 1), a2 + hstep, voffA);
      PG8_WAIT_L(8); PG8_BAR; PG8_WAIT_L(0); PG8_MMA(0, 0, At, B0); PG8_BAR; PG8_SCHED;
      PG8_LDB(B1, 1, 1); PG8_STAGE(PG8_SB(1, 0), b3, voffB);
      PG8_BAR; PG8_WAIT_L(0); PG8_MMA(0, 1, At, B1); PG8_BAR;
      PG8_LDA(At, 1, 1); PG8_STAGE(PG8_SA(1, 0), a3, voffA);
      PG8_BAR; PG8_WAIT_L(0); PG8_MMA(1, 0, At, B0); PG8_BAR; PG8_SCHED;
      PG8_STAGE(PG8_SB(1, 1), b3 + hstep, voffB);
      PG8_WAIT_V(6); PG8_BAR; PG8_MMA(1, 1, At, B1); PG8_BAR;
    }
    E(acc, cur, wr, wc, fr, fq);
    if (!has_next) break;
#pragma unroll
    for (int a = 0; a < 2; ++a)
#pragma unroll
      for (int b = 0; b < 2; ++b)
#pragma unroll
        for (int m = 0; m < 4; ++m)
#pragma unroll
          for (int n = 0; n < 2; ++n) acc[a][b][m][n] = (f32x4){0.f, 0.f, 0.f, 0.f};
    cur = nxt; cA = nA; cB = nB; ++ui;
  }
  PG8_WAIT_V(0);
  if (wr == 0) PG8_BAR;
  PG8_BAR;
#undef PG8_SA
#undef PG8_SB
#undef PG8_STAGE
#undef PG8_LDA
#undef PG8_LDB
#undef PG8_MMA
#undef PG8_WAIT_V
#undef PG8_WAIT_L
#undef PG8_BAR
#undef PG8_SCHED
}

DI u32x4 pack8(const f32x4 a, const f32x4 b) { return (u32x4){pk2(a.x, a.y), pk2(a.z, a.w), pk2(b.x, b.y), pk2(b.z, b.w)}; }
DI float sq4(const f32x4 a) { return (a.x * a.x + a.y * a.y) + (a.z * a.z + a.w * a.w); }

DI void rowsum_xch(float (&ss)[2][4], LAS float* xch, int wr, int wc, int fr, int fq) {
#pragma unroll
  for (int ai = 0; ai < 2; ++ai)
#pragma unroll
    for (int m = 0; m < 4; ++m) { float s = ss[ai][m]; s += __shfl_xor(s, 16); s += __shfl_xor(s, 32); ss[ai][m] = s; }
  if (fq == 0) {
#pragma unroll
    for (int ai = 0; ai < 2; ++ai)
#pragma unroll
      for (int m = 0; m < 4; ++m) xch[(128 * ai + 64 * wr + 16 * m + fr) * 4 + wc] = ss[ai][m];
  }
  asm volatile("s_waitcnt lgkmcnt(0)" ::: "memory");
  __builtin_amdgcn_s_barrier();
  asm volatile("" ::: "memory");
#pragma unroll
  for (int ai = 0; ai < 2; ++ai)
#pragma unroll
    for (int m = 0; m < 4; ++m) { const f32x4 t = *(const LAS f32x4*)(xch + (128 * ai + 64 * wr + 16 * m + fr) * 4); ss[ai][m] = (t.x + t.y) + (t.z + t.w); }
}

struct EpiG1 {
  static constexpr bool PERM = true;
  P p; LAS unsigned char* lds;
  DI void operator()(const acc_t& acc, const Unit& u, int, int, int, int) const {
    int t_ = threadIdx.x; asm volatile("" : "+v"(t_));
    const int wid_ = __builtin_amdgcn_readfirstlane(t_ >> 6), wr = wid_ >> 2, wc = wid_ & 3, fr = t_ & 15, fq = (t_ >> 4) & 3;
    GAS char* ws_ = (GAS char*)p.ws; GAS float* out_ = (GAS float*)p.out; asm volatile("" : "+s"(ws_), "+s"(out_));
    (void)out_;
    const int nt = u.pn;
    const bool samp = u.pm >= 256;
    const int row0 = u.pm * 256 + wr * 64 + fr;
    const int rl0 = samp ? row0 - NTOK_P : row0;
    const int c8 = wc * 32 + 8 * fq;
    if (nt < 2) {
      GAS u16* base = (GAS u16*)(ws_ + OFF_SBQ) + nt * 256 + c8;
#pragma unroll
      for (int ai = 0; ai < 2; ++ai)
#pragma unroll
        for (int m = 0; m < 4; ++m) { GAS u16* rp = base + (size_t)(row0 + ai * 128 + m * 16) * 512;
#pragma unroll
          for (int bj = 0; bj < 2; ++bj) *(GAS u32x4*)(rp + bj * 128) = pack8(acc[ai][bj][m][0] * QS_SB, acc[ai][bj][m][1] * QS_SB); }
    } else if (nt < 6) {
      const bool isv = nt >= 4;
      const int cb = (nt & 1) * 256 + c8;
      GAS float* ofb = out_ + (samp ? (isv ? O_SVS : O_SKS) : (isv ? O_SVP : O_SKP)) + cb;
#pragma unroll
      for (int ai = 0; ai < 2; ++ai)
#pragma unroll
        for (int m = 0; m < 4; ++m) { GAS float* of = ofb + (size_t)(rl0 + ai * 128 + m * 16) * 512;
#pragma unroll
          for (int bj = 0; bj < 2; ++bj) { *(GAS f32x4*)(of + bj * 128) = acc[ai][bj][m][0]; *(GAS f32x4*)(of + bj * 128 + 4) = acc[ai][bj][m][1];
          } }
    } else if (nt < 8 || nt >= 11) {
      const int cb = (nt < 8 ? (nt - 6) * 256 : 512 + (nt - 11) * 256) + c8;
      GAS u16* base = (GAS u16*)(ws_ + OFF_GATES) + cb;
#pragma unroll
      for (int ai = 0; ai < 2; ++ai)
#pragma unroll
        for (int m = 0; m < 4; ++m) { GAS u16* rp = base + (size_t)(row0 + ai * 128 + m * 16) * 1024;
#pragma unroll
          for (int bj = 0; bj < 2; ++bj) { f32x4 a = acc[ai][bj][m][0], b = acc[ai][bj][m][1];
            a.x = silu_f(a.x); a.y = silu_f(a.y); a.z = silu_f(a.z); a.w = silu_f(a.w); b.x = silu_f(b.x); b.y = silu_f(b.y); b.z = silu_f(b.z); b.w = silu_f(b.w);
            *(GAS u32x4*)(rp + bj * 128) = pack8(a, b); } }
    } else if (nt == 8 || nt == 9) {
      const int part = nt - 8;
      float ss[2][4];
#pragma unroll
      for (int ai = 0; ai < 2; ++ai)
#pragma unroll
        for (int m = 0; m < 4; ++m) { float s = sq4(acc[ai][0][m][0]) + sq4(acc[ai][0][m][1]); if (part == 0) s += sq4(acc[ai][1][m][0]) + sq4(acc[ai][1][m][1]); ss[ai][m] = s; }
      rowsum_xch(ss, (LAS float*)(lds + XCH_OFF), wr, wc, fr, fq);
      GAS float* cqss = (GAS float*)(ws_ + OFF_CQSS) + (size_t)part * NTOK;
      if (wc == 0 && fq == 0) {
#pragma unroll
        for (int ai = 0; ai < 2; ++ai)
#pragma unroll
          for (int m = 0; m < 4; ++m) cqss[row0 + ai * 128 + m * 16] = ss[ai][m];
      }
      GAS u16* base = (GAS u16*)(ws_ + OFF_CQ) + part * 256 + c8;
#pragma unroll
      for (int ai = 0; ai < 2; ++ai)
#pragma unroll
        for (int m = 0; m < 4; ++m) { GAS u16* rp = base + (size_t)(row0 + ai * 128 + m * 16) * 384;
          *(GAS u32x4*)(rp) = pack8(acc[ai][0][m][0], acc[ai][0][m][1]);
          if (part == 0) *(GAS u32x4*)(rp + 128) = pack8(acc[ai][1][m][0], acc[ai][1][m][1]); }
      if (part == 1 && wc == 0) {
        const GAS float* tab = (const GAS float*)(ws_ + OFF_ROPE);
        GAS float* okr = out_ + (samp ? O_KRS : O_KRP);
        GAS u16* kr = (GAS u16*)(ws_ + OFF_KROPE);
        const int i0 = (8 * fq) & 15;
#pragma unroll
        for (int ai = 0; ai < 2; ++ai)
#pragma unroll
          for (int m = 0; m < 4; ++m) {
            const int row = row0 + ai * 128 + m * 16, rl = rl0 + ai * 128 + m * 16;
            const int ridx = samp ? 2048 + (rl & 63) : (rl & 2047);
            f32x4 o[2];
#pragma unroll
            for (int n = 0; n < 2; ++n) {
              const f32x4 cs = *(const GAS f32x4*)(tab + ridx * 32 + i0 + 4 * n), sn = *(const GAS f32x4*)(tab + ridx * 32 + 16 + i0 + 4 * n);
              const f32x4 mine = acc[ai][1][m][n];
              f32x4 oth; oth.x = __shfl_xor(mine.x, 32); oth.y = __shfl_xor(mine.y, 32); oth.z = __shfl_xor(mine.z, 32); oth.w = __shfl_xor(mine.w, 32);
              o[n] = (fq < 2) ? (mine * cs - oth * sn) : (mine * cs + oth * sn);
            }
            *(GAS f32x4*)(okr + (size_t)rl * 32 + 8 * fq) = o[0]; *(GAS f32x4*)(okr + (size_t)rl * 32 + 8 * fq + 4) = o[1];
            *(GAS u32x4*)(kr + (size_t)row * 32 + 8 * fq) = pack8(o[0], o[1]);
          }
      }
    } else {
      float ss[2][4];
#pragma unroll
      for (int ai = 0; ai < 2; ++ai)
#pragma unroll
        for (int m = 0; m < 4; ++m) ss[ai][m] = (sq4(acc[ai][0][m][0]) + sq4(acc[ai][0][m][1])) + (sq4(acc[ai][1][m][0]) + sq4(acc[ai][1][m][1]));
      rowsum_xch(ss, (LAS float*)(lds + XCH_OFF), wr, wc, fr, fq);
      GAS float* ofb = out_ + (samp ? O_CKVS : O_CKVP) + c8;
      GAS u16* base = (GAS u16*)(ws_ + OFF_CKV) + c8;
      f32x4 gv[2][2];
#pragma unroll
      for (int bj = 0; bj < 2; ++bj)
#pragma unroll
        for (int n = 0; n < 2; ++n) gv[bj][n] = *(const f32x4*)(p.kv_norm_g + bj * 128 + c8 + 4 * n);
#pragma unroll
      for (int ai = 0; ai < 2; ++ai)
#pragma unroll
        for (int m = 0; m < 4; ++m) {
          const float r = rsqrtf(ss[ai][m] * (1.f / 256.f) + EPS);
          GAS float* of = ofb + (size_t)(rl0 + ai * 128 + m * 16) * 256; GAS u16* rp = base + (size_t)(row0 + ai * 128 + m * 16) * 256;
#pragma unroll
          for (int bj = 0; bj < 2; ++bj) {
            const f32x4 a = acc[ai][bj][m][0] * r * gv[bj][0], b = acc[ai][bj][m][1] * r * gv[bj][1];
            *(GAS f32x4*)(of + bj * 128) = a; *(GAS f32x4*)(of + bj * 128 + 4) = b;
            *(GAS u32x4*)(rp + bj * 128) = pack8(a, b);
          }
        }
    }
  }
};

struct EpiG2 {
  static constexpr bool PERM = false;
  P p;
  DI void operator()(const acc_t& acc, const Unit& u, int, int, int, int) const {
    int t_ = threadIdx.x; asm volatile("" : "+v"(t_));
    const int wid_ = __builtin_amdgcn_readfirstlane(t_ >> 6), wr = wid_ >> 2, wc = wid_ & 3, fr = t_ & 15, fq = (t_ >> 4) & 3;
    GAS char* ws_ = (GAS char*)p.ws; GAS float* out_ = (GAS float*)p.out; asm volatile("" : "+s"(ws_), "+s"(out_));
    (void)out_;
    const bool samp = u.pm >= 256;
    const int row0 = u.pm * 256 + wr * 64 + fr;
    const GAS float* cqss = (const GAS float*)(ws_ + OFF_CQSS);
    const GAS float* tab = (const GAS float*)(ws_ + OFF_ROPE);
    GAS u16* dst = (GAS u16*)(ws_ + OFF_QMLA);
#pragma unroll
    for (int ai = 0; ai < 2; ++ai)
#pragma unroll
      for (int m = 0; m < 4; ++m) {
        const int row = row0 + ai * 128 + m * 16;
        const float r = rsqrtf((cqss[row] + cqss[NTOK + row]) * (1.f / 384.f) + EPS) * QS_MLA;
        const int ridx = samp ? 2048 + ((row - NTOK_P) & 63) : (row & 2047);
#pragma unroll
        for (int bj = 0; bj < 2; ++bj) {
          const int gi = u.pn * 8 + bj * 4 + wc;
          f32x4 x1 = acc[ai][bj][m][0] * r, x2 = acc[ai][bj][m][1] * r;
          if (gi % 3 == 2) {
            const f32x4 cs = *(const GAS f32x4*)(tab + ridx * 32 + 4 * fq), sn = *(const GAS f32x4*)(tab + ridx * 32 + 16 + 4 * fq);
            const f32x4 o1 = x1 * cs - x2 * sn, o2 = x2 * cs + x1 * sn;
            x1 = o1; x2 = o2;
          }
          GAS u16* rp = dst + (size_t)row * 768 + gi * 32 + 4 * fq;
          *(GAS u32x2*)(rp) = (u32x2){pk2(x1.x, x1.y), pk2(x1.z, x1.w)};
          *(GAS u32x2*)(rp + 16) = (u32x2){pk2(x2.x, x2.y), pk2(x2.z, x2.w)};
        }
        __builtin_amdgcn_sched_barrier(0);
      }
  }
};

struct EpiG3 {
  static constexpr bool PERM = true;
  P p;
  DI void operator()(const acc_t& acc, const Unit& u, int, int, int, int) const {
    int t_ = threadIdx.x; asm volatile("" : "+v"(t_));
    const int wid_ = __builtin_amdgcn_readfirstlane(t_ >> 6), wr = wid_ >> 2, wc = wid_ & 3, fr = t_ & 15, fq = (t_ >> 4) & 3;
    GAS char* ws_ = (GAS char*)p.ws; GAS float* out_ = (GAS float*)p.out; asm volatile("" : "+s"(ws_), "+s"(out_));
    (void)out_;
    GAS u16* base = (GAS u16*)(ws_ + OFF_KV) + u.pn * 256 + wc * 32 + 8 * fq;
    const int row0 = u.pm * 256 + wr * 64 + fr;
#pragma unroll
    for (int ai = 0; ai < 2; ++ai)
#pragma unroll
      for (int m = 0; m < 4; ++m) { GAS u16* rp = base + (size_t)(row0 + ai * 128 + m * 16) * 1024;
#pragma unroll
        for (int bj = 0; bj < 2; ++bj) *(GAS u32x4*)(rp + bj * 128) = pack8(acc[ai][bj][m][0], acc[ai][bj][m][1]); }
  }
};

struct EpiG4 {
  static constexpr bool PERM = true;
  P p; LAS unsigned char* lds;
  DI void operator()(const acc_t& acc, const Unit& u, int, int, int, int) const {
    int t_ = threadIdx.x; asm volatile("" : "+v"(t_));
    const int wid_ = __builtin_amdgcn_readfirstlane(t_ >> 6), wr = wid_ >> 2, wc = wid_ & 3, fr = t_ & 15, fq = (t_ >> 4) & 3;
    GAS char* ws_ = (GAS char*)p.ws; GAS float* out_ = (GAS float*)p.out; asm volatile("" : "+s"(ws_), "+s"(out_));
    (void)out_;
    const int row0 = u.pm * 256 + wr * 64 + fr;
    float ss[2][4];
#pragma unroll
    for (int ai = 0; ai < 2; ++ai)
#pragma unroll
      for (int m = 0; m < 4; ++m) ss[ai][m] = (sq4(acc[ai][0][m][0]) + sq4(acc[ai][0][m][1])) + (sq4(acc[ai][1][m][0]) + sq4(acc[ai][1][m][1]));
    rowsum_xch(ss, (LAS float*)(lds + XCH_OFF), wr, wc, fr, fq);
    GAS float* rss = (GAS float*)(ws_ + OFF_ROWSS) + (size_t)u.pn * NTOK;
    if (wc == 0 && fq == 0) {
#pragma unroll
      for (int ai = 0; ai < 2; ++ai)
#pragma unroll
        for (int m = 0; m < 4; ++m) rss[row0 + ai * 128 + m * 16] = ss[ai][m];
    }
    GAS u16* base = (GAS u16*)(ws_ + OFF_GATES) + u.pn * 256 + wc * 32 + 8 * fq;
#pragma unroll
    for (int ai = 0; ai < 2; ++ai)
#pragma unroll
      for (int m = 0; m < 4; ++m) { GAS u16* rp = base + (size_t)(row0 + ai * 128 + m * 16) * 1024;
#pragma unroll
        for (int bj = 0; bj < 2; ++bj) *(GAS u32x4*)(rp + bj * 128) = pack8(acc[ai][bj][m][0], acc[ai][bj][m][1]); }
  }
};

DI void gemm_g1(const P& p, char* smem) {
  StaticOrder S; S.init(NTOK, NPAD, gridDim.x, blockIdx.x);
  EpiG1 E{p, (LAS unsigned char*)smem};
  gemm_phase((LAS unsigned char*)smem, (const u16*)(p.ws + OFF_H), (const u16*)(p.ws + OFF_WIN), 1024, S, E);
}
DI void gemm_g23(const P& p, char* smem) {
  { StaticOrder S; S.init(NTOK, 768, gridDim.x, blockIdx.x);
    EpiG2 E{p};
    gemm_phase((LAS unsigned char*)smem, (const u16*)(p.ws + OFF_CQ), (const u16*)(p.ws + OFF_WUQ), 384, S, E); }
  { StaticOrder S; S.init(NKV, 1024, gridDim.x, (blockIdx.x + 128) % gridDim.x);
    EpiG3 E{p};
    gemm_phase((LAS unsigned char*)smem, (const u16*)(p.ws + OFF_CKV), (const u16*)(p.ws + OFF_WUKV), 256, S, E); }
}
DI void gemm_g4(const P& p, char* smem) {
  StaticOrder S; S.init(NTOK, 1024, gridDim.x, blockIdx.x);
  EpiG4 E{p, (LAS unsigned char*)smem};
  gemm_phase((LAS unsigned char*)smem, (const u16*)(p.ws + OFF_H), (const u16*)(p.ws + OFF_WOUT), 1024, S, E);
}

constexpr int KS_SB = 144, KS_MLA = 208, VS = 192;
constexpr int MLA_STAGE = 64 * KS_MLA + 64 * VS;
constexpr int SB_STAGE = 64 * KS_SB + 64 * VS;
constexpr int FLAG_OFF = 65536;

DI void pv_step(const char* Vt, const bf16x8 (&pb)[4], f32x16 (&o)[2], int lane) {
  const int lh = lane >> 5, q4 = (lane & 15) >> 2, p4 = lane & 3, g1 = (lane >> 4) & 1;
  const char* vb = Vt + (4 * lh + q4) * VS + 32 * g1 + 8 * p4;
#pragma unroll
  for (int ks = 0; ks < 4; ++ks) {
#pragma unroll
    for (int dvt = 0; dvt < 2; ++dvt) {
      const s16x4 lo = tr_read(vb + (ks * 16) * VS + dvt * 64);
      const s16x4 hi = tr_read(vb + (ks * 16 + 8) * VS + dvt * 64);
      const bf16x8 vf = __builtin_shufflevector(lo, hi, 0, 1, 2, 3, 4, 5, 6, 7);
      o[dvt] = MFMA32(vf, pb[ks], o[dvt]);
    }
  }
}

DI void pack_p(const f32x16 (&s)[2], bf16x8 (&pb)[4]) {
#pragma unroll
  for (int mt = 0; mt < 2; ++mt)
#pragma unroll
    for (int h = 0; h < 2; ++h) {
      u32x4 t = {pk2(s[mt][8 * h + 0], s[mt][8 * h + 1]), pk2(s[mt][8 * h + 2], s[mt][8 * h + 3]),
                 pk2(s[mt][8 * h + 4], s[mt][8 * h + 5]), pk2(s[mt][8 * h + 6], s[mt][8 * h + 7])};
      pb[mt * 2 + h] = __builtin_bit_cast(bf16x8, t);
    }
}

DI void store_o(const P& p, const f32x16 (&o)[2], float inv, size_t tok, int colbase, int lh) {
  const u16* gates = (const u16*)(p.ws + OFF_GATES);
  u16* mixed = (u16*)(p.ws + OFF_H);
#pragma unroll
  for (int dvt = 0; dvt < 2; ++dvt)
#pragma unroll
    for (int g = 0; g < 4; ++g) {
      const size_t off = tok * 1024 + colbase + dvt * 32 + g * 8 + lh * 4;
      const u32x2 gt = *(const u32x2*)(gates + off);
      u32x2 ov = {pk2(o[dvt][4 * g + 0] * inv * bflo(gt.x), o[dvt][4 * g + 1] * inv * bfhi(gt.x)),
                  pk2(o[dvt][4 * g + 2] * inv * bflo(gt.y), o[dvt][4 * g + 3] * inv * bfhi(gt.y))};
      *(u32x2*)(mixed + off) = ov;
    }
}

DI void mla_item(const P& p, char* smem, int b, int hd, int q0, bool samp) {
  int tid = threadIdx.x; asm volatile("" : "+v"(tid));
  const int w = __builtin_amdgcn_readfirstlane(tid >> 6), lane = tid & 63, l32 = lane & 31, lh = lane >> 5;
  const bool active = samp ? (w < 4) : true;
  const int hw = samp ? hd + (w >> 1) : hd;
  const int qw0 = samp ? (w & 1) * 32 : q0 + w * 32;
  constexpr int STG = 2 * MLA_STAGE;
  const int hoff = samp ? (w >> 1) * MLA_STAGE : 0;
  const size_t tokrow0 = samp ? (size_t)(NTOK_P + b * 64) : (size_t)b * 2048;
  const int nkb_blk = samp ? 65 : (q0 / 64 + 4);
  const int nkb_w = samp ? 65 : (qw0 / 64 + 1);
  const u16* kv = (const u16*)(p.ws + OFF_KV);
  const u16* krope = (const u16*)(p.ws + OFF_KROPE);
  bf16x8 qf[6];
  if (active) {
    const u16* qp = (const u16*)(p.ws + OFF_QMLA) + (tokrow0 + qw0 + l32) * 768 + hw * 96 + lh * 8;
#pragma unroll
    for (int ks = 0; ks < 6; ++ks) qf[ks] = *(const bf16x8*)(qp + ks * 16);
  } else {
#pragma unroll
    for (int ks = 0; ks < 6; ++ks) qf[ks] = (bf16x8){0, 0, 0, 0, 0, 0, 0, 0};
  }
  u32x4 rkn, rvv, rkr, rkn2, rvv2;
  rkr = rkn2 = rvv2 = (u32x4){0, 0, 0, 0};
  auto gload = [&](int kb) {
    const size_t trow0 = samp ? (kb < 64 ? (size_t)(NTOK + b * PAST + kb * 64) : (size_t)(NTOK_P + b * 64)) : (size_t)(b * 2048 + kb * 64);
    if (samp) {
      const int h2 = tid >> 8, u = tid & 255;
      const u16* base = kv + (trow0 + (u >> 3)) * 1024 + (hd + h2) * 128 + (u & 7) * 8;
      rkn = *(const u32x4*)base; rvv = *(const u32x4*)(base + 64);
      rkn2 = *(const u32x4*)(base + 32 * 1024); rvv2 = *(const u32x4*)(base + 32 * 1024 + 64);
      rkr = *(const u32x4*)(krope + (trow0 + (u >> 2)) * 32 + (u & 3) * 8);
    } else {
      const size_t row = trow0 + (tid >> 3);
      const u16* base = kv + row * 1024 + hd * 128 + (tid & 7) * 8;
      rkn = *(const u32x4*)base;
      rvv = *(const u32x4*)(base + 64);
      if (tid < 256) rkr = *(const u32x4*)(krope + (trow0 + (tid >> 2)) * 32 + (tid & 3) * 8);
    }
  };
  auto lstore = [&](int buf) {
    if (samp) {
      const int h2 = tid >> 8, u = tid & 255;
      char* Kt = smem + buf * STG + h2 * MLA_STAGE; char* Vt = Kt + 64 * KS_MLA;
      *(u32x4*)(Kt + (u >> 3) * KS_MLA + (u & 7) * 16) = rkn;
      *(u32x4*)(Kt + (32 + (u >> 3)) * KS_MLA + (u & 7) * 16) = rkn2;
      *(u32x4*)(Vt + (u >> 3) * VS + (u & 7) * 16) = rvv;
      *(u32x4*)(Vt + (32 + (u >> 3)) * VS + (u & 7) * 16) = rvv2;
      *(u32x4*)(Kt + (u >> 2) * KS_MLA + 128 + (u & 3) * 16) = rkr;
    } else {
      char* Kt = smem + buf * STG; char* Vt = Kt + 64 * KS_MLA;
      *(u32x4*)(Kt + (tid >> 3) * KS_MLA + (tid & 7) * 16) = rkn;
      *(u32x4*)(Vt + (tid >> 3) * VS + (tid & 7) * 16) = rvv;
      if (tid < 256) *(u32x4*)(Kt + (tid >> 2) * KS_MLA + 128 + (tid & 3) * 16) = rkr;
    }
  };
  f32x16 o[2];
#pragma unroll
  for (int i = 0; i < 16; ++i) { o[0][i] = 0.f; o[1][i] = 0.f; }
  float mrun = -1e30f, lsum = 0.f;
  gload(0); lstore(0);
  __syncthreads();
  for (int kb = 0; kb < nkb_blk; ++kb) {
    const bool has_next = kb + 1 < nkb_blk;
    if (has_next) gload(kb + 1);
    if (active && kb < nkb_w) {
      const char* Kt = smem + (kb & 1) * STG + hoff; const char* Vt = Kt + 64 * KS_MLA;
      f32x16 s[2];
      const float cinit = (kb == 0) ? 0.f : -mrun;
#pragma unroll
      for (int i = 0; i < 16; ++i) { s[0][i] = cinit; s[1][i] = cinit; }
      const char* kp = Kt + l32 * KS_MLA + lh * 16;
#pragma unroll
      for (int ks = 0; ks < 6; ++ks) {
        const bf16x8 a0 = *(const bf16x8*)(kp + ks * 32);
        const bf16x8 a1 = *(const bf16x8*)(kp + 32 * KS_MLA + ks * 32);
        s[0] = MFMA32(a0, qf[ks], s[0]);
        s[1] = MFMA32(a1, qf[ks], s[1]);
      }
      f32x16 e[2];
      float ps0 = 0.f, ps1 = 0.f;
      bool redo = (kb == 0);
      if (!redo) {
#pragma unroll
        for (int i = 0; i < 16; ++i) { e[0][i] = ex2(s[0][i]); e[1][i] = ex2(s[1][i]); ps0 += e[0][i]; ps1 += e[1][i]; }
        redo = (__builtin_amdgcn_ballot_w64(!(ps0 + ps1 < 1e18f)) != 0ull);
      }
      if (redo) {
        float mx = fmaxf(s[0][0], s[1][0]);
#pragma unroll
        for (int i = 1; i < 16; ++i) mx = fmaxf(mx, fmaxf(s[0][i], s[1][i]));
        mx = fmaxf(mx, __shfl_xor(mx, 32));
        const float up = (kb == 0) ? mx : fmaxf(mx, 0.f);
        const float alpha = (kb == 0) ? 0.f : ex2(-up);
        lsum *= alpha;
#pragma unroll
        for (int i = 0; i < 16; ++i) { o[0][i] *= alpha; o[1][i] *= alpha; }
        mrun = (kb == 0) ? mx : mrun + up;
        ps0 = 0.f; ps1 = 0.f;
#pragma unroll
        for (int i = 0; i < 16; ++i) { e[0][i] = ex2(s[0][i] - up); e[1][i] = ex2(s[1][i] - up); ps0 += e[0][i]; ps1 += e[1][i]; }
      }
      lsum += ps0 + ps1;
      bf16x8 pb[4];
      pack_p(e, pb);
      pv_step(Vt, pb, o, lane);
    }
    if (has_next) lstore((kb + 1) & 1);
    __syncthreads();
  }
  if (active) {
    const float lt = lsum + __shfl_xor(lsum, 32);
    store_o(p, o, 1.f / lt, tokrow0 + qw0 + l32, 512 + hw * 64, lh);
  }
}

constexpr int SB_NS = 6;
DI void sb_item(const P& p, char* smem, int b, int hd, int q0, bool samp) {
  int tid = threadIdx.x; asm volatile("" : "+v"(tid));
  const int w = __builtin_amdgcn_readfirstlane(tid >> 6), lane = tid & 63, l32 = lane & 31, lh = lane >> 5;
  const int nq = samp ? 64 : 256;
  const bool active = (w * 32 < nq);
  const int qw0 = q0 + w * 32;
  const int qpos_w0 = samp ? PAST + qw0 : qw0;
  const size_t tokrow0 = samp ? (size_t)(NTOK_P + b * 64) : (size_t)b * 2048;
  const int dw = samp ? 64 : (q0 >> 6) + (w >> 1);
  const int d_min = samp ? 64 : (q0 >> 6), d_cnt = samp ? 1 : 4;
  int* flags = (int*)(smem + SB_NS * SB_STAGE);
  bf16x8 qf[4];
  if (active) {
    const u16* qp = (const u16*)(p.ws + OFF_SBQ) + (tokrow0 + qw0 + l32) * 512 + hd * 64 + lh * 8;
#pragma unroll
    for (int ks = 0; ks < 4; ++ks) qf[ks] = *(const bf16x8*)(qp + ks * 16);
  } else {
#pragma unroll
    for (int ks = 0; ks < 4; ++ks) qf[ks] = (bf16x8){0, 0, 0, 0, 0, 0, 0, 0};
  }
  const int r = tid >> 3, c = tid & 7;
  const float* nk = p.out + (samp ? O_SKS : O_SKP);
  const float* nv = p.out + (samp ? O_SVS : O_SVP);
  auto src_off = [&](int kb) -> size_t {
    return samp ? (kb < 64 ? ((size_t)(b * PAST + kb * 64 + r) * 8 + hd) * 64 + c * 8 : (size_t)(b * 64 + r) * 512 + hd * 64 + c * 8)
                : ((size_t)b * 2048 + (size_t)kb * 64 + r) * 512 + hd * 64 + c * 8;
  };
  {
    f32x4 pk[4][2], pv[4][2];
#pragma unroll
    for (int i = 0; i < 4; ++i) {
      if (i < d_cnt) {
        const size_t off = src_off(d_min + i);
        const f32x4* ks = (const f32x4*)(nk + off); const f32x4* vs = (const f32x4*)(nv + off);
        pk[i][0] = ks[0]; pk[i][1] = ks[1]; pv[i][0] = vs[0]; pv[i][1] = vs[1];
      }
    }
#pragma unroll
    for (int i = 0; i < 4; ++i) {
      if (i < d_cnt) {
        char* Kt = smem + ((d_min + i) % SB_NS) * SB_STAGE; char* Vt = Kt + 64 * KS_SB;
        *(u32x4*)(Kt + r * KS_SB + c * 16) = pack8(pk[i][0], pk[i][1]);
        *(u32x4*)(Vt + r * VS + c * 16) = pack8(pv[i][0], pv[i][1]);
      }
    }
  }
  f32x4 fk0, fk1, fv0, fv1;
  fk0 = fk1 = fv0 = fv1 = (f32x4){0.f, 0.f, 0.f, 0.f};
  auto gload = [&](int kb) {
    const size_t off = src_off(kb);
    const f32x4* ks = (const f32x4*)((samp ? p.cache_sb_k : nk) + off);
    const f32x4* vs = (const f32x4*)((samp ? p.cache_sb_v : nv) + off);
    fk0 = ks[0]; fk1 = ks[1]; fv0 = vs[0]; fv1 = vs[1];
  };
  auto lstore = [&](int kb) {
    char* Kt = smem + (kb % SB_NS) * SB_STAGE; char* Vt = Kt + 64 * KS_SB;
    *(u32x4*)(Kt + r * KS_SB + c * 16) = pack8(fk0, fk1);
    *(u32x4*)(Vt + r * VS + c * 16) = pack8(fv0, fv1);
  };
  f32x16 o[2];
#pragma unroll
  for (int i = 0; i < 16; ++i) { o[0][i] = 0.f; o[1][i] = 0.f; }
  float Pg = 1.f;
  bool done = false;
  __syncthreads();
  for (int t = 0;; ++t) {
    const int kbn = d_min - (t + 1);
    const bool has_next = kbn >= 0;
    if (has_next) gload(kbn);
    const int kbw = dw - t;
    if (active && !done && kbw >= 0) {
      const char* Kt = smem + (kbw % SB_NS) * SB_STAGE; const char* Vt = Kt + 64 * KS_SB;
      f32x16 s[2];
#pragma unroll
      for (int i = 0; i < 16; ++i) { s[0][i] = 0.f; s[1][i] = 0.f; }
      const char* kp = Kt + l32 * KS_SB + lh * 16;
#pragma unroll
      for (int ks = 0; ks < 4; ++ks) {
        const bf16x8 a0 = *(const bf16x8*)(kp + ks * 32);
        const bf16x8 a1 = *(const bf16x8*)(kp + 32 * KS_SB + ks * 32);
        s[0] = MFMA32(a0, qf[ks], s[0]);
        s[1] = MFMA32(a1, qf[ks], s[1]);
      }
      const int qpos = qpos_w0 + l32;
      const int kt0 = kbw * 64 + lh * 4;
      const bool diag = (kbw * 64 + 63 >= qpos_w0);
      f32x16 om[2];
#pragma unroll
      for (int mt = 0; mt < 2; ++mt)
#pragma unroll
        for (int i = 0; i < 16; ++i) {
          const float z = __builtin_amdgcn_fmed3f(s[mt][i], -126.f, 126.f);
          const float e = ex2(-z);
          const float bt = __builtin_amdgcn_rcpf(1.f + e);
          s[mt][i] = bt; om[mt][i] = e * bt;
        }
      if (__builtin_amdgcn_readfirstlane((int)diag)) {
#pragma unroll
        for (int mt = 0; mt < 2; ++mt)
#pragma unroll
          for (int i = 0; i < 16; ++i) {
            const bool cz = (kt0 + mt * 32 + (i >> 2) * 8 + (i & 3)) < qpos;
            s[mt][i] = cz ? s[mt][i] : 0.f;
            om[mt][i] = cz ? om[mt][i] : 1.f;
          }
      }
      float R[8], Ro[8];
#pragma unroll
      for (int k8 = 0; k8 < 8; ++k8) {
        const int mt = k8 >> 2, g = k8 & 3;
        R[k8] = (om[mt][4 * g] * om[mt][4 * g + 1]) * (om[mt][4 * g + 2] * om[mt][4 * g + 3]);
      }
#pragma unroll
      for (int k8 = 0; k8 < 8; ++k8) Ro[k8] = __shfl_xor(R[k8], 32);
#pragma unroll
      for (int k8 = 7; k8 >= 0; --k8) {
        const int mt = k8 >> 2, g = k8 & 3;
        const float t3 = lh == 0 ? Pg * Ro[k8] : Pg;
        const float t2 = t3 * om[mt][4 * g + 3];
        const float t1 = t2 * om[mt][4 * g + 2];
        const float t0 = t1 * om[mt][4 * g + 1];
        s[mt][4 * g + 3] *= t3;
        s[mt][4 * g + 2] *= t2;
        s[mt][4 * g + 1] *= t1;
        s[mt][4 * g + 0] *= t0;
        Pg *= R[k8] * Ro[k8];
      }
      bf16x8 pb[4];
      pack_p(s, pb);
      pv_step(Vt, pb, o, lane);
      done = (__builtin_amdgcn_ballot_w64(Pg < SB_DONE) == ~0ull);
    }
    if (lane == 0) flags[(t & 1) * 8 + w] = (!active || done || kbw < 1) ? 1 : 0;
    if (has_next) lstore(kbn);
    __syncthreads();
    int alld = 1;
#pragma unroll
    for (int i = 0; i < 8; ++i) alld &= flags[(t & 1) * 8 + i];
    if (alld) break;
  }
  if (active) store_o(p, o, 1.f, tokrow0 + qw0 + l32, hd * 64, lh);
}

DI void attn_phase(const P& p, char* smem) {
  __shared__ int s_item;
  int* ctr = (int*)(p.ws + OFF_CTR);
  constexpr int N_MS = 64, N_SS = 128, N_MP = 2048, N_SP = 2048, N_ALL = N_MS + N_SS + N_MP + N_SP;
  if (threadIdx.x == 0) s_item = atomicAdd(ctr, 1);
  __syncthreads();
  int item = s_item;
  while (item < N_ALL) {
    __syncthreads();
    int nxt = 0;
    if (threadIdx.x == 0) nxt = atomicAdd(ctr, 1);
    int it = item;
    if (it < N_MS) { mla_item(p, smem, it >> 2, (it & 3) * 2, 0, true); }
    else if ((it -= N_MS) < N_SS) { sb_item(p, smem, it >> 3, it & 7, 0, true); }
    else if ((it -= N_SS) < N_MP) { const int qt = 7 - (it >> 8), bh = it & 255; mla_item(p, smem, bh >> 3, bh & 7, qt * 256, false); }
    else { it -= N_MP; const int qt = 7 - (it >> 8), bh = it & 255; sb_item(p, smem, bh >> 3, bh & 7, qt * 256, false); }
    if (threadIdx.x == 0) s_item = nxt;
    __syncthreads();
    item = s_item;
  }
}

DI void phase_fin(const P& p) {
  const int lane = threadIdx.x & 63, gw = blockIdx.x * 8 + (threadIdx.x >> 6), ngw = gridDim.x * 8;
  const float* mod = (const float*)(p.ws + OFF_MOD);
  const float* rss = (const float*)(p.ws + OFF_ROWSS);
  const u16* outp = (const u16*)(p.ws + OFF_GATES);
  const f32x4* pg4 = (const f32x4*)p.post_g;
  for (int row = gw * 2; row < NTOK; row += ngw * 2) {
    const float* xr; int bm;
    if (row < NTOK_P) { xr = p.x_prompt + (size_t)row * 1024; bm = row >> 11; }
    else { xr = p.x_sample + (size_t)(row - NTOK_P) * 1024; bm = 32 + ((row - NTOK_P) >> 6); }
    const f32x4* x4 = (const f32x4*)xr;
    const u32x2* o2 = (const u32x2*)(outp + (size_t)row * 1024);
    f32x4 xv[2][4]; u32x2 ov[2][4];
#pragma unroll
    for (int j = 0; j < 4; ++j) { xv[0][j] = __builtin_nontemporal_load(x4 + lane + 64 * j); xv[1][j] = __builtin_nontemporal_load(x4 + 256 + lane + 64 * j); ov[0][j] = o2[lane + 64 * j]; ov[1][j] = o2[256 + lane + 64 * j]; }
    const float s0 = (rss[row] + rss[NTOK + row]) + (rss[2 * NTOK + row] + rss[3 * NTOK + row]);
    const float s1 = (rss[row + 1] + rss[NTOK + row + 1]) + (rss[2 * NTOK + row + 1] + rss[3 * NTOK + row + 1]);
    const float r0 = rsqrtf(s0 * (1.f / 1024.f) + EPS), r1 = rsqrtf(s1 * (1.f / 1024.f) + EPS);
    const f32x4* gt4 = (const f32x4*)(mod + bm * 3072 + 2048);
    f32x4* y4 = (f32x4*)(p.out + (size_t)row * 1024);
#pragma unroll
    for (int j = 0; j < 4; ++j) {
      const int c4 = lane + 64 * j;
      const f32x4 m = gt4[c4] * pg4[c4];
      const f32x4 m0 = m * r0, m1 = m * r1;
      f32x4 y;
      y.x = xv[0][j].x + m0.x * bflo(ov[0][j].x); y.y = xv[0][j].y + m0.y * bfhi(ov[0][j].x);
      y.z = xv[0][j].z + m0.z * bflo(ov[0][j].y); y.w = xv[0][j].w + m0.w * bfhi(ov[0][j].y);
      y4[c4] = y;
      y.x = xv[1][j].x + m1.x * bflo(ov[1][j].x); y.y = xv[1][j].y + m1.y * bfhi(ov[1][j].x);
      y.z = xv[1][j].z + m1.z * bflo(ov[1][j].y); y.w = xv[1][j].w + m1.w * bfhi(ov[1][j].y);
      y4[256 + c4] = y;
    }
  }
}

__global__ void __launch_bounds__(512) sbmla_fwd(P p, int ph_lo, int ph_hi) {
  extern __shared__ __attribute__((aligned(16))) char smem[];
  cg::grid_group grid = cg::this_grid();
#ifndef REP_PHASE
#define REP_PHASE -1
#endif
#define PHASE(i, call) if (ph_lo <= (i) && (i) < ph_hi) { call; \
    if (REP_PHASE == (i)) { grid.sync(); if ((i) == 4) { if (blockIdx.x == 0 && threadIdx.x == 0) *(int*)(p.ws + OFF_CTR) = 0; grid.sync(); } call; } \
    if ((i) + 1 < ph_hi) grid.sync(); }
  PHASE(0, phase0(p, smem))
  PHASE(1, phase1(p))
  PHASE(2, gemm_g1(p, smem))
  PHASE(3, gemm_g23(p, smem))
  PHASE(4, attn_phase(p, smem))
  PHASE(5, gemm_g4(p, smem))
  PHASE(6, phase_fin(p))
#undef PHASE
}

#ifndef N_LAUNCH_SPLIT
#define N_LAUNCH_SPLIT 0
#endif

extern "C" void kernel_launch(void* const* d_in, const int* in_sizes, int n_in, void* d_out, int out_size, void* d_ws, size_t ws_size,
                              hipStream_t stream) {
  static int grid_blocks = 0;
  if (grid_blocks == 0) {
    if (n_in != 18 || ws_size < WS_END) { fprintf(stderr, "kernel_launch: unexpected n_in %d or ws_size %zu (need %zu)\n", n_in, ws_size, (size_t)WS_END); grid_blocks = -1; return; }
    int dev = 0, cus = 0, per_cu = 0;
    hipGetDevice(&dev);
    hipDeviceGetAttribute(&cus, hipDeviceAttributeMultiprocessorCount, dev);
    if (hipFuncSetAttribute((const void*)sbmla_fwd, hipFuncAttributeMaxDynamicSharedMemorySize, LDS_BYTES) != hipSuccess)
      fprintf(stderr, "kernel_launch: hipFuncSetAttribute failed\n");
    if (hipOccupancyMaxActiveBlocksPerMultiprocessor(&per_cu, (const void*)sbmla_fwd, 512, LDS_BYTES) != hipSuccess || per_cu < 1) {
      fprintf(stderr, "kernel_launch: occupancy query gave %d\n", per_cu); per_cu = 1;
    }
    (void)hipGetLastError();
    grid_blocks = cus * per_cu;
    if (grid_blocks > 256) grid_blocks = 256;
    fprintf(stderr, "kernel_launch: grid %d (cus %d per_cu %d)\n", grid_blocks, cus, per_cu);
  }
  if (grid_blocks < 0) return;
  P p{};
  const float** pp = (const float**)&p;
  for (int i = 0; i < 18; ++i) pp[i] = (const float*)d_in[i];
  p.out = (float*)d_out;
  p.ws = (char*)d_ws;
#if N_LAUNCH_SPLIT
  for (int ph = 0; ph < 7; ++ph) {
    int lo = ph, hi = ph + 1;
    hipLaunchKernelGGL(sbmla_fwd, dim3(grid_blocks), dim3(512), LDS_BYTES, stream, p, lo, hi);
  }
#else
  int lo = 0, hi = 7;
  void* args[] = {&p, &lo, &hi};
  hipError_t e = hipLaunchCooperativeKernel((const void*)sbmla_fwd, dim3(grid_blocks), dim3(512), args, LDS_BYTES, stream);
  if (e != hipSuccess) fprintf(stderr, "cooperative launch failed: %s (grid %d)\n", hipGetErrorString(e), grid_blocks);
#endif
}
```

```cpp
#include <hip/hip_runtime.h>
#include <hip/hip_cooperative_groups.h>
#include <cstdio>
namespace cg = cooperative_groups;

#define DI __device__ __forceinline__
typedef unsigned short u16;
typedef short bf16x8 __attribute__((ext_vector_type(8)));
typedef short s16x4 __attribute__((ext_vector_type(4)));
typedef float f32x4 __attribute__((ext_vector_type(4)));
typedef float f32x16 __attribute__((ext_vector_type(16)));
typedef unsigned u32x4 __attribute__((ext_vector_type(4)));
typedef unsigned u32x2 __attribute__((ext_vector_type(2)));

constexpr int T_P = 2048, T_S = 64, PAST = 4096;
constexpr int NTOK_P = 65536, NTOK = 66560;
constexpr int TKS = PAST + T_S;
constexpr int NKV = NTOK_P + 16 * TKS;
constexpr int IN_COLS = 3232, NPAD = 3328;
constexpr float EPS = 1e-6f;
constexpr float LOG2E = 1.4426950408889634f;
constexpr float QS_SB = 0.125f * LOG2E;
constexpr float QS_MLA = 0.10206207261596575f * LOG2E;
constexpr float SB_DONE = 1e-13f;

constexpr size_t O_YP = 0, O_YS = 67108864, O_SKP = 68157440, O_SVP = 101711872, O_CKVP = 135266304, O_KRP = 152043520,
                 O_SKS = 154140672, O_SVS = 154664960, O_CKVS = 155189248, O_KRS = 155451392;

constexpr size_t OFF_CTR = 0;
constexpr size_t OFF_MOD = 256;
constexpr size_t OFF_ROPE = OFF_MOD + 589824;
constexpr size_t OFF_WIN = OFF_ROPE + 270336;
constexpr size_t OFF_WUQ = OFF_WIN + 6815744;
constexpr size_t OFF_WUKV = OFF_WUQ + 589824;
constexpr size_t OFF_WOUT = OFF_WUKV + 524288;
constexpr size_t OFF_CQSS = OFF_WOUT + 2097152;
constexpr size_t OFF_ROWSS = OFF_CQSS + 532480;
constexpr size_t OFF_H = OFF_ROWSS + 1064960;
constexpr size_t OFF_GATES = OFF_H + 136314880;
constexpr size_t OFF_SBQ = OFF_GATES + 136314880;
constexpr size_t OFF_SBK = OFF_SBQ + 68157440;
constexpr size_t OFF_SBV = OFF_SBK + 68157440;
constexpr size_t OFF_CQ = OFF_SBV + 68157440;
constexpr size_t OFF_CKV = OFF_CQ + 51118080;
constexpr size_t OFF_KROPE = OFF_CKV + 67633152;
constexpr size_t OFF_QMLA = OFF_KROPE + 8454144;
constexpr size_t OFF_KV = OFF_QMLA + 102236160;
constexpr size_t WS_END = OFF_KV + 270532608;

constexpr int LDS_BYTES = 131072 + 4096;

struct P {
  const float *x_prompt, *x_sample, *cache_sb_k, *cache_sb_v, *cache_ckv, *cache_krope, *c_prompt, *c_sample,
      *ada_w, *ada_b, *pre_g, *w_in, *q_norm_g, *w_uq, *kv_norm_g, *w_ukv, *w_out, *post_g;
  float* out;
  char* ws;
};

DI unsigned pk2(float a, float b) {
  typedef __bf16 bf2 __attribute__((ext_vector_type(2)));
  typedef float f2 __attribute__((ext_vector_type(2)));
  f2 v = {a, b};
  bf2 r = __builtin_convertvector(v, bf2);
  return __builtin_bit_cast(unsigned, r);
}
DI u16 bf1(float a) { return (u16)(pk2(a, 0.f) & 0xffffu); }
DI float bflo(unsigned v) { return __uint_as_float(v << 16); }
DI float bfhi(unsigned v) { return __uint_as_float(v & 0xffff0000u); }
DI float silu_f(float x) { return x * __builtin_amdgcn_rcpf(1.f + __builtin_amdgcn_exp2f(-1.4426950408889634f * x)); }
DI float ex2(float x) { return __builtin_amdgcn_exp2f(x); }
DI float lg2(float x) { return __builtin_amdgcn_logf(x); }
DI float wave_sum(float v) {
#pragma unroll
  for (int o = 1; o < 64; o <<= 1) v += __shfl_xor(v, o);
  return v;
}
#define MFMA32(a, b, c) __builtin_amdgcn_mfma_f32_32x32x16_bf16((a), (b), (c), 0, 0, 0)
#define MFMA16(a, b, c) __builtin_amdgcn_mfma_f32_16x16x32_bf16((a), (b), (c), 0, 0, 0)

typedef __attribute__((address_space(3))) s16x4* lds_s16x4_ptr;
DI s16x4 tr_read(const char* ptr) {
  return __builtin_amdgcn_ds_read_tr16_b64_v4i16((lds_s16x4_ptr)(unsigned)(size_t)ptr);
}

DI int win_src_col(int p) {
  if (p < 2432) return p;
  if (p < 2464) return 2688 + (p - 2432);
  if (p < 2560) return -1;
  if (p < 2816) return 2432 + (p - 2560);
  return 2720 + (p - 2816);
}

DI void transpose_w(const float* __restrict__ W, int K, int N, int NP, u16* __restrict__ Wt, const float* __restrict__ kscale,
                    bool perm, int gtid, int gstride) {
  const int nk8 = K / 8;
  for (int e = gtid; e < NP * nk8; e += gstride) {
    const int pcol = e % NP, k8 = e / NP;
    const int c = perm ? win_src_col(pcol) : pcol;
    float v[8];
#pragma unroll
    for (int i = 0; i < 8; ++i) {
      float x = (c >= 0) ? W[(size_t)(k8 * 8 + i) * N + c] : 0.f;
      if (kscale) x *= kscale[k8 * 8 + i];
      v[i] = x;
    }
    u32x4 o = {pk2(v[0], v[1]), pk2(v[2], v[3]), pk2(v[4], v[5]), pk2(v[6], v[7])};
    *(u32x4*)(Wt + (size_t)pcol * K + k8 * 8) = o;
  }
}

DI void mod_job(const P& p, int job, float* lds) {
  const int cc = job % 48, bh = job / 48;
  const int tid = threadIdx.x, lane = tid & 63, w = tid >> 6;
  float* mod = (float*)(p.ws + OFF_MOD);
  __syncthreads();
  for (int e = tid; e < 24 * 1024; e += 512) {
    const int bl = e >> 10, k = e & 1023;
    const int b = bh * 24 + bl;
    const float cv = b < 32 ? p.c_prompt[b * 1024 + k] : p.c_sample[(b - 32) * 1024 + k];
    lds[k * 24 + bl] = silu_f(cv);
  }
  __syncthreads();
  float acc[24];
#pragma unroll
  for (int i = 0; i < 24; ++i) acc[i] = 0.f;
  const int col = cc * 64 + lane;
  for (int k = w * 128; k < w * 128 + 128; k += 16) {
    float wv[16];
#pragma unroll
    for (int u = 0; u < 16; ++u) wv[u] = p.ada_w[(size_t)(k + u) * 3072 + col];
#pragma unroll
    for (int u = 0; u < 16; ++u) {
      const f32x4* s4 = (const f32x4*)(lds + (k + u) * 24);
#pragma unroll
      for (int q = 0; q < 6; ++q) {
        const f32x4 s = s4[q];
        acc[q * 4 + 0] += s.x * wv[u]; acc[q * 4 + 1] += s.y * wv[u]; acc[q * 4 + 2] += s.z * wv[u]; acc[q * 4 + 3] += s.w * wv[u];
      }
    }
  }
  __syncthreads();
#pragma unroll
  for (int i = 0; i < 24; ++i) lds[(w * 24 + i) * 64 + lane] = acc[i];
  __syncthreads();
  for (int e = tid; e < 24 * 64; e += 512) {
    const int bl = e >> 6, l = e & 63;
    float s = 0.f;
#pragma unroll
    for (int ww = 0; ww < 8; ++ww) s += lds[(ww * 24 + bl) * 64 + l];
    const int b = bh * 24 + bl, c = cc * 64 + l;
    mod[b * 3072 + c] = s + p.ada_b[c];
  }
  __syncthreads();
}

DI void phase0(const P& p, char* smem) {
  const int tid = threadIdx.x;
  if (blockIdx.x == 0 && tid < 32) { ((int*)(p.ws + OFF_CTR))[tid] = 0; }
  for (int job = blockIdx.x; job < 96; job += gridDim.x) mod_job(p, job, (float*)smem);
  const bool split = gridDim.x >= 192;
  if (split && blockIdx.x < 96) return;
  const int gtid = (split ? blockIdx.x - 96 : blockIdx.x) * 512 + tid, gstride = (split ? gridDim.x - 96 : gridDim.x) * 512;
  transpose_w(p.w_in, 1024, IN_COLS, NPAD, (u16*)(p.ws + OFF_WIN), nullptr, true, gtid, gstride);
  transpose_w(p.w_uq, 384, 768, 768, (u16*)(p.ws + OFF_WUQ), p.q_norm_g, false, gtid, gstride);
  transpose_w(p.w_ukv, 256, 1024, 1024, (u16*)(p.ws + OFF_WUKV), nullptr, false, gtid, gstride);
  transpose_w(p.w_out, 1024, 1024, 1024, (u16*)(p.ws + OFF_WOUT), nullptr, false, gtid, gstride);
  {
    u16* ckv = (u16*)(p.ws + OFF_CKV);
    for (int e = gtid; e < 16 * PAST * 32; e += gstride) {
      const int c8 = e & 31, s = (e >> 5) & 4095, b = e >> 17;
      const f32x4* src = (const f32x4*)(p.cache_ckv + ((size_t)(b * PAST + s) * 256 + c8 * 8));
      const f32x4 a = src[0], c = src[1];
      u32x4 o = {pk2(a.x, a.y), pk2(a.z, a.w), pk2(c.x, c.y), pk2(c.z, c.w)};
      *(u32x4*)(ckv + ((size_t)(NTOK + b * PAST + s) * 256 + c8 * 8)) = o;
    }
    u16* kr = (u16*)(p.ws + OFF_KROPE);
    for (int e = gtid; e < 16 * PAST * 4; e += gstride) {
      const int c8 = e & 3, s = (e >> 2) & 4095, b = e >> 14;
      const f32x4* src = (const f32x4*)(p.cache_krope + ((size_t)(b * PAST + s) * 32 + c8 * 8));
      const f32x4 a = src[0], c = src[1];
      u32x4 o = {pk2(a.x, a.y), pk2(a.z, a.w), pk2(c.x, c.y), pk2(c.z, c.w)};
      *(u32x4*)(kr + ((size_t)(NTOK + b * PAST + s) * 32 + c8 * 8)) = o;
    }
  }
  {
    float* tab = (float*)(p.ws + OFF_ROPE);
    for (int e = gtid; e < 2112 * 16; e += gstride) {
      const int idx = e >> 4, i = e & 15;
      const int pos = idx < 2048 ? idx : PAST + (idx - 2048);
      const float inv = exp2f(-(float)i * (13.287712379549449f / 16.f));
      const float ang = (float)pos * inv;
      tab[idx * 32 + i] = cosf(ang);
      tab[idx * 32 + 16 + i] = sinf(ang);
    }
  }
}

DI void phase1(const P& p) {
  const int lane = threadIdx.x & 63, gw = blockIdx.x * 8 + (threadIdx.x >> 6), ngw = gridDim.x * 8;
  const float* mod = (const float*)(p.ws + OFF_MOD);
  u16* hb = (u16*)(p.ws + OFF_H);
  const f32x4* g4 = (const f32x4*)p.pre_g;
  for (int row = gw * 2; row < NTOK; row += ngw * 2) {
    const float* xr; int bm;
    if (row < NTOK_P) { xr = p.x_prompt + (size_t)row * 1024; bm = row >> 11; }
    else { xr = p.x_sample + (size_t)(row - NTOK_P) * 1024; bm = 32 + ((row - NTOK_P) >> 6); }
    const f32x4* x4 = (const f32x4*)xr;
    const f32x4* sh4 = (const f32x4*)(mod + bm * 3072);
    const f32x4* sc4 = (const f32x4*)(mod + bm * 3072 + 1024);
    f32x4 v[2][4]; float ss0 = 0.f, ss1 = 0.f;
#pragma unroll
    for (int j = 0; j < 4; ++j) { v[0][j] = __builtin_nontemporal_load(x4 + lane + 64 * j); v[1][j] = __builtin_nontemporal_load(x4 + 256 + lane + 64 * j); }
#pragma unroll
    for (int j = 0; j < 4; ++j) {
      ss0 += v[0][j].x * v[0][j].x + v[0][j].y * v[0][j].y + v[0][j].z * v[0][j].z + v[0][j].w * v[0][j].w;
      ss1 += v[1][j].x * v[1][j].x + v[1][j].y * v[1][j].y + v[1][j].z * v[1][j].z + v[1][j].w * v[1][j].w;
    }
#pragma unroll
    for (int o = 1; o < 64; o <<= 1) { ss0 += __shfl_xor(ss0, o); ss1 += __shfl_xor(ss1, o); }
    const float r0 = rsqrtf(ss0 * (1.f / 1024.f) + EPS), r1 = rsqrtf(ss1 * (1.f / 1024.f) + EPS);
#pragma unroll
    for (int j = 0; j < 4; ++j) {
      const int c4 = lane + 64 * j;
      const f32x4 g = g4[c4], sc = sc4[c4], sh = sh4[c4];
      const f32x4 m = g * (sc + 1.f);
      const f32x4 a = v[0][j] * r0 * m + sh, bq = v[1][j] * r1 * m + sh;
      *(u32x2*)(hb + (size_t)row * 1024 + c4 * 4) = (u32x2){pk2(a.x, a.y), pk2(a.z, a.w)};
      *(u32x2*)(hb + (size_t)(row + 1) * 1024 + c4 * 4) = (u32x2){pk2(bq.x, bq.y), pk2(bq.z, bq.w)};
    }
  }
}

#define LAS __attribute__((address_space(3)))
#define GAS __attribute__((address_space(1)))
constexpr int BM = 256, BK = 64, HALF = 128, HTB = HALF * BK * 2, NXCD = 8, WGM = 8;
constexpr int XCH_OFF = 131072;
DI int lds_byte(int r, int c) { const int st = (r >> 4) * 2 + (c >> 5), rr = r & 15, cc = c & 31, ob = rr * 64 + cc * 2; return st * 1024 + (ob ^ (((ob >> 9) & 1) << 5)); }
DI void stage_rc(int b, int& R, int& C) { const int st = b / 1024, sb = b % 1024, swz = sb ^ (((sb >> 9) & 1) << 5); R = (st >> 1) * 16 + swz / 64; C = (st & 1) * 32 + (swz % 64) / 2; }
DI int perm32(int rho) { const int n = rho >> 4, i = rho & 15; return 8 * (i >> 2) + 4 * n + (i & 3); }

struct Unit { int pm, pn; };
struct StaticOrder {
  int nM, nN, nwg, G, c;
  DI void init(int M, int N, int G_, int c_) { nM = M / BM; nN = N / BM; nwg = nM * nN; G = G_; c = c_; }
  DI bool next(int i, Unit& u) const {
    const long L = (long)i * G + c; if (L >= nwg) return false;
    int wgid = (int)L; { const int q = nwg / NXCD, r = nwg % NXCD, xcd = wgid % NXCD, off = wgid / NXCD; wgid = (xcd < r ? xcd * (q + 1) : r * (q + 1) + (xcd - r) * q) + off; }
    const int nig = WGM * nN, gid = wgid / nig, fm = gid * WGM, gsz = (nM - fm) < WGM ? (nM - fm) : WGM;
    u.pm = fm + ((wgid % nig) % gsz); u.pn = (wgid % nig) / gsz; return true;
  }
};

typedef f32x4 acc_t[2][2][4][2];
template <class Epi>
DI void gemm_phase(LAS unsigned char* lds, const u16* Ag, const u16* Btg, const int K, const StaticOrder& S, const Epi& E) {
  int tid = threadIdx.x; asm volatile("" : "+v"(tid));
  const int wid = __builtin_amdgcn_readfirstlane(tid >> 6), lane = tid & 63, wr = wid >> 2, wc = wid & 3, fr = lane & 15, fq = lane >> 4;
  const int nt = K / BK;
  unsigned voffA[2], voffB[2];
#pragma unroll
  for (int i = 0; i < 2; ++i) { int R, C; stage_rc(tid * 16 + i * 8192, R, C); const int Rb = Epi::PERM ? ((R & ~31) + perm32(R & 31)) : R;
    voffA[i] = (unsigned)(R * K + C) * 2u; voffB[i] = (unsigned)(Rb * K + C) * 2u; }
  const size_t kstep = (size_t)(BK * 2);
  const size_t hstep = (size_t)HALF * K * 2;
  const size_t tstep = 2 * hstep;
  const unsigned ldsw = (unsigned)wid * 1024u;
  const int aoff = lds_byte(wr * 64 + fr, fq * 8), boff = lds_byte(wc * 32 + fr, fq * 8);
#define PG8_SA(b, h) (((b) * 2 + (h)) * HTB)
#define PG8_SB(b, h) ((4 + (b) * 2 + (h)) * HTB)
#define PG8_STAGE(bufoff, gbase, voff) do { _Pragma("unroll") for (int _i = 0; _i < 2; ++_i) \
    __builtin_amdgcn_global_load_lds((const unsigned*)((const char*)(gbase) + (voff)[_i]), (LAS unsigned*)(lds + (bufoff) + ldsw + _i * 8192), 16, 0, 0); } while (0)
#define PG8_LDA(dst, b, h) do { _Pragma("unroll") for (int m = 0; m < 4; ++m) _Pragma("unroll") for (int k = 0; k < 2; ++k) dst[m][k] = *(const LAS bf16x8*)(lds + PG8_SA(b, h) + aoff + m * 2048 + k * 1024); } while (0)
#define PG8_LDB(dst, b, h) do { _Pragma("unroll") for (int n = 0; n < 2; ++n) _Pragma("unroll") for (int k = 0; k < 2; ++k) dst[n][k] = *(const LAS bf16x8*)(lds + PG8_SB(b, h) + boff + n * 2048 + k * 1024); } while (0)
#define PG8_MMA(ai, bj, At, Bt) do { __builtin_amdgcn_s_setprio(1); _Pragma("unroll") for (int m = 0; m < 4; ++m) _Pragma("unroll") for (int n = 0; n < 2; ++n) _Pragma("unroll") for (int k = 0; k < 2; ++k) \
    acc[ai][bj][m][n] = __builtin_amdgcn_mfma_f32_16x16x32_bf16(Bt[n][k], At[m][k], acc[ai][bj][m][n], 0, 0, 0); __builtin_amdgcn_s_setprio(0); } while (0)
#define PG8_WAIT_V(n) asm volatile("s_waitcnt vmcnt(" #n ")" ::: "memory")
#define PG8_WAIT_L(n) asm volatile("s_waitcnt lgkmcnt(" #n ")" ::: "memory")
#define PG8_BAR __builtin_amdgcn_s_barrier()
#define PG8_SCHED __builtin_amdgcn_sched_barrier(0)
  Unit cur, nxt; int ui = 0;
  if (!S.next(0, cur)) return;
  f32x4 acc[2][2][4][2];
#pragma unroll
  for (int a = 0; a < 2; ++a)
#pragma unroll
    for (int b = 0; b < 2; ++b)
#pragma unroll
      for (int m = 0; m < 4; ++m)
#pragma unroll
        for (int n = 0; n < 2; ++n) acc[a][b][m][n] = (f32x4){0.f, 0.f, 0.f, 0.f};
  bf16x8 At[4][2], B0[2][2], B1[2][2];
  const char* cA = (const char*)Ag + (size_t)cur.pm * tstep; const char* cB = (const char*)Btg + (size_t)cur.pn * tstep;
  PG8_STAGE(PG8_SB(0, 0), cB, voffB); PG8_STAGE(PG8_SA(0, 0), cA, voffA); PG8_STAGE(PG8_SB(0, 1), cB + hstep, voffB); PG8_STAGE(PG8_SA(0, 1), cA + hstep, voffA);
  if (wr == 1) PG8_BAR;
  PG8_WAIT_V(4); PG8_BAR;
  PG8_STAGE(PG8_SB(1, 0), cB + kstep, voffB); PG8_STAGE(PG8_SA(1, 0), cA + kstep, voffA); PG8_STAGE(PG8_SB(1, 1), cB + hstep + kstep, voffB);
  PG8_WAIT_V(6); PG8_BAR;
  for (;;) {
    const bool has_next = S.next(ui + 1, nxt);
    const char* nA = has_next ? (const char*)Ag + (size_t)nxt.pm * tstep : cA; const char* nB = has_next ? (const char*)Btg + (size_t)nxt.pn * tstep : cB;
#pragma unroll 1
    for (int t = 0; t < nt; t += 2) {
      const bool last = (t == nt - 2);
      const char* a1 = cA + (size_t)(t + 1) * kstep;
      const char* a2 = last ? nA : cA + (size_t)(t + 2) * kstep; const char* b2 = last ? nB : cB + (size_t)(t + 2) * kstep;
      const char* a3 = a2 + kstep; const char* b3 = b2 + kstep;
      PG8_LDB(B0, 0, 0); PG8_SCHED; PG8_LDA(At, 0, 0); PG8_STAGE(PG8_SA(1, 1), a1 + hstep, voffA);
      PG8_WAIT_L(8); PG8_BAR; PG8_WAIT_L(0); PG8_MMA(0, 0, At, B0); PG8_BAR; PG8_SCHED;
      PG8_LDB(B1, 0, 1); PG8_STAGE(PG8_SB(0, 0), b2, voffB);
      PG8_BAR; PG8_WAIT_L(0); PG8_MMA(0, 1, At, B1); PG8_BAR;
      PG8_LDA(At, 0, 1); PG8_STAGE(PG8_SA(0, 0), a2, voffA);
      PG8_BAR; PG8_WAIT_L(0); PG8_MMA(1, 0, At, B0); PG8_BAR; PG8_SCHED;
      PG8_STAGE(PG8_SB(0, 1), b2 + hstep, voffB);
      PG8_WAIT_V(6); PG8_BAR; PG8_MMA(1, 1, At, B1); PG8_BAR;
      PG8_LDB(B0, 1, 0); PG8_SCHED; PG8_LDA(At, 1, 0); PG8_STAGE(PG8_SA(0, 1), a2 + hstep, voffA);
      PG8_WAIT_L(8); PG8_BAR; PG8_WAIT_L(0); PG8_MMA(0, 0, At, B0); PG8_BAR; PG8_SCHED;
      PG8_LDB(B1, 1, 1); PG8_STAGE(PG8_SB(1, 0), b3, voffB);
      PG8_BAR; PG8_WAIT_L(0); PG8_MMA(0, 1, At, B1); PG8_BAR;
      PG8_LDA(At, 1, 1); PG8_STAGE(PG8_SA(1, 0), a3, voffA);
      PG8_BAR; PG8_WAIT_L(0); PG8_MMA(1, 0, At, B0); PG8_BAR; PG8_SCHED;
      PG8_STAGE(PG8_SB(1, 1), b3 + hstep, voffB);
      PG8_WAIT_V(6); PG8_BAR; PG8_MMA(1, 1, At, B1); PG8_BAR;
    }
    E(acc, cur, wr, wc, fr, fq);
    if (!has_next) break;
#pragma unroll
    for (int a = 0; a < 2; ++a)
#pragma unroll
      for (int b = 0; b < 2; ++b)
#pragma unroll
        for (int m = 0; m < 4; ++m)
#pragma unroll
          for (int n = 0; n < 2; ++n) acc[a][b][m][n] = (f32x4){0.f, 0.f, 0.f, 0.f};
    cur = nxt; cA = nA; cB = nB; ++ui;
  }
  PG8_WAIT_V(0);
  if (wr == 0) PG8_BAR;
  PG8_BAR;
#undef PG8_SA
#undef PG8_SB
#undef PG8_STAGE
#undef PG8_LDA
#undef PG8_LDB
#undef PG8_MMA
#undef PG8_WAIT_V
#undef PG8_WAIT_L
#undef PG8_BAR
#undef PG8_SCHED
}

DI u32x4 pack8(const f32x4 a, const f32x4 b) { return (u32x4){pk2(a.x, a.y), pk2(a.z, a.w), pk2(b.x, b.y), pk2(b.z, b.w)}; }
DI float sq4(const f32x4 a) { return (a.x * a.x + a.y * a.y) + (a.z * a.z + a.w * a.w); }

DI void rowsum_xch(float (&ss)[2][4], LAS float* xch, int wr, int wc, int fr, int fq) {
#pragma unroll
  for (int ai = 0; ai < 2; ++ai)
#pragma unroll
    for (int m = 0; m < 4; ++m) { float s = ss[ai][m]; s += __shfl_xor(s, 16); s += __shfl_xor(s, 32); ss[ai][m] = s; }
  if (fq == 0) {
#pragma unroll
    for (int ai = 0; ai < 2; ++ai)
#pragma unroll
      for (int m = 0; m < 4; ++m) xch[(128 * ai + 64 * wr + 16 * m + fr) * 4 + wc] = ss[ai][m];
  }
  asm volatile("s_waitcnt lgkmcnt(0)" ::: "memory");
  __builtin_amdgcn_s_barrier();
  asm volatile("" ::: "memory");
#pragma unroll
  for (int ai = 0; ai < 2; ++ai)
#pragma unroll
    for (int m = 0; m < 4; ++m) { const f32x4 t = *(const LAS f32x4*)(xch + (128 * ai + 64 * wr + 16 * m + fr) * 4); ss[ai][m] = (t.x + t.y) + (t.z + t.w); }
}

struct EpiG1 {
  static constexpr bool PERM = true;
  P p; LAS unsigned char* lds;
  DI void operator()(const acc_t& acc, const Unit& u, int, int, int, int) const {
    int t_ = threadIdx.x; asm volatile("" : "+v"(t_));
    const int wid_ = __builtin_amdgcn_readfirstlane(t_ >> 6), wr = wid_ >> 2, wc = wid_ & 3, fr = t_ & 15, fq = (t_ >> 4) & 3;
    GAS char* ws_ = (GAS char*)p.ws; GAS float* out_ = (GAS float*)p.out; asm volatile("" : "+s"(ws_), "+s"(out_));
    (void)out_;
    const int nt = u.pn;
    const bool samp = u.pm >= 256;
    const int row0 = u.pm * 256 + wr * 64 + fr;
    const int rl0 = samp ? row0 - NTOK_P : row0;
    const int c8 = wc * 32 + 8 * fq;
    if (nt < 2) {
      GAS u16* base = (GAS u16*)(ws_ + OFF_SBQ) + nt * 256 + c8;
#pragma unroll
      for (int ai = 0; ai < 2; ++ai)
#pragma unroll
        for (int m = 0; m < 4; ++m) { GAS u16* rp = base + (size_t)(row0 + ai * 128 + m * 16) * 512;
#pragma unroll
          for (int bj = 0; bj < 2; ++bj) *(GAS u32x4*)(rp + bj * 128) = pack8(acc[ai][bj][m][0] * QS_SB, acc[ai][bj][m][1] * QS_SB); }
    } else if (nt < 6) {
      const bool isv = nt >= 4;
      const int cb = (nt & 1) * 256 + c8;
      GAS float* ofb = out_ + (samp ? (isv ? O_SVS : O_SKS) : (isv ? O_SVP : O_SKP)) + cb;
#pragma unroll
      for (int ai = 0; ai < 2; ++ai)
#pragma unroll
        for (int m = 0; m < 4; ++m) { GAS float* of = ofb + (size_t)(rl0 + ai * 128 + m * 16) * 512;
#pragma unroll
          for (int bj = 0; bj < 2; ++bj) { *(GAS f32x4*)(of + bj * 128) = acc[ai][bj][m][0]; *(GAS f32x4*)(of + bj * 128 + 4) = acc[ai][bj][m][1];
          } }
    } else if (nt < 8 || nt >= 11) {
      const int cb = (nt < 8 ? (nt - 6) * 256 : 512 + (nt - 11) * 256) + c8;
      GAS u16* base = (GAS u16*)(ws_ + OFF_GATES) + cb;
#pragma unroll
      for (int ai = 0; ai < 2; ++ai)
#pragma unroll
        for (int m = 0; m < 4; ++m) { GAS u16* rp = base + (size_t)(row0 + ai * 128 + m * 16) * 1024;
#pragma unroll
          for (int bj = 0; bj < 2; ++bj) { f32x4 a = acc[ai][bj][m][0], b = acc[ai][bj][m][1];
            a.x = silu_f(a.x); a.y = silu_f(a.y); a.z = silu_f(a.z); a.w = silu_f(a.w); b.x = silu_f(b.x); b.y = silu_f(b.y); b.z = silu_f(b.z); b.w = silu_f(b.w);
            *(GAS u32x4*)(rp + bj * 128) = pack8(a, b); } }
    } else if (nt == 8 || nt == 9) {
      const int part = nt - 8;
      float ss[2][4];
#pragma unroll
      for (int ai = 0; ai < 2; ++ai)
#pragma unroll
        for (int m = 0; m < 4; ++m) { float s = sq4(acc[ai][0][m][0]) + sq4(acc[ai][0][m][1]); if (part == 0) s += sq4(acc[ai][1][m][0]) + sq4(acc[ai][1][m][1]); ss[ai][m] = s; }
      rowsum_xch(ss, (LAS float*)(lds + XCH_OFF), wr, wc, fr, fq);
      GAS float* cqss = (GAS float*)(ws_ + OFF_CQSS) + (size_t)part * NTOK;
      if (wc == 0 && fq == 0) {
#pragma unroll
        for (int ai = 0; ai < 2; ++ai)
#pragma unroll
          for (int m = 0; m < 4; ++m) cqss[row0 + ai * 128 + m * 16] = ss[ai][m];
      }
      GAS u16* base = (GAS u16*)(ws_ + OFF_CQ) + part * 256 + c8;
#pragma unroll
      for (int ai = 0; ai < 2; ++ai)
#pragma unroll
        for (int m = 0; m < 4; ++m) { GAS u16* rp = base + (size_t)(row0 + ai * 128 + m * 16) * 384;
          *(GAS u32x4*)(rp) = pack8(acc[ai][0][m][0], acc[ai][0][m][1]);
          if (part == 0) *(GAS u32x4*)(rp + 128) = pack8(acc[ai][1][m][0], acc[ai][1][m][1]); }
      if (part == 1 && wc == 0) {
        const GAS float* tab = (const GAS float*)(ws_ + OFF_ROPE);
        GAS float* okr = out_ + (samp ? O_KRS : O_KRP);
        GAS u16* kr = (GAS u16*)(ws_ + OFF_KROPE);
        const int i0 = (8 * fq) & 15;
#pragma unroll
        for (int ai = 0; ai < 2; ++ai)
#pragma unroll
          for (int m = 0; m < 4; ++m) {
            const int row = row0 + ai * 128 + m * 16, rl = rl0 + ai * 128 + m * 16;
            const int ridx = samp ? 2048 + (rl & 63) : (rl & 2047);
            f32x4 o[2];
#pragma unroll
            for (int n = 0; n < 2; ++n) {
              const f32x4 cs = *(const GAS f32x4*)(tab + ridx * 32 + i0 + 4 * n), sn = *(const GAS f32x4*)(tab + ridx * 32 + 16 + i0 + 4 * n);
              const f32x4 mine = acc[ai][1][m][n];
              f32x4 oth; oth.x = __shfl_xor(mine.x, 32); oth.y = __shfl_xor(mine.y, 32); oth.z = __shfl_xor(mine.z, 32); oth.w = __shfl_xor(mine.w, 32);
              o[n] = (fq < 2) ? (mine * cs - oth * sn) : (mine * cs + oth * sn);
            }
            *(GAS f32x4*)(okr + (size_t)rl * 32 + 8 * fq) = o[0]; *(GAS f32x4*)(okr + (size_t)rl * 32 + 8 * fq + 4) = o[1];
            *(GAS u32x4*)(kr + (size_t)row * 32 + 8 * fq) = pack8(o[0], o[1]);
          }
      }
    } else {
      float ss[2][4];
#pragma unroll
      for (int ai = 0; ai < 2; ++ai)
#pragma unroll
        for (int m = 0; m < 4; ++m) ss[ai][m] = (sq4(acc[ai][0][m][0]) + sq4(acc[ai][0][m][1])) + (sq4(acc[ai][1][m][0]) + sq4(acc[ai][1][m][1]));
      rowsum_xch(ss, (LAS float*)(lds + XCH_OFF), wr, wc, fr, fq);
      GAS float* ofb = out_ + (samp ? O_CKVS : O_CKVP) + c8;
      GAS u16* base = (GAS u16*)(ws_ + OFF_CKV) + c8;
      f32x4 gv[2][2];
#pragma unroll
      for (int bj = 0; bj < 2; ++bj)
#pragma unroll
        for (int n = 0; n < 2; ++n) gv[bj][n] = *(const f32x4*)(p.kv_norm_g + bj * 128 + c8 + 4 * n);
#pragma unroll
      for (int ai = 0; ai < 2; ++ai)
#pragma unroll
        for (int m = 0; m < 4; ++m) {
          const float r = rsqrtf(ss[ai][m] * (1.f / 256.f) + EPS);
          GAS float* of = ofb + (size_t)(rl0 + ai * 128 + m * 16) * 256; GAS u16* rp = base + (size_t)(row0 + ai * 128 + m * 16) * 256;
#pragma unroll
          for (int bj = 0; bj < 2; ++bj) {
            const f32x4 a = acc[ai][bj][m][0] * r * gv[bj][0], b = acc[ai][bj][m][1] * r * gv[bj][1];
            *(GAS f32x4*)(of + bj * 128) = a; *(GAS f32x4*)(of + bj * 128 + 4) = b;
            *(GAS u32x4*)(rp + bj * 128) = pack8(a, b);
          }
        }
    }
  }
};

struct EpiG2 {
  static constexpr bool PERM = false;
  P p;
  DI void operator()(const acc_t& acc, const Unit& u, int, int, int, int) const {
    int t_ = threadIdx.x; asm volatile("" : "+v"(t_));
    const int wid_ = __builtin_amdgcn_readfirstlane(t_ >> 6), wr = wid_ >> 2, wc = wid_ & 3, fr = t_ & 15, fq = (t_ >> 4) & 3;
    GAS char* ws_ = (GAS char*)p.ws; GAS float* out_ = (GAS float*)p.out; asm volatile("" : "+s"(ws_), "+s"(out_));
    (void)out_;
    const bool samp = u.pm >= 256;
    const int row0 = u.pm * 256 + wr * 64 + fr;
    const GAS float* cqss = (const GAS float*)(ws_ + OFF_CQSS);
    const GAS float* tab = (const GAS float*)(ws_ + OFF_ROPE);
    GAS u16* dst = (GAS u16*)(ws_ + OFF_QMLA);
#pragma unroll
    for (int ai = 0; ai < 2; ++ai)
#pragma unroll
      for (int m = 0; m < 4; ++m) {
        const int row = row0 + ai * 128 + m * 16;
        const float r = rsqrtf((cqss[row] + cqss[NTOK + row]) * (1.f / 384.f) + EPS) * QS_MLA;
        const int ridx = samp ? 2048 + ((row - NTOK_P) & 63) : (row & 2047);
#pragma unroll
        for (int bj = 0; bj < 2; ++bj) {
          const int gi = u.pn * 8 + bj * 4 + wc;
          f32x4 x1 = acc[ai][bj][m][0] * r, x2 = acc[ai][bj][m][1] * r;
          if (gi % 3 == 2) {
            const f32x4 cs = *(const GAS f32x4*)(tab + ridx * 32 + 4 * fq), sn = *(const GAS f32x4*)(tab + ridx * 32 + 16 + 4 * fq);
            const f32x4 o1 = x1 * cs - x2 * sn, o2 = x2 * cs + x1 * sn;
            x1 = o1; x2 = o2;
          }
          GAS u16* rp = dst + (size_t)row * 768 + gi * 32 + 4 * fq;
          *(GAS u32x2*)(rp) = (u32x2){pk2(x1.x, x1.y), pk2(x1.z, x1.w)};
          *(GAS u32x2*)(rp + 16) = (u32x2){pk2(x2.x, x2.y), pk2(x2.z, x2.w)};
        }
      }
  }
};

struct EpiG3 {
  static constexpr bool PERM = true;
  P p;
  DI void operator()(const acc_t& acc, const Unit& u, int, int, int, int) const {
    int t_ = threadIdx.x; asm volatile("" : "+v"(t_));
    const int wid_ = __builtin_amdgcn_readfirstlane(t_ >> 6), wr = wid_ >> 2, wc = wid_ & 3, fr = t_ & 15, fq = (t_ >> 4) & 3;
    GAS char* ws_ = (GAS char*)p.ws; GAS float* out_ = (GAS float*)p.out; asm volatile("" : "+s"(ws_), "+s"(out_));
    (void)out_;
    GAS u16* base = (GAS u16*)(ws_ + OFF_KV) + u.pn * 256 + wc * 32 + 8 * fq;
    const int row0 = u.pm * 256 + wr * 64 + fr;
#pragma unroll
    for (int ai = 0; ai < 2; ++ai)
#pragma unroll
      for (int m = 0; m < 4; ++m) { GAS u16* rp = base + (size_t)(row0 + ai * 128 + m * 16) * 1024;
#pragma unroll
        for (int bj = 0; bj < 2; ++bj) *(GAS u32x4*)(rp + bj * 128) = pack8(acc[ai][bj][m][0], acc[ai][bj][m][1]); }
  }
};

struct EpiG4 {
  static constexpr bool PERM = true;
  P p; LAS unsigned char* lds;
  DI void operator()(const acc_t& acc, const Unit& u, int, int, int, int) const {
    int t_ = threadIdx.x; asm volatile("" : "+v"(t_));
    const int wid_ = __builtin_amdgcn_readfirstlane(t_ >> 6), wr = wid_ >> 2, wc = wid_ & 3, fr = t_ & 15, fq = (t_ >> 4) & 3;
    GAS char* ws_ = (GAS char*)p.ws; GAS float* out_ = (GAS float*)p.out; asm volatile("" : "+s"(ws_), "+s"(out_));
    (void)out_;
    const int row0 = u.pm * 256 + wr * 64 + fr;
    float ss[2][4];
#pragma unroll
    for (int ai = 0; ai < 2; ++ai)
#pragma unroll
      for (int m = 0; m < 4; ++m) ss[ai][m] = (sq4(acc[ai][0][m][0]) + sq4(acc[ai][0][m][1])) + (sq4(acc[ai][1][m][0]) + sq4(acc[ai][1][m][1]));
    rowsum_xch(ss, (LAS float*)(lds + XCH_OFF), wr, wc, fr, fq);
    GAS float* rss = (GAS float*)(ws_ + OFF_ROWSS) + (size_t)u.pn * NTOK;
    if (wc == 0 && fq == 0) {
#pragma unroll
      for (int ai = 0; ai < 2; ++ai)
#pragma unroll
        for (int m = 0; m < 4; ++m) rss[row0 + ai * 128 + m * 16] = ss[ai][m];
    }
    GAS u16* base = (GAS u16*)(ws_ + OFF_GATES) + u.pn * 256 + wc * 32 + 8 * fq;
#pragma unroll
    for (int ai = 0; ai < 2; ++ai)
#pragma unroll
      for (int m = 0; m < 4; ++m) { GAS u16* rp = base + (size_t)(row0 + ai * 128 + m * 16) * 1024;
#pragma unroll
        for (int bj = 0; bj < 2; ++bj) *(GAS u32x4*)(rp + bj * 128) = pack8(acc[ai][bj][m][0], acc[ai][bj][m][1]); }
  }
};

DI void gemm_g1(const P& p, char* smem) {
  StaticOrder S; S.init(NTOK, NPAD, gridDim.x, blockIdx.x);
  EpiG1 E{p, (LAS unsigned char*)smem};
  gemm_phase((LAS unsigned char*)smem, (const u16*)(p.ws + OFF_H), (const u16*)(p.ws + OFF_WIN), 1024, S, E);
}
DI void gemm_g23(const P& p, char* smem) {
  { StaticOrder S; S.init(NTOK, 768, gridDim.x, blockIdx.x);
    EpiG2 E{p};
    gemm_phase((LAS unsigned char*)smem, (const u16*)(p.ws + OFF_CQ), (const u16*)(p.ws + OFF_WUQ), 384, S, E); }
  { StaticOrder S; S.init(NKV, 1024, gridDim.x, (blockIdx.x + 128) % gridDim.x);
    EpiG3 E{p};
    gemm_phase((LAS unsigned char*)smem, (const u16*)(p.ws + OFF_CKV), (const u16*)(p.ws + OFF_WUKV), 256, S, E); }
}
DI void gemm_g4(const P& p, char* smem) {
  StaticOrder S; S.init(NTOK, 1024, gridDim.x, blockIdx.x);
  EpiG4 E{p, (LAS unsigned char*)smem};
  gemm_phase((LAS unsigned char*)smem, (const u16*)(p.ws + OFF_H), (const u16*)(p.ws + OFF_WOUT), 1024, S, E);
}

constexpr int KS_SB = 144, KS_MLA = 208, VS = 192;
constexpr int MLA_STAGE = 64 * KS_MLA + 64 * VS;
constexpr int SB_STAGE = 64 * KS_SB + 64 * VS;
constexpr int FLAG_OFF = 65536;

DI void pv_step(const char* Vt, const bf16x8 (&pb)[4], f32x16 (&o)[2], int lane) {
  const int lh = lane >> 5, q4 = (lane & 15) >> 2, p4 = lane & 3, g1 = (lane >> 4) & 1;
  const char* vb = Vt + (4 * lh + q4) * VS + 32 * g1 + 8 * p4;
#pragma unroll
  for (int ks = 0; ks < 4; ++ks) {
#pragma unroll
    for (int dvt = 0; dvt < 2; ++dvt) {
      const s16x4 lo = tr_read(vb + (ks * 16) * VS + dvt * 64);
      const s16x4 hi = tr_read(vb + (ks * 16 + 8) * VS + dvt * 64);
      const bf16x8 vf = __builtin_shufflevector(lo, hi, 0, 1, 2, 3, 4, 5, 6, 7);
      o[dvt] = MFMA32(vf, pb[ks], o[dvt]);
    }
  }
}

DI void pack_p(const f32x16 (&s)[2], bf16x8 (&pb)[4]) {
#pragma unroll
  for (int mt = 0; mt < 2; ++mt)
#pragma unroll
    for (int h = 0; h < 2; ++h) {
      u32x4 t = {pk2(s[mt][8 * h + 0], s[mt][8 * h + 1]), pk2(s[mt][8 * h + 2], s[mt][8 * h + 3]),
                 pk2(s[mt][8 * h + 4], s[mt][8 * h + 5]), pk2(s[mt][8 * h + 6], s[mt][8 * h + 7])};
      pb[mt * 2 + h] = __builtin_bit_cast(bf16x8, t);
    }
}

DI void store_o(const P& p, const f32x16 (&o)[2], float inv, size_t tok, int colbase, int lh) {
  const u16* gates = (const u16*)(p.ws + OFF_GATES);
  u16* mixed = (u16*)(p.ws + OFF_H);
#pragma unroll
  for (int dvt = 0; dvt < 2; ++dvt)
#pragma unroll
    for (int g = 0; g < 4; ++g) {
      const size_t off = tok * 1024 + colbase + dvt * 32 + g * 8 + lh * 4;
      const u32x2 gt = *(const u32x2*)(gates + off);
      u32x2 ov = {pk2(o[dvt][4 * g + 0] * inv * bflo(gt.x), o[dvt][4 * g + 1] * inv * bfhi(gt.x)),
                  pk2(o[dvt][4 * g + 2] * inv * bflo(gt.y), o[dvt][4 * g + 3] * inv * bfhi(gt.y))};
      *(u32x2*)(mixed + off) = ov;
    }
}

DI void mla_item(const P& p, char* smem, int b, int hd, int q0, bool samp) {
  int tid = threadIdx.x; asm volatile("" : "+v"(tid));
  const int w = __builtin_amdgcn_readfirstlane(tid >> 6), lane = tid & 63, l32 = lane & 31, lh = lane >> 5;
  const bool active = samp ? (w < 4) : true;
  const int hw = samp ? hd + (w >> 1) : hd;
  const int qw0 = samp ? (w & 1) * 32 : q0 + w * 32;
  constexpr int STG = 2 * MLA_STAGE;
  const int hoff = samp ? (w >> 1) * MLA_STAGE : 0;
  const size_t tokrow0 = samp ? (size_t)(NTOK_P + b * 64) : (size_t)b * 2048;
  const int nkb_blk = samp ? 65 : (q0 / 64 + 4);
  const int nkb_w = samp ? 65 : (qw0 / 64 + 1);
  const u16* kv = (const u16*)(p.ws + OFF_KV);
  const u16* krope = (const u16*)(p.ws + OFF_KROPE);
  bf16x8 qf[6];
  if (active) {
    const u16* qp = (const u16*)(p.ws + OFF_QMLA) + (tokrow0 + qw0 + l32) * 768 + hw * 96 + lh * 8;
#pragma unroll
    for (int ks = 0; ks < 6; ++ks) qf[ks] = *(const bf16x8*)(qp + ks * 16);
  } else {
#pragma unroll
    for (int ks = 0; ks < 6; ++ks) qf[ks] = (bf16x8){0, 0, 0, 0, 0, 0, 0, 0};
  }
  u32x4 rkn, rvv, rkr, rkn2, rvv2;
  rkr = rkn2 = rvv2 = (u32x4){0, 0, 0, 0};
  auto gload = [&](int kb) {
    const size_t trow0 = samp ? (kb < 64 ? (size_t)(NTOK + b * PAST + kb * 64) : (size_t)(NTOK_P + b * 64)) : (size_t)(b * 2048 + kb * 64);
    if (samp) {
      const int h2 = tid >> 8, u = tid & 255;
      const u16* base = kv + (trow0 + (u >> 3)) * 1024 + (hd + h2) * 128 + (u & 7) * 8;
      rkn = *(const u32x4*)base; rvv = *(const u32x4*)(base + 64);
      rkn2 = *(const u32x4*)(base + 32 * 1024); rvv2 = *(const u32x4*)(base + 32 * 1024 + 64);
      rkr = *(const u32x4*)(krope + (trow0 + (u >> 2)) * 32 + (u & 3) * 8);
    } else {
      const size_t row = trow0 + (tid >> 3);
      const u16* base = kv + row * 1024 + hd * 128 + (tid & 7) * 8;
      rkn = *(const u32x4*)base;
      rvv = *(const u32x4*)(base + 64);
      if (tid < 256) rkr = *(const u32x4*)(krope + (trow0 + (tid >> 2)) * 32 + (tid & 3) * 8);
    }
  };
  auto lstore = [&](int buf) {
    if (samp) {
      const int h2 = tid >> 8, u = tid & 255;
      char* Kt = smem + buf * STG + h2 * MLA_STAGE; char* Vt = Kt + 64 * KS_MLA;
      *(u32x4*)(Kt + (u >> 3) * KS_MLA + (u & 7) * 16) = rkn;
      *(u32x4*)(Kt + (32 + (u >> 3)) * KS_MLA + (u & 7) * 16) = rkn2;
      *(u32x4*)(Vt + (u >> 3) * VS + (u & 7) * 16) = rvv;
      *(u32x4*)(Vt + (32 + (u >> 3)) * VS + (u & 7) * 16) = rvv2;
      *(u32x4*)(Kt + (u >> 2) * KS_MLA + 128 + (u & 3) * 16) = rkr;
    } else {
      char* Kt = smem + buf * STG; char* Vt = Kt + 64 * KS_MLA;
      *(u32x4*)(Kt + (tid >> 3) * KS_MLA + (tid & 7) * 16) = rkn;
      *(u32x4*)(Vt + (tid >> 3) * VS + (tid & 7) * 16) = rvv;
      if (tid < 256) *(u32x4*)(Kt + (tid >> 2) * KS_MLA + 128 + (tid & 3) * 16) = rkr;
    }
  };
  f32x16 o[2];
#pragma unroll
  for (int i = 0; i < 16; ++i) { o[0][i] = 0.f; o[1][i] = 0.f; }
  float mrun = -1e30f, lsum = 0.f;
  gload(0); lstore(0);
  __syncthreads();
  for (int kb = 0; kb < nkb_blk; ++kb) {
    const bool has_next = kb + 1 < nkb_blk;
    if (has_next) gload(kb + 1);
    if (active && kb < nkb_w) {
      const char* Kt = smem + (kb & 1) * STG + hoff; const char* Vt = Kt + 64 * KS_MLA;
      f32x16 s[2];
      const float cinit = (kb == 0) ? 0.f : -mrun;
#pragma unroll
      for (int i = 0; i < 16; ++i) { s[0][i] = cinit; s[1][i] = cinit; }
      const char* kp = Kt + l32 * KS_MLA + lh * 16;
#pragma unroll
      for (int ks = 0; ks < 6; ++ks) {
        const bf16x8 a0 = *(const bf16x8*)(kp + ks * 32);
        const bf16x8 a1 = *(const bf16x8*)(kp + 32 * KS_MLA + ks * 32);
        s[0] = MFMA32(a0, qf[ks], s[0]);
        s[1] = MFMA32(a1, qf[ks], s[1]);
      }
      f32x16 e[2];
      float ps0 = 0.f, ps1 = 0.f;
      bool redo = (kb == 0);
      if (!redo) {
#pragma unroll
        for (int i = 0; i < 16; ++i) { e[0][i] = ex2(s[0][i]); e[1][i] = ex2(s[1][i]); ps0 += e[0][i]; ps1 += e[1][i]; }
        redo = (__builtin_amdgcn_ballot_w64(!(ps0 + ps1 < 1e18f)) != 0ull);
      }
      if (redo) {
        float mx = fmaxf(s[0][0], s[1][0]);
#pragma unroll
        for (int i = 1; i < 16; ++i) mx = fmaxf(mx, fmaxf(s[0][i], s[1][i]));
        mx = fmaxf(mx, __shfl_xor(mx, 32));
        const float up = (kb == 0) ? mx : fmaxf(mx, 0.f);
        const float alpha = (kb == 0) ? 0.f : ex2(-up);
        lsum *= alpha;
#pragma unroll
        for (int i = 0; i < 16; ++i) { o[0][i] *= alpha; o[1][i] *= alpha; }
        mrun = (kb == 0) ? mx : mrun + up;
        ps0 = 0.f; ps1 = 0.f;
#pragma unroll
        for (int i = 0; i < 16; ++i) { e[0][i] = ex2(s[0][i] - up); e[1][i] = ex2(s[1][i] - up); ps0 += e[0][i]; ps1 += e[1][i]; }
      }
      lsum += ps0 + ps1;
      bf16x8 pb[4];
      pack_p(e, pb);
      pv_step(Vt, pb, o, lane);
    }
    if (has_next) lstore((kb + 1) & 1);
    __syncthreads();
  }
  if (active) {
    const float lt = lsum + __shfl_xor(lsum, 32);
    store_o(p, o, 1.f / lt, tokrow0 + qw0 + l32, 512 + hw * 64, lh);
  }
}

constexpr int SB_NS = 6;
DI void sb_item(const P& p, char* smem, int b, int hd, int q0, bool samp) {
  int tid = threadIdx.x; asm volatile("" : "+v"(tid));
  const int w = __builtin_amdgcn_readfirstlane(tid >> 6), lane = tid & 63, l32 = lane & 31, lh = lane >> 5;
  const int nq = samp ? 64 : 256;
  const bool active = (w * 32 < nq);
  const int qw0 = q0 + w * 32;
  const int qpos_w0 = samp ? PAST + qw0 : qw0;
  const size_t tokrow0 = samp ? (size_t)(NTOK_P + b * 64) : (size_t)b * 2048;
  const int dw = samp ? 64 : (q0 >> 6) + (w >> 1);
  const int d_min = samp ? 64 : (q0 >> 6), d_cnt = samp ? 1 : 4;
  int* flags = (int*)(smem + SB_NS * SB_STAGE);
  bf16x8 qf[4];
  if (active) {
    const u16* qp = (const u16*)(p.ws + OFF_SBQ) + (tokrow0 + qw0 + l32) * 512 + hd * 64 + lh * 8;
#pragma unroll
    for (int ks = 0; ks < 4; ++ks) qf[ks] = *(const bf16x8*)(qp + ks * 16);
  } else {
#pragma unroll
    for (int ks = 0; ks < 4; ++ks) qf[ks] = (bf16x8){0, 0, 0, 0, 0, 0, 0, 0};
  }
  const int r = tid >> 3, c = tid & 7;
  const float* nk = p.out + (samp ? O_SKS : O_SKP);
  const float* nv = p.out + (samp ? O_SVS : O_SVP);
  auto src_off = [&](int kb) -> size_t {
    return samp ? (kb < 64 ? ((size_t)(b * PAST + kb * 64 + r) * 8 + hd) * 64 + c * 8 : (size_t)(b * 64 + r) * 512 + hd * 64 + c * 8)
                : ((size_t)b * 2048 + (size_t)kb * 64 + r) * 512 + hd * 64 + c * 8;
  };
  {
    f32x4 pk[4][2], pv[4][2];
#pragma unroll
    for (int i = 0; i < 4; ++i) {
      if (i < d_cnt) {
        const size_t off = src_off(d_min + i);
        const f32x4* ks = (const f32x4*)(nk + off); const f32x4* vs = (const f32x4*)(nv + off);
        pk[i][0] = ks[0]; pk[i][1] = ks[1]; pv[i][0] = vs[0]; pv[i][1] = vs[1];
      }
    }
#pragma unroll
    for (int i = 0; i < 4; ++i) {
      if (i < d_cnt) {
        char* Kt = smem + ((d_min + i) % SB_NS) * SB_STAGE; char* Vt = Kt + 64 * KS_SB;
        *(u32x4*)(Kt + r * KS_SB + c * 16) = pack8(pk[i][0], pk[i][1]);
        *(u32x4*)(Vt + r * VS + c * 16) = pack8(pv[i][0], pv[i][1]);
      }
    }
  }
  f32x4 fk0, fk1, fv0, fv1;
  fk0 = fk1 = fv0 = fv1 = (f32x4){0.f, 0.f, 0.f, 0.f};
  auto gload = [&](int kb) {
    const size_t off = src_off(kb);
    const f32x4* ks = (const f32x4*)((samp ? p.cache_sb_k : nk) + off);
    const f32x4* vs = (const f32x4*)((samp ? p.cache_sb_v : nv) + off);
    fk0 = ks[0]; fk1 = ks[1]; fv0 = vs[0]; fv1 = vs[1];
  };
  auto lstore = [&](int kb) {
    char* Kt = smem + (kb % SB_NS) * SB_STAGE; char* Vt = Kt + 64 * KS_SB;
    *(u32x4*)(Kt + r * KS_SB + c * 16) = pack8(fk0, fk1);
    *(u32x4*)(Vt + r * VS + c * 16) = pack8(fv0, fv1);
  };
  f32x16 o[2];
#pragma unroll
  for (int i = 0; i < 16; ++i) { o[0][i] = 0.f; o[1][i] = 0.f; }
  float Pg = 1.f;
  bool done = false;
  __syncthreads();
  for (int t = 0;; ++t) {
    const int kbn = d_min - (t + 1);
    const bool has_next = kbn >= 0;
    if (has_next) gload(kbn);
    const int kbw = dw - t;
    if (active && !done && kbw >= 0) {
      const char* Kt = smem + (kbw % SB_NS) * SB_STAGE; const char* Vt = Kt + 64 * KS_SB;
      f32x16 s[2];
#pragma unroll
      for (int i = 0; i < 16; ++i) { s[0][i] = 0.f; s[1][i] = 0.f; }
      const char* kp = Kt + l32 * KS_SB + lh * 16;
#pragma unroll
      for (int ks = 0; ks < 4; ++ks) {
        const bf16x8 a0 = *(const bf16x8*)(kp + ks * 32);
        const bf16x8 a1 = *(const bf16x8*)(kp + 32 * KS_SB + ks * 32);
        s[0] = MFMA32(a0, qf[ks], s[0]);
        s[1] = MFMA32(a1, qf[ks], s[1]);
      }
      const int qpos = qpos_w0 + l32;
      const int kt0 = kbw * 64 + lh * 4;
      const bool diag = (kbw * 64 + 63 >= qpos_w0);
      f32x16 om[2];
#pragma unroll
      for (int mt = 0; mt < 2; ++mt)
#pragma unroll
        for (int i = 0; i < 16; ++i) {
          const float z = __builtin_amdgcn_fmed3f(s[mt][i], -126.f, 126.f);
          const float e = ex2(-z);
          const float bt = __builtin_amdgcn_rcpf(1.f + e);
          s[mt][i] = bt; om[mt][i] = e * bt;
        }
      if (__builtin_amdgcn_readfirstlane((int)diag)) {
#pragma unroll
        for (int mt = 0; mt < 2; ++mt)
#pragma unroll
          for (int i = 0; i < 16; ++i) {
            const bool cz = (kt0 + mt * 32 + (i >> 2) * 8 + (i & 3)) < qpos;
            s[mt][i] = cz ? s[mt][i] : 0.f;
            om[mt][i] = cz ? om[mt][i] : 1.f;
          }
      }
      float R[8], Ro[8];
#pragma unroll
      for (int k8 = 0; k8 < 8; ++k8) {
        const int mt = k8 >> 2, g = k8 & 3;
        R[k8] = (om[mt][4 * g] * om[mt][4 * g + 1]) * (om[mt][4 * g + 2] * om[mt][4 * g + 3]);
      }
#pragma unroll
      for (int k8 = 0; k8 < 8; ++k8) Ro[k8] = __shfl_xor(R[k8], 32);
#pragma unroll
      for (int k8 = 7; k8 >= 0; --k8) {
        const int mt = k8 >> 2, g = k8 & 3;
        const float t3 = lh == 0 ? Pg * Ro[k8] : Pg;
        const float t2 = t3 * om[mt][4 * g + 3];
        const float t1 = t2 * om[mt][4 * g + 2];
        const float t0 = t1 * om[mt][4 * g + 1];
        s[mt][4 * g + 3] *= t3;
        s[mt][4 * g + 2] *= t2;
        s[mt][4 * g + 1] *= t1;
        s[mt][4 * g + 0] *= t0;
        Pg *= R[k8] * Ro[k8];
      }
      bf16x8 pb[4];
      pack_p(s, pb);
      pv_step(Vt, pb, o, lane);
      done = (__builtin_amdgcn_ballot_w64(Pg < SB_DONE) == ~0ull);
    }
    if (lane == 0) flags[(t & 1) * 8 + w] = (!active || done || kbw < 1) ? 1 : 0;
    if (has_next) lstore(kbn);
    __syncthreads();
    int alld = 1;
#pragma unroll
    for (int i = 0; i < 8; ++i) alld &= flags[(t & 1) * 8 + i];
    if (alld) break;
  }
  if (active) store_o(p, o, 1.f, tokrow0 + qw0 + l32, hd * 64, lh);
}

DI void attn_phase(const P& p, char* smem) {
  __shared__ int s_item;
  int* ctr = (int*)(p.ws + OFF_CTR);
  constexpr int N_MS = 64, N_SS = 128, N_MP = 2048, N_SP = 2048, N_ALL = N_MS + N_SS + N_MP + N_SP;
  if (threadIdx.x == 0) s_item = atomicAdd(ctr, 1);
  __syncthreads();
  int item = s_item;
  while (item < N_ALL) {
    __syncthreads();
    int nxt = 0;
    if (threadIdx.x == 0) nxt = atomicAdd(ctr, 1);
    int it = item;
    if (it < N_MS) { mla_item(p, smem, it >> 2, (it & 3) * 2, 0, true); }
    else if ((it -= N_MS) < N_SS) { sb_item(p, smem, it >> 3, it & 7, 0, true); }
    else if ((it -= N_SS) < N_MP) { const int qt = 7 - (it >> 8), bh = it & 255; mla_item(p, smem, bh >> 3, bh & 7, qt * 256, false); }
    else { it -= N_MP; const int qt = 7 - (it >> 8), bh = it & 255; sb_item(p, smem, bh >> 3, bh & 7, qt * 256, false); }
    if (threadIdx.x == 0) s_item = nxt;
    __syncthreads();
    item = s_item;
  }
}

DI void phase_fin(const P& p) {
  const int lane = threadIdx.x & 63, gw = blockIdx.x * 8 + (threadIdx.x >> 6), ngw = gridDim.x * 8;
  const float* mod = (const float*)(p.ws + OFF_MOD);
  const float* rss = (const float*)(p.ws + OFF_ROWSS);
  const u16* outp = (const u16*)(p.ws + OFF_GATES);
  const f32x4* pg4 = (const f32x4*)p.post_g;
  for (int row = gw * 2; row < NTOK; row += ngw * 2) {
    const float* xr; int bm;
    if (row < NTOK_P) { xr = p.x_prompt + (size_t)row * 1024; bm = row >> 11; }
    else { xr = p.x_sample + (size_t)(row - NTOK_P) * 1024; bm = 32 + ((row - NTOK_P) >> 6); }
    const f32x4* x4 = (const f32x4*)xr;
    const u32x2* o2 = (const u32x2*)(outp + (size_t)row * 1024);
    f32x4 xv[2][4]; u32x2 ov[2][4];
#pragma unroll
    for (int j = 0; j < 4; ++j) { xv[0][j] = __builtin_nontemporal_load(x4 + lane + 64 * j); xv[1][j] = __builtin_nontemporal_load(x4 + 256 + lane + 64 * j); ov[0][j] = o2[lane + 64 * j]; ov[1][j] = o2[256 + lane + 64 * j]; }
    const float s0 = (rss[row] + rss[NTOK + row]) + (rss[2 * NTOK + row] + rss[3 * NTOK + row]);
    const float s1 = (rss[row + 1] + rss[NTOK + row + 1]) + (rss[2 * NTOK + row + 1] + rss[3 * NTOK + row + 1]);
    const float r0 = rsqrtf(s0 * (1.f / 1024.f) + EPS), r1 = rsqrtf(s1 * (1.f / 1024.f) + EPS);
    const f32x4* gt4 = (const f32x4*)(mod + bm * 3072 + 2048);
    f32x4* y4 = (f32x4*)(p.out + (size_t)row * 1024);
#pragma unroll
    for (int j = 0; j < 4; ++j) {
      const int c4 = lane + 64 * j;
      const f32x4 m = gt4[c4] * pg4[c4];
      const f32x4 m0 = m * r0, m1 = m * r1;
      f32x4 y;
      y.x = xv[0][j].x + m0.x * bflo(ov[0][j].x); y.y = xv[0][j].y + m0.y * bfhi(ov[0][j].x);
      y.z = xv[0][j].z + m0.z * bflo(ov[0][j].y); y.w = xv[0][j].w + m0.w * bfhi(ov[0][j].y);
      y4[c4] = y;
      y.x = xv[1][j].x + m1.x * bflo(ov[1][j].x); y.y = xv[1][j].y + m1.y * bfhi(ov[1][j].x);
      y.z = xv[1][j].z + m1.z * bflo(ov[1][j].y); y.w = xv[1][j].w + m1.w * bfhi(ov[1][j].y);
      y4[256 + c4] = y;
    }
  }
}

__global__ void __launch_bounds__(512) sbmla_fwd(P p, int ph_lo, int ph_hi) {
  extern __shared__ __attribute__((aligned(16))) char smem[];
  cg::grid_group grid = cg::this_grid();
#ifndef REP_PHASE
#define REP_PHASE -1
#endif
#define PHASE(i, call) if (ph_lo <= (i) && (i) < ph_hi) { call; \
    if (REP_PHASE == (i)) { grid.sync(); if ((i) == 4) { if (blockIdx.x == 0 && threadIdx.x == 0) *(int*)(p.ws + OFF_CTR) = 0; grid.sync(); } call; } \
    if ((i) + 1 < ph_hi) grid.sync(); }
  PHASE(0, phase0(p, smem))
  PHASE(1, phase1(p))
  PHASE(2, gemm_g1(p, smem))
  PHASE(3, gemm_g23(p, smem))
  PHASE(4, attn_phase(p, smem))
  PHASE(5, gemm_g4(p, smem))
  PHASE(6, phase_fin(p))
#undef PHASE
}

#ifndef N_LAUNCH_SPLIT
#define N_LAUNCH_SPLIT 0
#endif

extern "C" void kernel_launch(void* const* d_in, const int* in_sizes, int n_in, void* d_out, int out_size, void* d_ws, size_t ws_size,
                              hipStream_t stream) {
  static int grid_blocks = 0;
  if (grid_blocks == 0) {
    if (n_in != 18 || ws_size < WS_END) { fprintf(stderr, "kernel_launch: unexpected n_in %d or ws_size %zu (need %zu)\n", n_in, ws_size, (size_t)WS_END); grid_blocks = -1; return; }
    int dev = 0, cus = 0, per_cu = 0;
    hipGetDevice(&dev);
    hipDeviceGetAttribute(&cus, hipDeviceAttributeMultiprocessorCount, dev);
    if (hipFuncSetAttribute((const void*)sbmla_fwd, hipFuncAttributeMaxDynamicSharedMemorySize, LDS_BYTES) != hipSuccess)
      fprintf(stderr, "kernel_launch: hipFuncSetAttribute failed\n");
    if (hipOccupancyMaxActiveBlocksPerMultiprocessor(&per_cu, (const void*)sbmla_fwd, 512, LDS_BYTES) != hipSuccess || per_cu < 1) {
      fprintf(stderr, "kernel_launch: occupancy query gave %d\n", per_cu); per_cu = 1;
    }
    (void)hipGetLastError();
    grid_blocks = cus * per_cu;
    if (grid_blocks > 256) grid_blocks = 256;
    fprintf(stderr, "kernel_launch: grid %d (cus %d per_cu %d)\n", grid_blocks, cus, per_cu);
  }
  if (grid_blocks < 0) return;
  P p{};
  const float** pp = (const float**)&p;
  for (int i = 0; i < 18; ++i) pp[i] = (const float*)d_in[i];
  p.out = (float*)d_out;
  p.ws = (char*)d_ws;
#if N_LAUNCH_SPLIT
  for (int ph = 0; ph < 7; ++ph) {
    int lo = ph, hi = ph + 1;
    hipLaunchKernelGGL(sbmla_fwd, dim3(grid_blocks), dim3(512), LDS_BYTES, stream, p, lo, hi);
  }
#else
  int lo = 0, hi = 7;
  void* args[] = {&p, &lo, &hi};
  hipError_t e = hipLaunchCooperativeKernel((const void*)sbmla_fwd, dim3(grid_blocks), dim3(512), args, LDS_BYTES, stream);
  if (e != hipSuccess) fprintf(stderr, "cooperative launch failed: %s (grid %d)\n", hipGetErrorString(e), grid_blocks);
#endif
}
```
